# Optimizing an MI355X kernel written in HIP

```python
import math
import jax, jax.numpy as jnp
from jax import lax
import numpy as np

D_MODEL = 1024
BATCH = 1
SEQ = 16384
DEPTH = 1

CHUNK = 64
CONV_WIDTH = 1024
CONV_K = 3
SSM_WIDTH = 512
SSM_GROUP = 16
SSM_GROUPS = SSM_WIDTH // SSM_GROUP
SSM_STATE = 64
DT_MIN = 1e-3
DT_MAX = 1e-1
N_BRANCHES = 2
IN_COLS = 3 * CONV_WIDTH + SSM_WIDTH + N_BRANCHES * D_MODEL
N_EXPERT_GROUPS = 4
EXPERTS_PER_GROUP = 8
N_EXPERTS = N_EXPERT_GROUPS * EXPERTS_PER_GROUP
EXPERT_FF = 512
TOP_K_INNER = 2
EPS = 1e-6

kernel_name = "hybrid_conv_s5_hiermoe_block"


def rms_norm(x, g):
    xf = x.astype(jnp.float32)
    y = xf * lax.rsqrt(jnp.mean(xf * xf, axis=-1, keepdims=True) + EPS)
    return (y * g.astype(jnp.float32)).astype(x.dtype)


def short_conv_branch(xc, bg, cg, conv_w, conv_b, w_out):
    v = cg * xc
    y = lax.conv_general_dilated(
        v, conv_w.astype(v.dtype), window_strides=(1,), padding=[(CONV_K - 1, 0)],
        dimension_numbers=("NWC", "WIO", "NWC"), feature_group_count=CONV_WIDTH)
    y = y + conv_b
    return (bg * y) @ w_out


def _ssm_combine(e1, e2):
    a1, s1 = e1
    a2, s2 = e2
    return a1 * a2, a2 * s1 + s2


def s5_branch(u, a_re, a_im, log_dt, b_re, b_im, c_re, c_im, d_skip, w_glu_a, w_glu_b):
    bsz, length, _ = u.shape
    f32 = jnp.float32
    uf = u.astype(f32).reshape(bsz, length, SSM_GROUPS, SSM_GROUP)
    lam = lax.complex(a_re.astype(f32), a_im.astype(f32))
    dt = jnp.exp(log_dt.astype(f32))[:, None]
    a_bar = jnp.exp(lam * dt)
    b = lax.complex(b_re.astype(f32), b_im.astype(f32))
    b_bar = ((a_bar - 1.0) / lam)[..., None] * b
    bu = lax.complex(jnp.einsum("gnh,blgh->blgn", b_bar.real, uf),
                     jnp.einsum("gnh,blgh->blgn", b_bar.imag, uf))
    a_seq = jnp.broadcast_to(a_bar[None, None], bu.shape)
    _, states = lax.associative_scan(_ssm_combine, (a_seq, bu), axis=1)
    y = (jnp.einsum("ghn,blgn->blgh", c_re.astype(f32), states.real)
         - jnp.einsum("ghn,blgn->blgh", c_im.astype(f32), states.imag))
    y = y.reshape(bsz, length, SSM_WIDTH) + d_skip.astype(f32) * u.astype(f32)
    y = jax.nn.gelu(y).astype(u.dtype)
    return (y @ w_glu_a) * jax.nn.sigmoid(y @ w_glu_b)


def hier_moe(h, w_route_group, b_route_group, w_route_expert, b_route_expert,
             w_gate, w_up, w_down):
    bsz, length, d = h.shape
    t = bsz * length
    hf = h.reshape(t, d)
    f32 = jnp.float32
    pg = jax.nn.softmax((hf @ w_route_group + b_route_group).astype(f32), axis=-1)
    pg_top, g_idx = lax.top_k(pg, 1)
    le = (hf @ w_route_expert + b_route_expert).astype(f32).reshape(t, N_EXPERT_GROUPS, EXPERTS_PER_GROUP)
    le_sel = jnp.take_along_axis(le, g_idx[:, :, None], axis=1)[:, 0]
    pe = jax.nn.softmax(le_sel, axis=-1)
    pe_top, e_idx = lax.top_k(pe, TOP_K_INNER)
    pe_top = pe_top / jnp.sum(pe_top, axis=-1, keepdims=True)
    weights = pg_top * pe_top
    expert_ids = g_idx * EXPERTS_PER_GROUP + e_idx
    combine = jnp.sum(jax.nn.one_hot(expert_ids, N_EXPERTS, dtype=f32) * weights[..., None], axis=1)
    out = jnp.zeros((t, d), f32)
    for e in range(N_EXPERTS):
        a = jax.nn.silu(hf @ w_gate[e]) * (hf @ w_up[e])
        out = out + combine[:, e:e + 1] * (a @ w_down[e]).astype(f32)
    return out.astype(h.dtype).reshape(bsz, length, d)


def setup_inputs(seed: int = 0) -> dict:
    key = jax.random.key(seed)
    ks = jax.random.split(key, 24)
    f32 = jnp.float32
    nrm = lambda k, shape, scale: jax.random.normal(k, shape, f32) * scale
    L_, D = DEPTH, D_MODEL
    G, N, H = SSM_GROUPS, SSM_STATE, SSM_GROUP
    return {
        "x": nrm(ks[0], (BATCH, SEQ, D), 1.0),
        "norm_mix": 1.0 + nrm(ks[1], (L_, D), 0.01),
        "w_in": nrm(ks[2], (L_, D, IN_COLS), D ** -0.5),
        "conv_w": nrm(ks[3], (L_, CONV_K, 1, CONV_WIDTH), CONV_K ** -0.5),
        "conv_b": nrm(ks[4], (L_, CONV_WIDTH), 0.01),
        "w_conv_out": nrm(ks[5], (L_, CONV_WIDTH, D), CONV_WIDTH ** -0.5),
        "ssm_a_re": -0.5 + nrm(ks[6], (L_, G, N), 0.01),
        "ssm_a_im": jnp.pi * jnp.arange(N, dtype=f32)[None, None, :] + nrm(ks[7], (L_, G, N), 0.01),
        "ssm_log_dt": jax.random.uniform(ks[8], (L_, G), f32, math.log(DT_MIN), math.log(DT_MAX)),
        "ssm_b_re": nrm(ks[9], (L_, G, N, H), (2 * H) ** -0.5),
        "ssm_b_im": nrm(ks[10], (L_, G, N, H), (2 * H) ** -0.5),
        "ssm_c_re": nrm(ks[11], (L_, G, H, N), (2 * N) ** -0.5),
        "ssm_c_im": nrm(ks[12], (L_, G, H, N), (2 * N) ** -0.5),
        "ssm_d": nrm(ks[13], (L_, SSM_WIDTH), 1.0),
        "w_glu_a": nrm(ks[14], (L_, SSM_WIDTH, D), SSM_WIDTH ** -0.5),
        "w_glu_b": nrm(ks[15], (L_, SSM_WIDTH, D), SSM_WIDTH ** -0.5),
        "gate_bias": nrm(ks[16], (L_, N_BRANCHES, D), 0.01),
        "w_o": nrm(ks[17], (L_, D, D), D ** -0.5),
        "norm_ffn": 1.0 + nrm(ks[18], (L_, D), 0.01),
        "w_route_group": nrm(ks[19], (L_, D, N_EXPERT_GROUPS), D ** -0.5),
        "b_route_group": nrm(ks[20], (L_, N_EXPERT_GROUPS), 0.01),
        "w_route_expert": nrm(ks[21], (L_, D, N_EXPERTS), D ** -0.5),
        "b_route_expert": nrm(ks[22], (L_, N_EXPERTS), 0.01),
        "w_gate": nrm(jax.random.fold_in(ks[23], 0), (L_, N_EXPERTS, D, EXPERT_FF), D ** -0.5),
        "w_up": nrm(jax.random.fold_in(ks[23], 1), (L_, N_EXPERTS, D, EXPERT_FF), D ** -0.5),
        "w_down": nrm(jax.random.fold_in(ks[23], 2), (L_, N_EXPERTS, EXPERT_FF, D), EXPERT_FF ** -0.5),
        "norm_final": 1.0 + nrm(jax.random.fold_in(ks[23], 3), (D,), 0.01),
    }


def reference(x, norm_mix, w_in, conv_w, conv_b, w_conv_out, ssm_a_re, ssm_a_im, ssm_log_dt,
              ssm_b_re, ssm_b_im, ssm_c_re, ssm_c_im, ssm_d, w_glu_a, w_glu_b, gate_bias, w_o,
              norm_ffn, w_route_group, b_route_group, w_route_expert, b_route_expert,
              w_gate, w_up, w_down, norm_final):
    bsz, length, d = x.shape
    c0, c1, c2, c3 = CONV_WIDTH, 2 * CONV_WIDTH, 3 * CONV_WIDTH, 3 * CONV_WIDTH + SSM_WIDTH
    for l in range(DEPTH):
        h = rms_norm(x, norm_mix[l])
        p = h @ w_in[l]
        xc, bg, cg, u, gl = p[..., :c0], p[..., c0:c1], p[..., c1:c2], p[..., c2:c3], p[..., c3:]
        gates = jax.nn.sigmoid(gl.reshape(bsz, length, N_BRANCHES, d) + gate_bias[l])
        ya = short_conv_branch(xc, bg, cg, conv_w[l], conv_b[l], w_conv_out[l])
        yb = s5_branch(u, ssm_a_re[l], ssm_a_im[l], ssm_log_dt[l], ssm_b_re[l], ssm_b_im[l],
                       ssm_c_re[l], ssm_c_im[l], ssm_d[l], w_glu_a[l], w_glu_b[l])
        mixed = gates[..., 0, :] * ya + gates[..., 1, :] * yb
        x = x + mixed @ w_o[l]
        h2 = rms_norm(x, norm_ffn[l])
        x = x + hier_moe(h2, w_route_group[l], b_route_group[l], w_route_expert[l],
                         b_route_expert[l], w_gate[l], w_up[l], w_down[l])
    return rms_norm(x, norm_final)
```

```cpp
#include <hip/hip_runtime.h>
#include <stdint.h>

namespace nv {
constexpr int T = 16384, D = 1024, SW = 512, NG = 32, NS = 64, NH = 16, INC = 5632, NE = 32, EFF = 512;
constexpr float EPS = 1e-6f;

__device__ __forceinline__ float wave_sum(float v) {
#pragma unroll
    for (int o = 1; o < 64; o <<= 1) v += __shfl_xor(v, o);
    return v;
}
__device__ __forceinline__ float sigmoidf_(float x) { return 1.f / (1.f + __expf(-x)); }
__device__ __forceinline__ float gelu_tanh(float x) { const float u = 0.7978845608028654f * (x + 0.044715f * x * x * x); return 0.5f * x * (1.f + tanhf(u)); }

__global__ __launch_bounds__(256) void k_rmsnorm(const float* x, const float* g, float* y, int rows) {
    const int row = blockIdx.x * 4 + (threadIdx.x >> 6), lane = threadIdx.x & 63;
    if (row >= rows) return;
    const float4* xr = (const float4*)(x + (size_t)row * D);
    float4 v[4]; float s = 0.f;
#pragma unroll
    for (int j = 0; j < 4; ++j) { v[j] = xr[lane + 64 * j]; s += v[j].x * v[j].x + v[j].y * v[j].y + v[j].z * v[j].z + v[j].w * v[j].w; }
    const float r = rsqrtf(wave_sum(s) * (1.f / D) + EPS);
    float4* yr = (float4*)(y + (size_t)row * D);
#pragma unroll
    for (int j = 0; j < 4; ++j) { const float4 gg = ((const float4*)g)[lane + 64 * j]; yr[lane + 64 * j] = make_float4(v[j].x * r * gg.x, v[j].y * r * gg.y, v[j].z * r * gg.z, v[j].w * r * gg.w); }
}

template <int MODE>
__global__ __launch_bounds__(256) void k_gemm(const float* A, int lda, const int* gather, const int* aoff_dev, const float* B, const float* B2, int ldb,
                                              float* C, int ldc, const int* coff_dev, const float* resid, int M, const int* Mdev, int N, int K) {
    __shared__ float As[16][68];
    __shared__ float Bs[16][64];
    __shared__ float Bs2[16][64];
    if (Mdev) M = *Mdev;
    const int row0 = blockIdx.y * 64, col0 = blockIdx.x * 64;
    if (row0 >= M) return;
    const int aoff = aoff_dev ? *aoff_dev : 0, coff = coff_dev ? *coff_dev : 0;
    const int tid = threadIdx.x, ty = tid >> 4, tx = tid & 15;
    const int lr = tid >> 2, lk = (tid & 3) * 4;
    const int bk = tid >> 4, bn = (tid & 15) * 4;
    int arow = -1;
    if (row0 + lr < M) arow = gather ? gather[row0 + lr] : (aoff + row0 + lr);
    float acc[4][4] = {}, acc2[4][4] = {};
    for (int k0 = 0; k0 < K; k0 += 16) {
        float4 av = make_float4(0.f, 0.f, 0.f, 0.f);
        if (arow >= 0) av = *(const float4*)(A + (size_t)arow * lda + k0 + lk);
        As[lk + 0][lr] = av.x; As[lk + 1][lr] = av.y; As[lk + 2][lr] = av.z; As[lk + 3][lr] = av.w;
        *(float4*)&Bs[bk][bn] = *(const float4*)(B + (size_t)(k0 + bk) * ldb + col0 + bn);
        if (MODE >= 2) *(float4*)&Bs2[bk][bn] = *(const float4*)(B2 + (size_t)(k0 + bk) * ldb + col0 + bn);
        __syncthreads();
#pragma unroll
        for (int k = 0; k < 16; ++k) {
            const float4 a = *(const float4*)&As[k][ty * 4];
            const float4 b = *(const float4*)&Bs[k][tx * 4];
            const float aa[4] = {a.x, a.y, a.z, a.w}, bb[4] = {b.x, b.y, b.z, b.w};
#pragma unroll
            for (int i = 0; i < 4; ++i)
#pragma unroll
                for (int j = 0; j < 4; ++j) acc[i][j] += aa[i] * bb[j];
            if (MODE >= 2) {
                const float4 b2 = *(const float4*)&Bs2[k][tx * 4]; const float cc[4] = {b2.x, b2.y, b2.z, b2.w};
#pragma unroll
                for (int i = 0; i < 4; ++i)
#pragma unroll
                    for (int j = 0; j < 4; ++j) acc2[i][j] += aa[i] * cc[j];
            }
        }
        __syncthreads();
    }
#pragma unroll
    for (int i = 0; i < 4; ++i) {
        const int r = row0 + ty * 4 + i;
        if (r >= M) continue;
        float o[4];
#pragma unroll
        for (int j = 0; j < 4; ++j) {
            float v = acc[i][j];
            if (MODE == 2) v = (v * sigmoidf_(v)) * acc2[i][j];
            if (MODE == 3) v = v * sigmoidf_(acc2[i][j]);
            o[j] = v;
        }
        const size_t ci = (size_t)(coff + r) * ldc + col0 + tx * 4;
        if (MODE == 1) { const float4 rr = *(const float4*)(resid + ci); o[0] += rr.x; o[1] += rr.y; o[2] += rr.z; o[3] += rr.w; }
        *(float4*)(C + ci) = make_float4(o[0], o[1], o[2], o[3]);
    }
}

__global__ __launch_bounds__(256) void k_conv(const float* xc, const float* cg, float* bg_z, const float* cw, const float* cb) {
    const size_t i = (size_t)blockIdx.x * 256 + threadIdx.x;
    const int t = (int)(i / D), c = (int)(i % D);
    float y = cb[c] + cw[2 * D + c] * (cg[i] * xc[i]);
    if (t >= 1) y += cw[1 * D + c] * (cg[i - D] * xc[i - D]);
    if (t >= 2) y += cw[0 * D + c] * (cg[i - 2 * D] * xc[i - 2 * D]);
    bg_z[i] = bg_z[i] * y;
}

struct cplx { float re, im; };
__device__ __forceinline__ cplx cmul(cplx a, cplx b) { return {a.re * b.re - a.im * b.im, a.re * b.im + a.im * b.re}; }

__device__ __forceinline__ void ssm_consts(const float* a_re, const float* a_im, const float* log_dt, int g, int n, cplx& abar, cplx& coef, cplx& a256) {
    const double lr = a_re[g * NS + n], li = a_im[g * NS + n], dt = exp((double)log_dt[g]);
    const double er = exp(lr * dt), cr = er * cos(li * dt), ci = er * sin(li * dt);
    abar = {(float)cr, (float)ci};
    const double nr = cr - 1.0, ni = ci, den = lr * lr + li * li;
    coef = {(float)((nr * lr + ni * li) / den), (float)((ni * lr - nr * li) / den)};
    const double e2 = exp(lr * dt * 256.0);
    a256 = {(float)(e2 * cos(li * dt * 256.0)), (float)(e2 * sin(li * dt * 256.0))};
}

template <int PASS>
__global__ __launch_bounds__(64) void k_ssm(const float* u, const float* a_re, const float* a_im, const float* log_dt, const float* b_re, const float* b_im,
                                            const float* c_re, const float* c_im, const float* dsk, float* E, const float* Cin, float* ys) {
    __shared__ float part[16][65];
    const int g = blockIdx.x, r = blockIdx.y, n = threadIdx.x;
    cplx abar, coef, a256; ssm_consts(a_re, a_im, log_dt, g, n, abar, coef, a256);
    cplx bb[16]; float cre[16], cim[16];
#pragma unroll
    for (int h = 0; h < 16; ++h) {
        bb[h] = cmul(coef, cplx{b_re[(g * NS + n) * NH + h], b_im[(g * NS + n) * NH + h]});
        cre[h] = c_re[(g * NH + h) * NS + n]; cim[h] = c_im[(g * NH + h) * NS + n];
    }
    cplx s = {0.f, 0.f};
    if (PASS == 2) s = {Cin[((size_t)(r * NG + g) * NS + n) * 2], Cin[((size_t)(r * NG + g) * NS + n) * 2 + 1]};
    for (int t = r * 256; t < r * 256 + 256; ++t) {
        const float* ut = u + (size_t)t * SW + g * NH;
        cplx bu = {0.f, 0.f};
#pragma unroll
        for (int h = 0; h < 16; ++h) { const float uv = ut[h]; bu.re += bb[h].re * uv; bu.im += bb[h].im * uv; }
        s = cmul(abar, s); s.re += bu.re; s.im += bu.im;
        if (PASS == 2) {
#pragma unroll
            for (int h = 0; h < 16; ++h) part[h][n] = cre[h] * s.re - cim[h] * s.im;
            __syncthreads();
            const int h = n & 15, q = n >> 4; float y = 0.f;
#pragma unroll
            for (int j = 0; j < 16; ++j) y += part[h][q * 16 + j];
            y += __shfl_xor(y, 16); y += __shfl_xor(y, 32);
            if (q == 0) { const float v = y + dsk[g * NH + h] * ut[h]; ys[(size_t)t * SW + g * NH + h] = gelu_tanh(v); }
            __syncthreads();
        }
    }
    if (PASS == 1) { E[((size_t)(r * NG + g) * NS + n) * 2] = s.re; E[((size_t)(r * NG + g) * NS + n) * 2 + 1] = s.im; }
}
__global__ __launch_bounds__(64) void k_ssm_carry(const float* a_re, const float* a_im, const float* log_dt, const float* E, float* Cin) {
    const int g = blockIdx.x, n = threadIdx.x;
    cplx abar, coef, a256; ssm_consts(a_re, a_im, log_dt, g, n, abar, coef, a256);
    cplx run = {0.f, 0.f};
    for (int r = 0; r < T / 256; ++r) {
        const size_t i = ((size_t)(r * NG + g) * NS + n) * 2;
        Cin[i] = run.re; Cin[i + 1] = run.im;
        run = cmul(a256, run); run.re += E[i]; run.im += E[i + 1];
    }
}

template <int ADD>
__global__ __launch_bounds__(256) void k_mix(const float* gl, const float* bias, const float* y, float* m) {
    const size_t i = (size_t)blockIdx.x * 256 + threadIdx.x; const int c = (int)(i % D);
    const float v = sigmoidf_(gl[i] + bias[c]) * y[i];
    m[i] = ADD ? m[i] + v : v;
}

__global__ __launch_bounds__(256) void k_route(const float* h2, const float* wrg, const float* brg, const float* wre, const float* bre,
                                               int* cnt, int* list, int* tok_e, int* tok_pos, float* tok_w) {
    const int t = blockIdx.x * 4 + (threadIdx.x >> 6), lane = threadIdx.x & 63;
    float acc[36];
#pragma unroll
    for (int j = 0; j < 36; ++j) acc[j] = 0.f;
    for (int k = lane; k < D; k += 64) {
        const float hv = h2[(size_t)t * D + k];
#pragma unroll
        for (int j = 0; j < 4; ++j) acc[j] += hv * wrg[k * 4 + j];
#pragma unroll
        for (int j = 0; j < 32; ++j) acc[4 + j] += hv * wre[k * 32 + j];
    }
#pragma unroll
    for (int j = 0; j < 36; ++j) acc[j] = wave_sum(acc[j]);
    if (lane == 0) {
        float lg[4]; int gi = 0; float lmax;
#pragma unroll
        for (int j = 0; j < 4; ++j) { lg[j] = acc[j] + brg[j]; }
        lmax = lg[0];
#pragma unroll
        for (int j = 1; j < 4; ++j) if (lg[j] > lmax) { lmax = lg[j]; gi = j; }
        float se = 0.f;
#pragma unroll
        for (int j = 0; j < 4; ++j) se += __expf(lg[j] - lmax);
        const float pg = 1.f / se;
        float v1 = -3.0e38f, v2 = -3.0e38f; int i1 = 0, i2 = 0;
#pragma unroll
        for (int j = 0; j < 8; ++j) { float v = 0.f;
#pragma unroll
            for (int q = 0; q < 4; ++q) if (q == gi) v = acc[4 + q * 8 + j] + bre[q * 8 + j];
            if (v > v1) { v2 = v1; i2 = i1; v1 = v; i1 = j; } else if (v > v2) { v2 = v; i2 = j; } }
        const float w1 = 1.f / (1.f + __expf(v2 - v1)), w2 = 1.f - w1;
        const int e1 = gi * 8 + i1, e2 = gi * 8 + i2;
        const int p1 = atomicAdd(&cnt[e1], 1), p2 = atomicAdd(&cnt[e2], 1);
        list[e1 * T + p1] = t; list[e2 * T + p2] = t;
        tok_e[t * 2] = e1; tok_e[t * 2 + 1] = e2; tok_pos[t * 2] = p1; tok_pos[t * 2 + 1] = p2;
        tok_w[t * 2] = pg * w1; tok_w[t * 2 + 1] = pg * w2;
    }
}
__global__ void k_offsets(const int* cnt, int* off) { if (threadIdx.x == 0) { int s = 0; for (int e = 0; e < NE; ++e) { off[e] = s; s += cnt[e]; } } }

__global__ __launch_bounds__(256) void k_final(float* out, const float* Y, const int* off, const int* tok_e, const int* tok_pos, const float* tok_w, const float* g) {
    const int t = blockIdx.x * 4 + (threadIdx.x >> 6), lane = threadIdx.x & 63;
    const int s1 = off[tok_e[t * 2]] + tok_pos[t * 2], s2 = off[tok_e[t * 2 + 1]] + tok_pos[t * 2 + 1];
    const float w1 = tok_w[t * 2], w2 = tok_w[t * 2 + 1];
    float4* xr = (float4*)(out + (size_t)t * D);
    const float4* y1 = (const float4*)(Y + (size_t)s1 * D); const float4* y2 = (const float4*)(Y + (size_t)s2 * D);
    float4 v[4]; float s = 0.f;
#pragma unroll
    for (int j = 0; j < 4; ++j) { const float4 a = xr[lane + 64 * j], b = y1[lane + 64 * j], c = y2[lane + 64 * j];
        v[j] = make_float4(a.x + w1 * b.x + w2 * c.x, a.y + w1 * b.y + w2 * c.y, a.z + w1 * b.z + w2 * c.z, a.w + w1 * b.w + w2 * c.w);
        s += v[j].x * v[j].x + v[j].y * v[j].y + v[j].z * v[j].z + v[j].w * v[j].w; }
    const float r = rsqrtf(wave_sum(s) * (1.f / D) + EPS);
#pragma unroll
    for (int j = 0; j < 4; ++j) { const float4 gg = ((const float4*)g)[lane + 64 * j]; xr[lane + 64 * j] = make_float4(v[j].x * r * gg.x, v[j].y * r * gg.y, v[j].z * r * gg.z, v[j].w * r * gg.w); }
}
}

#define LAS __attribute__((address_space(3)))
typedef unsigned short bf16_t;
typedef short bf16x8 __attribute__((ext_vector_type(8)));
typedef float f32x4 __attribute__((ext_vector_type(4)));
typedef float f32x16 __attribute__((ext_vector_type(16)));
typedef unsigned u32x4 __attribute__((ext_vector_type(4)));
typedef unsigned u32x2 __attribute__((ext_vector_type(2)));

constexpr int T = 16384, D = 1024, SW = 512, NG = 32, NS = 64, NH = 16, INC = 5632, NE = 32, EFF = 512;
constexpr float EPS = 1e-6f;

__device__ __forceinline__ unsigned cvt_pk_bf16(float lo, float hi) { unsigned r; asm volatile("v_cvt_pk_bf16_f32 %0, %1, %2" : "=v"(r) : "v"(lo), "v"(hi)); return r; }
__device__ __forceinline__ float bf_lo(unsigned w) { return __uint_as_float(w << 16); }
__device__ __forceinline__ float bf_hi(unsigned w) { return __uint_as_float(w & 0xffff0000u); }
__device__ __forceinline__ float fsigmoid(float x) { return __builtin_amdgcn_rcpf(1.f + __builtin_amdgcn_exp2f(-1.4426950408889634f * x)); }
__device__ __forceinline__ float fsilu(float x) { return x * fsigmoid(x); }
__device__ __forceinline__ float fgelu_tanh(float x) { const float u = 0.7978845608028654f * (x + 0.044715f * x * x * x); return x * fsigmoid(2.f * u); }
__device__ __forceinline__ float wave_sum64(float v) {
#pragma unroll
    for (int o = 1; o < 64; o <<= 1) v += __shfl_xor(v, o);
    return v;
}

namespace pg8 {
constexpr int BM = 256, BK = 64, HALF = 128, HTB = HALF * BK * 2, STAGE_BYTES = 8 * HTB, NXCD = 8, WGM = 8;
__host__ __device__ __forceinline__ int lds_byte(int r, int c) { const int st = (r >> 4) * 2 + (c >> 5), rr = r & 15, cc = c & 31, ob = rr * 64 + cc * 2; return st * 1024 + (ob ^ (((ob >> 9) & 1) << 5)); }
__host__ __device__ __forceinline__ void stage_rc(int b, int& R, int& C) { const int st = b / 1024, sb = b % 1024, swz = sb ^ (((sb >> 9) & 1) << 5); R = (st >> 1) * 16 + swz / 64; C = (st & 1) * 32 + (swz % 64) / 2; }
__host__ __device__ __forceinline__ int perm32(int rho) { const int n = rho >> 4, i = rho & 15; return 8 * (i >> 2) + 4 * n + (i & 3); }

struct Unit { int pm, pn, e, nrow, srow; };

__device__ __forceinline__ void tile_map(int L, int nM, int nN, int& pm, int& pn) {
    const int nwg = nM * nN; int wgid = L;
    { const int q = nwg / NXCD, r = nwg % NXCD, xcd = wgid % NXCD, off = wgid / NXCD; wgid = (xcd < r ? xcd * (q + 1) : r * (q + 1) + (xcd - r) * q) + off; }
    const int nig = WGM * nN, gid = wgid / nig, fm = gid * WGM, gsz = (nM - fm) < WGM ? (nM - fm) : WGM;
    pm = fm + ((wgid % nig) % gsz); pn = (wgid % nig) / gsz;
}
struct DenseOrder {
    const char* A; const char* Bt; int K, nM, nNt, sub, G, c;
    __device__ __forceinline__ bool next(int i, Unit& u) const {
        const int L = (i / sub) * G + c; if (L >= nM * nNt) return false;
        int pm, pn; tile_map(L, nM, nNt, pm, pn); u.pm = pm; u.pn = pn * sub + (i % sub); u.e = 0; u.nrow = 256; u.srow = 0; return true;
    }
    __device__ __forceinline__ const char* a_base(const Unit& u) const { return A + (size_t)u.pm * (size_t)(BM * 2) * K; }
    __device__ __forceinline__ const char* b_base(const Unit& u) const { return Bt + (size_t)u.pn * (size_t)(BM * 2) * K; }
    __device__ __forceinline__ unsigned a_row(const Unit&, int r) const { return (unsigned)r; }
};
struct MoEOrder {
    const LAS int* tb; const LAS int* lc; const int* list; const char* A; const char* Bt; int K; size_t bstride; int G, c; bool gather;
    __device__ __forceinline__ bool next(int i, Unit& u) const {
        const int L = i * G + c; const int ntile = tb[32]; if (L >= ntile * 4) return false;
        const int tt = L >> 2; int e = 0;
#pragma unroll 1
        for (int q = 1; q < 32; ++q) if (tb[q] <= tt) e = q;
        e = __builtin_amdgcn_readfirstlane(e);
        u.e = e; u.pm = tt - tb[e]; u.pn = L & 3; const int rem = lc[e] - 256 * u.pm; u.nrow = rem < 256 ? rem : 256; u.srow = 256 * tt; return true;
    }
    __device__ __forceinline__ const char* a_base(const Unit& u) const { return gather ? A : A + (size_t)u.srow * 2 * K; }
    __device__ __forceinline__ const char* b_base(const Unit& u) const { return Bt + (size_t)u.e * bstride + (size_t)u.pn * (size_t)(BM * 2) * K; }
    __device__ __forceinline__ unsigned a_row(const Unit& u, int r) const { return r < u.nrow ? (unsigned)list[u.e * T + 256 * u.pm + r] : 0u; }
};

template <class Epi, class Sched, bool GATHER, bool ALIGN_EPI>
__device__ __forceinline__ void gemm_phase(LAS unsigned char* lds, const int K, const Sched& S, const Epi& E) {
    const int tid = threadIdx.x, wid = __builtin_amdgcn_readfirstlane(tid >> 6), lane = tid & 63, wr = wid >> 2, wc = wid & 3, fr = lane & 15, fq = lane >> 4;
    const int nt = K / BK;
    unsigned voffB[2], vA[2][2], nvA[2][2]; int Rr[2], Cc[2];
#pragma unroll
    for (int i = 0; i < 2; ++i) { int R, C; stage_rc(tid * 16 + i * 8192, R, C); const int Rb = Epi::PERM ? ((R & ~31) + perm32(R & 31)) : R;
        Rr[i] = R; Cc[i] = C; voffB[i] = (unsigned)(Rb * K + C) * 2u; }
    const size_t kstep = (size_t)(BK * 2);
    const size_t hstep = (size_t)HALF * K * 2;
    const unsigned ldsw = (unsigned)wid * 1024u;
    const int aoff = lds_byte(wr * 64 + fr, fq * 8), boff = lds_byte(wc * 32 + fr, fq * 8);
#define PG8_SA(b, h) (((b) * 2 + (h)) * HTB)
#define PG8_SB(b, h) ((4 + (b) * 2 + (h)) * HTB)
#define PG8_STAGE(bufoff, gbase, voff) do { _Pragma("unroll") for (int _i = 0; _i < 2; ++_i) \
        __builtin_amdgcn_global_load_lds((const unsigned*)((const char*)(gbase) + (voff)[_i]), (LAS unsigned*)(lds + (bufoff) + ldsw + _i * 8192), 16, 0, 0); } while (0)
#define PG8_LDA(dst, b, h) do { _Pragma("unroll") for (int m = 0; m < 4; ++m) _Pragma("unroll") for (int k = 0; k < 2; ++k) dst[m][k] = *(const LAS bf16x8*)(lds + PG8_SA(b, h) + aoff + m * 2048 + k * 1024); } while (0)
#define PG8_LDB(dst, b, h) do { _Pragma("unroll") for (int n = 0; n < 2; ++n) _Pragma("unroll") for (int k = 0; k < 2; ++k) dst[n][k] = *(const LAS bf16x8*)(lds + PG8_SB(b, h) + boff + n * 2048 + k * 1024); } while (0)
#define PG8_MMA(ai, bj, At, Bt) do { __builtin_amdgcn_s_setprio(1); _Pragma("unroll") for (int m = 0; m < 4; ++m) _Pragma("unroll") for (int n = 0; n < 2; ++n) _Pragma("unroll") for (int k = 0; k < 2; ++k) \
        acc[ai][bj][m][n] = __builtin_amdgcn_mfma_f32_16x16x32_bf16(Bt[n][k], At[m][k], acc[ai][bj][m][n], 0, 0, 0); __builtin_amdgcn_s_setprio(0); } while (0)
#define PG8_WAIT_V(n) asm volatile("s_waitcnt vmcnt(" #n ")" ::: "memory")
#define PG8_WAIT_L(n) asm volatile("s_waitcnt lgkmcnt(" #n ")" ::: "memory")
#define PG8_BAR __builtin_amdgcn_s_barrier()
#define PG8_SCHED __builtin_amdgcn_sched_barrier(0)
    Unit cur, nxt; int ui = 0;
    if (!S.next(0, cur)) return;
#pragma unroll
    for (int h = 0; h < 2; ++h)
#pragma unroll
        for (int i = 0; i < 2; ++i) vA[h][i] = (unsigned)((GATHER ? S.a_row(cur, h * HALF + Rr[i]) : (unsigned)(h * HALF + Rr[i])) * (unsigned)K + (unsigned)Cc[i]) * 2u;
    f32x4 acc[2][2][4][2];
#pragma unroll
    for (int a = 0; a < 2; ++a)
#pragma unroll
        for (int b = 0; b < 2; ++b)
#pragma unroll
            for (int m = 0; m < 4; ++m)
#pragma unroll
                for (int n = 0; n < 2; ++n) acc[a][b][m][n] = (f32x4){0.f, 0.f, 0.f, 0.f};
    bf16x8 At[4][2], B0[2][2], B1[2][2];
    const char* cA = S.a_base(cur); const char* cB = S.b_base(cur);
    PG8_STAGE(PG8_SB(0, 0), cB, voffB); PG8_STAGE(PG8_SB(0, 1), cB + hstep, voffB); PG8_STAGE(PG8_SA(0, 0), cA, vA[0]); PG8_STAGE(PG8_SA(0, 1), cA, vA[1]);
    if (wr == 1) PG8_BAR;
    PG8_WAIT_V(2); PG8_BAR;
    PG8_STAGE(PG8_SB(1, 0), cB + kstep, voffB); PG8_STAGE(PG8_SA(1, 0), cA + kstep, vA[0]); PG8_STAGE(PG8_SB(1, 1), cB + hstep + kstep, voffB);
    PG8_WAIT_V(6); PG8_BAR;
    for (;;) {
        const bool has_next = S.next(ui + 1, nxt);
        const char* nA = has_next ? S.a_base(nxt) : cA; const char* nB = has_next ? S.b_base(nxt) : cB;
        if constexpr (GATHER) {
#pragma unroll
            for (int h = 0; h < 2; ++h)
#pragma unroll
                for (int i = 0; i < 2; ++i) nvA[h][i] = has_next ? (unsigned)(S.a_row(nxt, h * HALF + Rr[i]) * (unsigned)K + (unsigned)Cc[i]) * 2u : vA[h][i];
        }
        for (int t = 0; t < nt; t += 2) {
            const bool last = (t == nt - 2);
            const char* a1 = cA + (size_t)(t + 1) * kstep;
            const char* a2 = last ? nA : cA + (size_t)(t + 2) * kstep; const char* b2 = last ? nB : cB + (size_t)(t + 2) * kstep;
            const char* a3 = a2 + kstep; const char* b3 = b2 + kstep;
            unsigned x0[2], x1[2];
            if constexpr (GATHER) { x0[0] = last ? nvA[0][0] : vA[0][0]; x0[1] = last ? nvA[0][1] : vA[0][1]; x1[0] = last ? nvA[1][0] : vA[1][0]; x1[1] = last ? nvA[1][1] : vA[1][1]; }
            else { x0[0] = vA[0][0]; x0[1] = vA[0][1]; x1[0] = vA[1][0]; x1[1] = vA[1][1]; }
            PG8_LDB(B0, 0, 0); PG8_LDB(B1, 0, 1); PG8_SCHED; PG8_LDA(At, 0, 0); PG8_STAGE(PG8_SA(1, 1), a1, vA[1]);
            PG8_WAIT_V(8); PG8_WAIT_L(0); PG8_BAR; PG8_MMA(0, 0, At, B0); PG8_MMA(0, 1, At, B1); PG8_BAR; PG8_SCHED;
            PG8_LDA(At, 0, 1); PG8_STAGE(PG8_SB(0, 0), b2, voffB); PG8_STAGE(PG8_SB(0, 1), b2 + hstep, voffB); PG8_STAGE(PG8_SA(0, 0), a2, x0);
            PG8_WAIT_V(8); PG8_WAIT_L(0); PG8_BAR; PG8_MMA(1, 0, At, B0); PG8_MMA(1, 1, At, B1); PG8_BAR; PG8_SCHED;
            PG8_LDB(B0, 1, 0); PG8_LDB(B1, 1, 1); PG8_SCHED; PG8_LDA(At, 1, 0); PG8_STAGE(PG8_SA(0, 1), a2, x1);
            PG8_WAIT_V(8); PG8_WAIT_L(0); PG8_BAR; PG8_MMA(0, 0, At, B0); PG8_MMA(0, 1, At, B1); PG8_BAR; PG8_SCHED;
            PG8_LDA(At, 1, 1); PG8_STAGE(PG8_SB(1, 0), b3, voffB); PG8_STAGE(PG8_SB(1, 1), b3 + hstep, voffB); PG8_STAGE(PG8_SA(1, 0), a3, x0);
            PG8_WAIT_V(8); PG8_WAIT_L(0); PG8_BAR; PG8_MMA(1, 0, At, B0); PG8_MMA(1, 1, At, B1); PG8_BAR; PG8_SCHED;
        }
        if constexpr (ALIGN_EPI) { if (wr == 0) PG8_BAR; }
        E(acc, cur, wr, wc, fr, fq);
        if (!has_next) break;
#pragma unroll
        for (int a = 0; a < 2; ++a)
#pragma unroll
            for (int b = 0; b < 2; ++b)
#pragma unroll
                for (int m = 0; m < 4; ++m)
#pragma unroll
                    for (int n = 0; n < 2; ++n) acc[a][b][m][n] = (f32x4){0.f, 0.f, 0.f, 0.f};
        cur = nxt; cA = nA; cB = nB; ++ui;
        if constexpr (GATHER) { vA[0][0] = nvA[0][0]; vA[0][1] = nvA[0][1]; vA[1][0] = nvA[1][0]; vA[1][1] = nvA[1][1]; }
        if constexpr (ALIGN_EPI) { if (wr == 1) PG8_BAR; }
    }
    PG8_WAIT_V(0);
    if constexpr (!ALIGN_EPI) { if (wr == 0) PG8_BAR; }
    PG8_BAR;
#undef PG8_SA
#undef PG8_SB
#undef PG8_STAGE
#undef PG8_LDA
#undef PG8_LDB
#undef PG8_MMA
#undef PG8_WAIT_V
#undef PG8_WAIT_L
#undef PG8_BAR
#undef PG8_SCHED
}
}

#define EPI_ROWS(ai, m) (u.pm * 256 + (ai) * 128 + wr * 64 + (m) * 16 + fr)
__device__ __forceinline__ u32x4 pack8(const f32x4 a, const f32x4 b) { u32x4 w; w.x = cvt_pk_bf16(a[0], a[1]); w.y = cvt_pk_bf16(a[2], a[3]); w.z = cvt_pk_bf16(b[0], b[1]); w.w = cvt_pk_bf16(b[2], b[3]); return w; }
__device__ __forceinline__ void unpack8(const u32x4 w, f32x4& a, f32x4& b) { a = (f32x4){bf_lo(w.x), bf_hi(w.x), bf_lo(w.y), bf_hi(w.y)}; b = (f32x4){bf_lo(w.z), bf_hi(w.z), bf_lo(w.w), bf_hi(w.w)}; }

struct EpiWin {
    static constexpr bool PERM = true;
    const float* rstd; bf16_t* v; bf16_t* bg; bf16_t* ub; bf16_t* gates; const float* gate_bias;
    __device__ __forceinline__ void operator()(const f32x4 (&acc)[2][2][4][2], const pg8::Unit& u, int wr, int wc, int fr, int fq) const {
        if (u.pn < 8) {
#pragma unroll
            for (int ai = 0; ai < 2; ++ai)
#pragma unroll
                for (int m = 0; m < 4; ++m) { const int row = EPI_ROWS(ai, m); const float rs = rstd[row], rs2 = rs * rs;
                    const f32x4 a0 = acc[ai][0][m][0] * acc[ai][1][m][0] * rs2, a1 = acc[ai][0][m][1] * acc[ai][1][m][1] * rs2;
                    *(u32x4*)(v + (size_t)row * D + 128 * u.pn + 32 * wc + 8 * fq) = pack8(a0, a1); }
        } else if (u.pn < 14) {
            bf16_t* base; int ld, c0;
            if (u.pn < 12) { base = bg; ld = D; c0 = 256 * (u.pn - 8); } else { base = ub; ld = SW; c0 = 256 * (u.pn - 12); }
#pragma unroll
            for (int ai = 0; ai < 2; ++ai)
#pragma unroll
                for (int m = 0; m < 4; ++m) { const int row = EPI_ROWS(ai, m); const float rs = rstd[row];
#pragma unroll
                    for (int bj = 0; bj < 2; ++bj) *(u32x4*)(base + (size_t)row * ld + c0 + 128 * bj + 32 * wc + 8 * fq) = pack8(acc[ai][bj][m][0] * rs, acc[ai][bj][m][1] * rs); }
        } else {
            const int c0 = 256 * (u.pn - 14) + 32 * wc + 8 * fq;
            f32x4 bv[2][2];
#pragma unroll
            for (int bj = 0; bj < 2; ++bj)
#pragma unroll
                for (int n = 0; n < 2; ++n) bv[bj][n] = *(const f32x4*)(gate_bias + c0 + 128 * bj + 4 * n);
#pragma unroll
            for (int ai = 0; ai < 2; ++ai)
#pragma unroll
                for (int m = 0; m < 4; ++m) { const int row = EPI_ROWS(ai, m); const float rs = rstd[row];
#pragma unroll
                    for (int bj = 0; bj < 2; ++bj) { f32x4 g0 = acc[ai][bj][m][0] * rs + bv[bj][0], g1 = acc[ai][bj][m][1] * rs + bv[bj][1];
#pragma unroll
                        for (int j = 0; j < 4; ++j) { g0[j] = fsigmoid(g0[j]); g1[j] = fsigmoid(g1[j]); }
                        *(u32x4*)(gates + (size_t)row * 2048 + c0 + 128 * bj) = pack8(g0, g1); } }
        }
    }
};
struct EpiGlu {
    static constexpr bool PERM = true;
    const bf16_t* gates; bf16_t* mb;
    __device__ __forceinline__ void operator()(const f32x4 (&acc)[2][2][4][2], const pg8::Unit& u, int wr, int wc, int fr, int fq) const {
        const int col = 128 * u.pn + 32 * wc + 8 * fq;
#pragma unroll
        for (int ai = 0; ai < 2; ++ai)
#pragma unroll
            for (int m = 0; m < 4; ++m) { const int row = EPI_ROWS(ai, m);
                f32x4 g0, g1; unpack8(*(const u32x4*)(gates + (size_t)row * 2048 + 1024 + col), g0, g1);
                f32x4 y0 = acc[ai][0][m][0], y1 = acc[ai][0][m][1]; const f32x4 b0 = acc[ai][1][m][0], b1 = acc[ai][1][m][1];
#pragma unroll
                for (int j = 0; j < 4; ++j) { y0[j] = y0[j] * fsigmoid(b0[j]) * g0[j]; y1[j] = y1[j] * fsigmoid(b1[j]) * g1[j]; }
                *(u32x4*)(mb + (size_t)row * D + col) = pack8(y0, y1); }
    }
};
struct EpiMix {
    static constexpr bool PERM = true;
    const bf16_t* gates; const bf16_t* mb; bf16_t* mixed;
    __device__ __forceinline__ void operator()(const f32x4 (&acc)[2][2][4][2], const pg8::Unit& u, int wr, int wc, int fr, int fq) const {
#pragma unroll
        for (int ai = 0; ai < 2; ++ai)
#pragma unroll
            for (int m = 0; m < 4; ++m) { const int row = EPI_ROWS(ai, m);
#pragma unroll
                for (int bj = 0; bj < 2; ++bj) { const int col = 256 * u.pn + 128 * bj + 32 * wc + 8 * fq;
                    f32x4 g0, g1, m0, m1; unpack8(*(const u32x4*)(gates + (size_t)row * 2048 + col), g0, g1); unpack8(*(const u32x4*)(mb + (size_t)row * D + col), m0, m1);
                    *(u32x4*)(mixed + (size_t)row * D + col) = pack8(g0 * acc[ai][bj][m][0] + m0, g1 * acc[ai][bj][m][1] + m1); } }
    }
};
struct EpiX1 {
    static constexpr bool PERM = false;
    const float* x; float* x1; bf16_t* x1b;
    __device__ __forceinline__ void operator()(const f32x4 (&acc)[2][2][4][2], const pg8::Unit& u, int wr, int wc, int fr, int fq) const {
#pragma unroll
        for (int ai = 0; ai < 2; ++ai)
#pragma unroll
            for (int m = 0; m < 4; ++m) { const int row = EPI_ROWS(ai, m);
#pragma unroll
                for (int bj = 0; bj < 2; ++bj)
#pragma unroll
                    for (int n = 0; n < 2; ++n) { const size_t o = (size_t)row * D + 256 * u.pn + 128 * bj + 32 * wc + 16 * n + 4 * fq;
                        const f32x4 r = *(const f32x4*)(x + o) + acc[ai][bj][m][n]; *(f32x4*)(x1 + o) = r;
                        u32x2 w; w.x = cvt_pk_bf16(r[0], r[1]); w.y = cvt_pk_bf16(r[2], r[3]); *(u32x2*)(x1b + o) = w; } }
    }
};
struct EpiUp {
    static constexpr bool PERM = true;
    const int* list; const float* rstd2; bf16_t* hmid;
    __device__ __forceinline__ void operator()(const f32x4 (&acc)[2][2][4][2], const pg8::Unit& u, int wr, int wc, int fr, int fq) const {
        const int col = 128 * u.pn + 32 * wc + 8 * fq;
#pragma unroll
        for (int ai = 0; ai < 2; ++ai)
#pragma unroll
            for (int m = 0; m < 4; ++m) { const int r = ai * 128 + wr * 64 + m * 16 + fr; const bool ok = r < u.nrow;
                const int tok = ok ? list[u.e * T + 256 * u.pm + r] : 0; const float rs = ok ? rstd2[tok] : 0.f;
                f32x4 g0 = acc[ai][0][m][0] * rs, g1 = acc[ai][0][m][1] * rs; const f32x4 u0 = acc[ai][1][m][0] * rs, u1 = acc[ai][1][m][1] * rs;
#pragma unroll
                for (int j = 0; j < 4; ++j) { g0[j] = fsilu(g0[j]) * u0[j]; g1[j] = fsilu(g1[j]) * u1[j]; }
                *(u32x4*)(hmid + (size_t)(u.srow + r) * EFF + col) = pack8(g0, g1); }
    }
};
struct EpiDown {
    static constexpr bool PERM = true;
    bf16_t* Y;
    __device__ __forceinline__ void operator()(const f32x4 (&acc)[2][2][4][2], const pg8::Unit& u, int wr, int wc, int fr, int fq) const {
#pragma unroll
        for (int ai = 0; ai < 2; ++ai)
#pragma unroll
            for (int m = 0; m < 4; ++m) { const int r = ai * 128 + wr * 64 + m * 16 + fr;
#pragma unroll
                for (int bj = 0; bj < 2; ++bj) *(u32x4*)(Y + (size_t)(u.srow + r) * D + 256 * u.pn + 128 * bj + 32 * wc + 8 * fq) = pack8(acc[ai][bj][m][0], acc[ai][bj][m][1]); }
    }
};

constexpr size_t MiB = 1u << 20;
constexpr size_t WS_CTL = 0, CTL_BYTES = 64 * 1024;
constexpr size_t WS_WIN = 1 * MiB, WS_WC = 12 * MiB, WS_WGLU = 14 * MiB, WS_WO = 16 * MiB;
constexpr size_t WS_RSTD1 = 18 * MiB, WS_RSTD2 = WS_RSTD1 + 64 * 1024, WS_TABA = WS_RSTD2 + 64 * 1024, WS_TABA256 = WS_TABA + 32 * 1024, WS_BBT = WS_TABA256 + 32 * 1024,
                 WS_CT = WS_BBT + 128 * 1024, WS_WRT = WS_CT + 128 * 1024, WS_E = 19 * MiB;
constexpr size_t WS_XB = 20 * MiB, WS_Z = 20 * MiB, WS_WD = 20 * MiB;
constexpr size_t WS_V = 52 * MiB, WS_MIXED = 52 * MiB, WS_Y = 52 * MiB;
constexpr size_t WS_BG = 84 * MiB, WS_MB = 84 * MiB, WS_X1B = 84 * MiB;
constexpr size_t WS_UB = 116 * MiB;
constexpr size_t WS_GATES = 132 * MiB, WS_WGU = 132 * MiB;
constexpr size_t WS_YS = 196 * MiB;
constexpr size_t WS_TOK = 212 * MiB, WS_LIST = 214 * MiB, WS_HMID = 216 * MiB, WS_END = 256 * MiB;
constexpr int CW_CNT = 64;
constexpr int CW_BAR = 4096;
constexpr int RING_BYTES = 131072, MISC_OFF = RING_BYTES, LDS_BYTES = 147456;

#define XB_TMO      128
#define XB_XCNT(j)  (256  + 64 * (j))
#define XB_XSUB(j)  (1280 + 64 * (j))
#define XB_XGEN(j)  (2304 + 64 * (j))
#define XB_TOP      3328
#define XB_TOPGEN   3392
#define XCD_BAR_WORDS 3456
#define XB_SPIN_CAP (1u << 18)
__device__ __forceinline__ unsigned xb_ld(unsigned* p)              { return __hip_atomic_load(p, __ATOMIC_RELAXED, __HIP_MEMORY_SCOPE_AGENT); }
__device__ __forceinline__ unsigned xb_add(unsigned* p, unsigned v) { return __hip_atomic_fetch_add(p, v, __ATOMIC_RELAXED, __HIP_MEMORY_SCOPE_AGENT); }
__device__ __forceinline__ unsigned xb_xcc_id() { return (unsigned)__builtin_amdgcn_s_getreg((3 << 11) | 20) & 0xFu; }
#define XB_SPIN(cond, bar) do { unsigned _sp = 0; while (cond) { __builtin_amdgcn_s_sleep(1); \
    if ((++_sp & 255u) == 0u) { if (xb_ld(&(bar)[XB_TMO])) break; if (_sp > XB_SPIN_CAP) { atomicAdd(&(bar)[XB_TMO], 1u); break; } } } } while (0)
struct XcdBarrier { unsigned* bar; unsigned x; volatile LAS unsigned* st; };
__device__ __forceinline__ XcdBarrier xcd_barrier_post(unsigned* bar, volatile LAS unsigned* st) {
    XcdBarrier b; b.bar = bar; b.x = xb_xcc_id(); b.st = st;
    if (threadIdx.x == 0) (void)xb_add(&bar[XB_XCNT(b.x)], 1u);
    return b;
}
__device__ __forceinline__ void xcd_barrier_complete(unsigned* bar, unsigned x, unsigned& nloc, unsigned& nx) {
    const unsigned G = gridDim.x * gridDim.y * gridDim.z;
    unsigned sum, cnt, mine, sp = 0u;
    for (;;) {
        sum = 0u; cnt = 0u; mine = 0u;
#pragma unroll
        for (unsigned j = 0; j < 16; ++j) { const unsigned c = xb_ld(&bar[XB_XCNT(j)]); sum += c; cnt += (c > 0u) ? 1u : 0u; mine = (j == x) ? c : mine; }
        if (sum == G) break;
        __builtin_amdgcn_s_sleep(1);
        if ((++sp & 255u) == 0u) { if (xb_ld(&bar[XB_TMO])) break; if (sp > XB_SPIN_CAP) { atomicAdd(&bar[XB_TMO], 1u); break; } }
    }
    nloc = mine > 0u ? mine : 1u; nx = cnt > 0u ? cnt : 1u;
}
__device__ __forceinline__ void xcd_barrier(const XcdBarrier& b) {
    asm volatile("s_waitcnt vmcnt(0)" ::: "memory");
    __syncthreads();
    if (threadIdx.x == 0) {
        unsigned* bar = b.bar;
        __builtin_amdgcn_s_waitcnt(0);
        unsigned nloc = b.st[0], nx = b.st[1];
        if (nloc == 0u) { xcd_barrier_complete(bar, b.x, nloc, nx); b.st[0] = nloc; b.st[1] = nx; }
        const unsigned old = xb_add(&bar[XB_XSUB(b.x)], 1u);
        const unsigned gen = old / nloc;
        if (old + 1u == (gen + 1u) * nloc) {
            __builtin_amdgcn_fence(__ATOMIC_RELEASE, "agent");
            asm volatile("s_waitcnt vmcnt(0)" ::: "memory");
            const unsigned og = xb_add(&bar[XB_TOP], 1u);
            const unsigned tg = og / nx;
            if (og + 1u == (tg + 1u) * nx) xb_add(&bar[XB_TOPGEN], 1u);
            else XB_SPIN(xb_ld(&bar[XB_TOPGEN]) == tg, bar);
            __builtin_amdgcn_fence(__ATOMIC_ACQUIRE, "agent");
            xb_add(&bar[XB_XGEN(b.x)], 1u);
            asm volatile("s_waitcnt vmcnt(0)" ::: "memory");
        } else {
            XB_SPIN(xb_ld(&bar[XB_XGEN(b.x)]) == gen, bar);
            __builtin_amdgcn_fence(__ATOMIC_ACQUIRE, "agent");
            asm volatile("s_waitcnt vmcnt(0)" ::: "memory");
        }
    }
    __syncthreads();
}

struct Args { const float* in[27]; float* out; unsigned char* ws; int ph_lo, ph_hi, use_bar, pad; };
struct Frame {
    LAS unsigned char* lds; volatile LAS unsigned* MISC; unsigned* ctl; unsigned char* ws;
    int tid, lane, wave, G;
};

__device__ __forceinline__ void tr_item(const float* src, int ld, int col0, int k0, const float* scale, bf16_t* dst, size_t drow0, int Kdst, LAS float* scr, int lane) {
#pragma unroll 8
    for (int i = 0; i < 32; ++i) { const int kk = 2 * i + (lane >> 5); float v = src[(size_t)(k0 + kk) * ld + col0 + (lane & 31)]; if (scale) v *= scale[k0 + kk]; scr[kk * 33 + (lane & 31)] = v; }
    asm volatile("s_waitcnt lgkmcnt(0)" ::: "memory");
    const int c = lane & 7;
#pragma unroll
    for (int j = 0; j < 4; ++j) { const int n = (lane >> 3) + 8 * j; const LAS float* s = scr + (8 * c) * 33 + n;
        u32x4 o; o.x = cvt_pk_bf16(s[0 * 33], s[1 * 33]); o.y = cvt_pk_bf16(s[2 * 33], s[3 * 33]); o.z = cvt_pk_bf16(s[4 * 33], s[5 * 33]); o.w = cvt_pk_bf16(s[6 * 33], s[7 * 33]);
        *(u32x4*)(dst + (drow0 + n) * (size_t)Kdst + k0 + 8 * c) = o; }
    asm volatile("s_waitcnt lgkmcnt(0)" ::: "memory");
}

__device__ __forceinline__ void p0_prologue(const Frame& F, const Args& a) {
    LAS float* scr = (LAS float*)(F.lds + F.wave * 16384);
    const int gw = blockIdx.x * 8 + F.wave, NGW = F.G * 8;
    bf16_t* Win_t = (bf16_t*)(F.ws + WS_WIN); bf16_t* Wc_t = (bf16_t*)(F.ws + WS_WC); bf16_t* Wglu_t = (bf16_t*)(F.ws + WS_WGLU); bf16_t* Wo_t = (bf16_t*)(F.ws + WS_WO);
    constexpr int I_WIN = 16 * 176, I_WC = 16 * 32, I_WO = 16 * 32, I_GLU = 8 * 64;
    for (int it = gw; it < I_WIN + I_WC + I_WO + I_GLU; it += NGW) {
        int r = it;
        if (r < I_WIN) { const int kb = r / 176, nb = r % 176, j0 = 32 * nb; int col0;
            if (j0 < 2048) { const int pn = j0 >> 8, i = j0 & 255; col0 = (i < 128) ? (128 * pn + i) : (2048 + 128 * pn + (i - 128)); } else if (j0 < 3072) col0 = j0 - 1024; else col0 = j0;
            tr_item(a.in[2], INC, col0, 64 * kb, a.in[1], Win_t, (size_t)j0, D, scr, F.lane); continue; }
        r -= I_WIN;
        if (r < I_WC) { tr_item(a.in[5], D, 32 * (r % 32), 64 * (r / 32), nullptr, Wc_t, (size_t)(32 * (r % 32)), D, scr, F.lane); continue; }
        r -= I_WC;
        if (r < I_WO) { tr_item(a.in[17], D, 32 * (r % 32), 64 * (r / 32), nullptr, Wo_t, (size_t)(32 * (r % 32)), D, scr, F.lane); continue; }
        r -= I_WO;
        { const int kb = r / 64, nb = r % 64, j0 = 32 * nb, pn = j0 >> 8, i = j0 & 255;
          tr_item(i < 128 ? a.in[14] : a.in[15], D, 128 * pn + (i & 127), 64 * kb, nullptr, Wglu_t, (size_t)j0, SW, scr, F.lane); }
    }
    { const float* x = a.in[0]; bf16_t* xb = (bf16_t*)(F.ws + WS_XB); float* rstd1 = (float*)(F.ws + WS_RSTD1);
      for (int m = gw; m < T; m += NGW) {
          const f32x4* xr = (const f32x4*)(x + (size_t)m * D) + F.lane; f32x4 v[4]; float s = 0.f;
#pragma unroll
          for (int j = 0; j < 4; ++j) { v[j] = xr[64 * j]; s += (v[j][0] * v[j][0] + v[j][1] * v[j][1]) + (v[j][2] * v[j][2] + v[j][3] * v[j][3]); }
          const float rs = rsqrtf(wave_sum64(s) * (1.f / D) + EPS);
          u32x2* o = (u32x2*)(xb + (size_t)m * D) + F.lane;
#pragma unroll
          for (int j = 0; j < 4; ++j) { u32x2 w; w.x = cvt_pk_bf16(v[j][0], v[j][1]); w.y = cvt_pk_bf16(v[j][2], v[j][3]); o[64 * j] = w; }
          if (F.lane == 0) rstd1[m] = rs; } }
    { bf16_t* wrt = (bf16_t*)(F.ws + WS_WRT); const float* g2 = a.in[18];
      for (int i = blockIdx.x * 512 + F.tid; i < 48 * D; i += F.G * 512) { const int j = i / D, k = i % D; float w = 0.f;
          if (j < 4) w = a.in[19][k * 4 + j]; else if (j < 36) w = a.in[21][k * 32 + (j - 4)];
          wrt[i] = (bf16_t)(cvt_pk_bf16(w * g2[k], 0.f) & 0xffffu); } }
    { float* tab_a = (float*)(F.ws + WS_TABA); float* tab_a256 = (float*)(F.ws + WS_TABA256); bf16_t* BbT = (bf16_t*)(F.ws + WS_BBT); bf16_t* Ct = (bf16_t*)(F.ws + WS_CT);
      for (int i = blockIdx.x * 512 + F.tid; i < NG * NS; i += F.G * 512) { const int g = i / NS, n = i % NS;
          const double lr = a.in[6][i], li = a.in[7][i], dt = exp((double)a.in[8][g]);
          const double er = exp(lr * dt), cr = er * cos(li * dt), ci = er * sin(li * dt);
          const double e16 = exp(lr * dt * 16.0), e256 = exp(lr * dt * 256.0);
          tab_a[i * 4 + 0] = (float)cr; tab_a[i * 4 + 1] = (float)ci; tab_a[i * 4 + 2] = (float)(e16 * cos(li * dt * 16.0)); tab_a[i * 4 + 3] = (float)(e16 * sin(li * dt * 16.0));
          tab_a256[i * 2 + 0] = (float)(e256 * cos(li * dt * 256.0)); tab_a256[i * 2 + 1] = (float)(e256 * sin(li * dt * 256.0));
          const double nr = cr - 1.0, ni = ci, den = lr * lr + li * li; const double kr = (nr * lr + ni * li) / den, ki = (ni * lr - nr * li) / den;
          for (int h = 0; h < NH; ++h) { const double br = a.in[9][i * NH + h], bi = a.in[10][i * NH + h];
              const float bbr = (float)(kr * br - ki * bi), bbi = (float)(kr * bi + ki * br);
              BbT[((size_t)(g * 4 + 0 + (n >> 5)) * 32 + (n & 31)) * 16 + h] = (bf16_t)(cvt_pk_bf16(bbr, 0.f) & 0xffffu);
              BbT[((size_t)(g * 4 + 2 + (n >> 5)) * 32 + (n & 31)) * 16 + h] = (bf16_t)(cvt_pk_bf16(bbi, 0.f) & 0xffffu);
              Ct[(size_t)(g * NH + h) * 128 + 2 * n] = (bf16_t)(cvt_pk_bf16(a.in[11][(g * NH + h) * NS + n], 0.f) & 0xffffu);
              Ct[(size_t)(g * NH + h) * 128 + 2 * n + 1] = (bf16_t)(cvt_pk_bf16(-a.in[12][(g * NH + h) * NS + n], 0.f) & 0xffffu); } } }
}

__device__ __forceinline__ void p2_conv(const Frame& F, const Args& a) {
    const bf16_t* v = (const bf16_t*)(F.ws + WS_V); const bf16_t* bg = (const bf16_t*)(F.ws + WS_BG); bf16_t* z = (bf16_t*)(F.ws + WS_Z);
    const float* cw = a.in[3]; const float* cb = a.in[4];
    const int gw = blockIdx.x * 8 + F.wave, NGW = F.G * 8;
    for (int it = gw; it < (T / 8) * 2; it += NGW) {
        const int t0 = (it >> 1) * 8, ch = (it & 1) * 512 + F.lane * 8;
        f32x4 w0a = *(const f32x4*)(cw + ch), w0b = *(const f32x4*)(cw + ch + 4), w1a = *(const f32x4*)(cw + D + ch), w1b = *(const f32x4*)(cw + D + ch + 4);
        f32x4 w2a = *(const f32x4*)(cw + 2 * D + ch), w2b = *(const f32x4*)(cw + 2 * D + ch + 4), ba = *(const f32x4*)(cb + ch), bb = *(const f32x4*)(cb + ch + 4);
        f32x4 p2a = {0.f, 0.f, 0.f, 0.f}, p2b = p2a, p1a = p2a, p1b = p2a;
        if (t0 >= 2) { unpack8(*(const u32x4*)(v + (size_t)(t0 - 2) * D + ch), p2a, p2b); unpack8(*(const u32x4*)(v + (size_t)(t0 - 1) * D + ch), p1a, p1b); }
#pragma unroll
        for (int i = 0; i < 8; ++i) { f32x4 ca, cbv, ga, gb; unpack8(*(const u32x4*)(v + (size_t)(t0 + i) * D + ch), ca, cbv); unpack8(*(const u32x4*)(bg + (size_t)(t0 + i) * D + ch), ga, gb);
            const f32x4 ya = ga * (w0a * p2a + w1a * p1a + w2a * ca + ba), yb = gb * (w0b * p2b + w1b * p1b + w2b * cbv + bb);
            *(u32x4*)(z + (size_t)(t0 + i) * D + ch) = pack8(ya, yb);
            p2a = p1a; p2b = p1b; p1a = ca; p1b = cbv; }
    }
}

__device__ __forceinline__ int tokmap(int r) { return 16 * ((r >> 2) & 1) + 4 * (r >> 3) + (r & 3); }
template <int PASS>
__device__ __forceinline__ void scan_tile(f32x16& re, f32x16& im, const f32x4 c, float& Rr, float& Ri, int hf) {
    const float ar = c[0], ai = c[1];
    float sr = hf ? 0.f : Rr, si = hf ? 0.f : Ri;
#pragma unroll
    for (int q = 0; q < 16; ++q) { const float nr = ar * sr - ai * si + re[q], ni = ar * si + ai * sr + im[q]; sr = nr; si = ni; re[q] = sr; im[q] = si; }
    const float orr = __shfl_xor(sr, 32), oii = __shfl_xor(si, 32);
    Rr = c[2] * sr - c[3] * si + orr; Ri = c[2] * si + c[3] * sr + oii;
    if (PASS == 2) {
        float cr = hf ? orr : 0.f, ci = hf ? oii : 0.f;
#pragma unroll
        for (int q = 0; q < 16; ++q) { const float nr = ar * cr - ai * ci, ni = ar * ci + ai * cr; cr = nr; ci = ni; re[q] += cr; im[q] += ci; }
    }
}
template <int PASS>
__device__ __forceinline__ void ssm_pass(const Frame& F, const Args& a) {
    const int lane = F.lane, hf = lane >> 5, col = lane & 31;
    const f32x4* tab_a = (const f32x4*)(F.ws + WS_TABA); const float2* tab_a256 = (const float2*)(F.ws + WS_TABA256);
    const bf16_t* BbT = (const bf16_t*)(F.ws + WS_BBT); const bf16_t* Ct = (const bf16_t*)(F.ws + WS_CT);
    const bf16_t* ub = (const bf16_t*)(F.ws + WS_UB); bf16_t* ys = (bf16_t*)(F.ws + WS_YS); float* E = (float*)(F.ws + WS_E);
    LAS unsigned char* sl = F.lds + F.wave * 8704;
    for (int id = blockIdx.x * 8 + F.wave; id < NG * (T / 256); id += F.G * 8) {
        const int g = id & 31, r = id >> 5;
        const f32x4 c0 = tab_a[g * NS + col], c1 = tab_a[g * NS + 32 + col];
        bf16x8 Bf[4];
#pragma unroll
        for (int q = 0; q < 4; ++q) Bf[q] = *(const bf16x8*)(BbT + ((size_t)(g * 4 + q) * 32 + col) * 16 + 8 * hf);
        float R0r = 0.f, R0i = 0.f, R1r = 0.f, R1i = 0.f;
        bf16x8 Cf[4], Df;
        if (PASS == 2) {
            const float2 p0 = tab_a256[g * NS + col], p1 = tab_a256[g * NS + 32 + col];
            for (int j = 0; j < r; ++j) {
                const float2 e0 = *(const float2*)(E + ((size_t)(j * NG + g) * NS + col) * 2), e1 = *(const float2*)(E + ((size_t)(j * NG + g) * NS + 32 + col) * 2);
                const float t0r = p0.x * R0r - p0.y * R0i + e0.x, t0i = p0.x * R0i + p0.y * R0r + e0.y; R0r = t0r; R0i = t0i;
                const float t1r = p1.x * R1r - p1.y * R1i + e1.x, t1i = p1.x * R1i + p1.y * R1r + e1.y; R1r = t1r; R1i = t1i; }
#pragma unroll
            for (int kb = 0; kb < 4; ++kb) Cf[kb] = *(const bf16x8*)(Ct + (size_t)(g * NH + (lane & 15)) * 128 + kb * 32 + 8 * (lane >> 4));
            const unsigned dbits = cvt_pk_bf16(a.in[13][g * NH + (lane & 15)], 0.f) & 0xffffu;
#pragma unroll
            for (int jj = 0; jj < 8; ++jj) Df[jj] = (short)((lane < 32 && (8 * (lane >> 4) + jj) == (lane & 15)) ? dbits : 0u);
        }
        for (int c = 0; c < 8; ++c) {
            const int t0 = r * 256 + c * 32;
            const bf16x8 Ua = *(const bf16x8*)(ub + (size_t)(t0 + tokmap(col)) * SW + g * NH + 8 * hf);
            const f32x16 zz = {0.f, 0.f, 0.f, 0.f, 0.f, 0.f, 0.f, 0.f, 0.f, 0.f, 0.f, 0.f, 0.f, 0.f, 0.f, 0.f};
            f32x16 bu0 = __builtin_amdgcn_mfma_f32_32x32x16_bf16(Ua, Bf[0], zz, 0, 0, 0);
            f32x16 bu1 = __builtin_amdgcn_mfma_f32_32x32x16_bf16(Ua, Bf[1], zz, 0, 0, 0);
            f32x16 bu2 = __builtin_amdgcn_mfma_f32_32x32x16_bf16(Ua, Bf[2], zz, 0, 0, 0);
            f32x16 bu3 = __builtin_amdgcn_mfma_f32_32x32x16_bf16(Ua, Bf[3], zz, 0, 0, 0);
            scan_tile<PASS>(bu0, bu2, c0, R0r, R0i, hf);
            scan_tile<PASS>(bu1, bu3, c1, R1r, R1i, hf);
            if (PASS == 2) {
                LAS unsigned* sw = (LAS unsigned*)sl;
#pragma unroll
                for (int q = 0; q < 16; ++q) { sw[(16 * hf + q) * 68 + col] = cvt_pk_bf16(bu0[q], bu2[q]); sw[(16 * hf + q) * 68 + 32 + col] = cvt_pk_bf16(bu1[q], bu3[q]); }
                asm volatile("s_waitcnt lgkmcnt(0)" ::: "memory");
#pragma unroll
                for (int mt = 0; mt < 2; ++mt) {
                    f32x4 y = {0.f, 0.f, 0.f, 0.f};
#pragma unroll
                    for (int kb = 0; kb < 4; ++kb) { const bf16x8 Af = *(const LAS bf16x8*)(sl + ((16 * mt + (lane & 15)) * 68 + kb * 16 + 4 * (lane >> 4)) * 4);
                        y = __builtin_amdgcn_mfma_f32_16x16x32_bf16(Af, Cf[kb], y, 0, 0, 0); }
                    bf16x8 A2 = {0, 0, 0, 0, 0, 0, 0, 0};
                    if (lane < 32) A2 = *(const bf16x8*)(ub + (size_t)(t0 + 16 * mt + (lane & 15)) * SW + g * NH + 8 * (lane >> 4));
                    y = __builtin_amdgcn_mfma_f32_16x16x32_bf16(A2, Df, y, 0, 0, 0);
#pragma unroll
                    for (int j = 0; j < 4; ++j) ys[(size_t)(t0 + 16 * mt + 4 * (lane >> 4) + j) * SW + g * NH + (lane & 15)] = (bf16_t)(cvt_pk_bf16(fgelu_tanh(y[j]), 0.f) & 0xffffu);
                }
                asm volatile("s_waitcnt lgkmcnt(0)" ::: "memory");
            }
        }
        if (PASS == 1 && hf == 0) {
            *(float2*)(E + ((size_t)(r * NG + g) * NS + col) * 2) = make_float2(R0r, R0i);
            *(float2*)(E + ((size_t)(r * NG + g) * NS + 32 + col) * 2) = make_float2(R1r, R1i);
        }
    }
}

__device__ __forceinline__ void p6_route(const Frame& F, const Args& a) {
    const bf16_t* x1b = (const bf16_t*)(F.ws + WS_X1B); const bf16_t* wrt = (const bf16_t*)(F.ws + WS_WRT); float* rstd2 = (float*)(F.ws + WS_RSTD2);
    int* cnt = (int*)(F.ctl + CW_CNT); int* list = (int*)(F.ws + WS_LIST);
    int* tok_e = (int*)(F.ws + WS_TOK); int* tok_pos = tok_e + 2 * T; float* tok_w = (float*)(tok_pos + 2 * T);
    volatile LAS int* lcnt = (volatile LAS int*)(F.MISC + 96); volatile LAS int* lbase = (volatile LAS int*)(F.MISC + 128);
    LAS float* lg = (LAS float*)(F.lds + F.wave * 4096);
    const int lane = F.lane;
    for (int blk = blockIdx.x; blk < T / 128; blk += F.G) {
        if (F.tid < 32) lcnt[F.tid] = 0;
        __syncthreads();
        const int tok0 = blk * 128 + F.wave * 16;
        f32x4 acc[3]; float ssq = 0.f;
#pragma unroll
        for (int n = 0; n < 3; ++n) acc[n] = (f32x4){0.f, 0.f, 0.f, 0.f};
        for (int kb = 0; kb < 32; ++kb) {
            const u32x4 aw = *(const u32x4*)(x1b + (size_t)(tok0 + (lane & 15)) * D + kb * 32 + 8 * (lane >> 4));
            f32x4 p, q; unpack8(aw, p, q); ssq += (p[0] * p[0] + p[1] * p[1]) + (p[2] * p[2] + p[3] * p[3]) + (q[0] * q[0] + q[1] * q[1]) + (q[2] * q[2] + q[3] * q[3]);
            bf16x8 Af; Af = __builtin_bit_cast(bf16x8, aw);
#pragma unroll
            for (int n = 0; n < 3; ++n) { const bf16x8 Bfr = *(const bf16x8*)(wrt + (size_t)(n * 16 + (lane & 15)) * D + kb * 32 + 8 * (lane >> 4));
                acc[n] = __builtin_amdgcn_mfma_f32_16x16x32_bf16(Af, Bfr, acc[n], 0, 0, 0); }
        }
        ssq += __shfl_xor(ssq, 16); ssq += __shfl_xor(ssq, 32);
        const float rs = rsqrtf(ssq * (1.f / D) + EPS);
#pragma unroll
        for (int n = 0; n < 3; ++n)
#pragma unroll
            for (int j = 0; j < 4; ++j) lg[(4 * (lane >> 4) + j) * 52 + n * 16 + (lane & 15)] = acc[n][j];
        asm volatile("s_waitcnt lgkmcnt(0)" ::: "memory");
        int e1 = 0, e2 = 0, rk1 = 0, rk2 = 0; float wt1 = 0.f, wt2 = 0.f;
        if (lane < 16) {
            const LAS float* my = lg + lane * 52;
            float l0 = my[0] * rs + a.in[20][0], l1 = my[1] * rs + a.in[20][1], l2 = my[2] * rs + a.in[20][2], l3 = my[3] * rs + a.in[20][3];
            int gi = 0; float lmax = l0;
            if (l1 > lmax) { lmax = l1; gi = 1; } if (l2 > lmax) { lmax = l2; gi = 2; } if (l3 > lmax) { lmax = l3; gi = 3; }
            const float se = __expf(l0 - lmax) + __expf(l1 - lmax) + __expf(l2 - lmax) + __expf(l3 - lmax);
            const float pg = 1.f / se;
            float v1 = -3.0e38f, v2 = -3.0e38f; int i1 = 0, i2 = 0;
#pragma unroll
            for (int j = 0; j < 8; ++j) { const float vv = my[4 + gi * 8 + j] * rs + a.in[22][gi * 8 + j];
                if (vv > v1) { v2 = v1; i2 = i1; v1 = vv; i1 = j; } else if (vv > v2) { v2 = vv; i2 = j; } }
            const float w1 = 1.f / (1.f + __expf(v2 - v1));
            e1 = gi * 8 + i1; e2 = gi * 8 + i2; wt1 = pg * w1; wt2 = pg * (1.f - w1);
            rk1 = __hip_atomic_fetch_add((LAS int*)&lcnt[e1], 1, __ATOMIC_RELAXED, __HIP_MEMORY_SCOPE_WORKGROUP);
            rk2 = __hip_atomic_fetch_add((LAS int*)&lcnt[e2], 1, __ATOMIC_RELAXED, __HIP_MEMORY_SCOPE_WORKGROUP);
            rstd2[tok0 + lane] = rs;
        }
        __syncthreads();
        if (F.tid < 32) { const int c = lcnt[F.tid]; lbase[F.tid] = c ? __hip_atomic_fetch_add(&cnt[F.tid], c, __ATOMIC_RELAXED, __HIP_MEMORY_SCOPE_AGENT) : 0; }
        __syncthreads();
        if (lane < 16) { const int t = tok0 + lane; const int p1 = lbase[e1] + rk1, p2 = lbase[e2] + rk2;
            list[e1 * T + p1] = t; list[e2 * T + p2] = t;
            tok_e[2 * t] = e1; tok_e[2 * t + 1] = e2; tok_pos[2 * t] = p1; tok_pos[2 * t + 1] = p2; tok_w[2 * t] = wt1; tok_w[2 * t + 1] = wt2; }
        __syncthreads();
    }
}
__device__ __forceinline__ void p6_convert(const Frame& F, const Args& a) {
    LAS float* scr = (LAS float*)(F.lds + F.wave * 16384);
    bf16_t* Wgu_t = (bf16_t*)(F.ws + WS_WGU); bf16_t* Wd_t = (bf16_t*)(F.ws + WS_WD);
    const int gw = blockIdx.x * 8 + F.wave, NGW = F.G * 8;
    constexpr int I_GU = NE * 16 * 32, I_D = NE * 8 * 32;
    for (int it = gw; it < I_GU + I_D; it += NGW) {
        if (it < I_GU) { const int e = it / 512, r = it % 512, kb = r / 32, nb = r % 32, j0 = 32 * nb, pn = j0 >> 8, i = j0 & 255;
            tr_item((i < 128 ? a.in[23] : a.in[24]) + (size_t)e * D * EFF, EFF, 128 * pn + (i & 127), 64 * kb, a.in[18], Wgu_t, (size_t)e * 1024 + j0, D, scr, F.lane); }
        else { const int q = it - I_GU, e = q / 256, r = q % 256, kb = r / 32, nb = r % 32;
            tr_item(a.in[25] + (size_t)e * EFF * D, D, 32 * nb, 64 * kb, nullptr, Wd_t, (size_t)e * 1024 + 32 * nb, EFF, scr, F.lane); }
    }
}
__device__ __forceinline__ void load_tb(const Frame& F) {
    volatile LAS int* tb = (volatile LAS int*)(F.MISC + 16); volatile LAS int* lc = (volatile LAS int*)(F.MISC + 64);
    if (F.tid < 32) lc[F.tid] = (int)__hip_atomic_load(F.ctl + CW_CNT + F.tid, __ATOMIC_RELAXED, __HIP_MEMORY_SCOPE_AGENT);
    __syncthreads();
    if (F.tid == 0) { int s = 0; for (int e = 0; e < 32; ++e) { tb[e] = s; s += (lc[e] + 255) >> 8; } tb[32] = s; }
    __syncthreads();
}
__device__ __forceinline__ void p9_final(const Frame& F, const Args& a) {
    const LAS int* tb = (const LAS int*)(F.MISC + 16);
    const int* tok_e = (const int*)(F.ws + WS_TOK); const int* tok_pos = tok_e + 2 * T; const float* tok_w = (const float*)(tok_pos + 2 * T);
    const bf16_t* Y = (const bf16_t*)(F.ws + WS_Y); const float* gf = a.in[26]; float* out = a.out;
    const int gw = blockIdx.x * 8 + F.wave, NGW = F.G * 8;
    for (int t = gw; t < T; t += NGW) {
        const int s1 = 256 * tb[tok_e[2 * t]] + tok_pos[2 * t], s2 = 256 * tb[tok_e[2 * t + 1]] + tok_pos[2 * t + 1];
        const float w1 = tok_w[2 * t], w2 = tok_w[2 * t + 1];
        f32x4 va[2], vb[2]; float s = 0.f;
#pragma unroll
        for (int j = 0; j < 2; ++j) { const int c = 8 * F.lane + 512 * j; f32x4 ya, yb, za, zb;
            unpack8(*(const u32x4*)(Y + (size_t)s1 * D + c), ya, yb); unpack8(*(const u32x4*)(Y + (size_t)s2 * D + c), za, zb);
            va[j] = *(const f32x4*)(out + (size_t)t * D + c) + w1 * ya + w2 * za; vb[j] = *(const f32x4*)(out + (size_t)t * D + c + 4) + w1 * yb + w2 * zb;
            s += (va[j][0] * va[j][0] + va[j][1] * va[j][1]) + (va[j][2] * va[j][2] + va[j][3] * va[j][3]) + (vb[j][0] * vb[j][0] + vb[j][1] * vb[j][1]) + (vb[j][2] * vb[j][2] + vb[j][3] * vb[j][3]); }
        const float rs = rsqrtf(wave_sum64(s) * (1.f / D) + EPS);
#pragma unroll
        for (int j = 0; j < 2; ++j) { const int c = 8 * F.lane + 512 * j;
            *(f32x4*)(out + (size_t)t * D + c) = va[j] * rs * *(const f32x4*)(gf + c); *(f32x4*)(out + (size_t)t * D + c + 4) = vb[j] * rs * *(const f32x4*)(gf + c + 4); }
    }
}

__global__ void __launch_bounds__(512, 2) mega_fwd(Args args) {
    extern __shared__ __attribute__((aligned(16))) unsigned char lds_raw[];
    Frame F;
    F.lds = (LAS unsigned char*)lds_raw; F.MISC = (volatile LAS unsigned*)(F.lds + MISC_OFF);
    F.tid = threadIdx.x; F.lane = F.tid & 63; F.wave = __builtin_amdgcn_readfirstlane(F.tid >> 6); F.G = gridDim.x;
    F.ws = args.ws; F.ctl = (unsigned*)(args.ws + WS_CTL);
    for (int u = F.tid; u < (LDS_BYTES - MISC_OFF) / 4; u += 512) ((LAS unsigned*)(F.lds + MISC_OFF))[u] = 0u;
    __syncthreads();
    XcdBarrier bar; bar.bar = F.ctl + CW_BAR; bar.x = 0; bar.st = nullptr;
    if (args.use_bar) bar = xcd_barrier_post(F.ctl + CW_BAR, F.MISC + 0);
    const int lo = args.ph_lo, hi = args.ph_hi;
#define IN(k) (lo <= (k) && (k) < hi)
#define SEAM(k) do { if (IN(k) && IN((k) + 1)) xcd_barrier(bar); } while (0)
    unsigned char* ws = args.ws;
    const int c = (int)blockIdx.x;

    if (IN(0)) { p0_prologue(F, args); }
    SEAM(0);
    if (IN(1)) {
        pg8::DenseOrder S{(const char*)(ws + WS_XB), (const char*)(ws + WS_WIN), D, T / 256, INC / 256, 1, F.G, c};
        EpiWin E{(const float*)(ws + WS_RSTD1), (bf16_t*)(ws + WS_V), (bf16_t*)(ws + WS_BG), (bf16_t*)(ws + WS_UB), (bf16_t*)(ws + WS_GATES), args.in[16]};
        pg8::gemm_phase<EpiWin, pg8::DenseOrder, false, true>(F.lds, D, S, E);
    }
    SEAM(1);
    if (IN(2)) { p2_conv(F, args); ssm_pass<1>(F, args); }
    SEAM(2);
    if (IN(3)) { ssm_pass<2>(F, args); }
    SEAM(3);
    if (IN(4)) {
        { pg8::DenseOrder S{(const char*)(ws + WS_YS), (const char*)(ws + WS_WGLU), SW, T / 256, 4, 2, F.G, c};
          EpiGlu E{(const bf16_t*)(ws + WS_GATES), (bf16_t*)(ws + WS_MB)};
          pg8::gemm_phase<EpiGlu, pg8::DenseOrder, false, true>(F.lds, SW, S, E); }
        asm volatile("s_waitcnt vmcnt(0)" ::: "memory"); __syncthreads();
        { pg8::DenseOrder S{(const char*)(ws + WS_Z), (const char*)(ws + WS_WC), D, T / 256, 4, 1, F.G, c};
          EpiMix E{(const bf16_t*)(ws + WS_GATES), (const bf16_t*)(ws + WS_MB), (bf16_t*)(ws + WS_MIXED)};
          pg8::gemm_phase<EpiMix, pg8::DenseOrder, false, true>(F.lds, D, S, E); }
    }
    SEAM(4);
    if (IN(5)) {
        pg8::DenseOrder S{(const char*)(ws + WS_MIXED), (const char*)(ws + WS_WO), D, T / 256, 4, 1, F.G, c};
        EpiX1 E{args.in[0], args.out, (bf16_t*)(ws + WS_X1B)};
        pg8::gemm_phase<EpiX1, pg8::DenseOrder, false, true>(F.lds, D, S, E);
    }
    SEAM(5);
    if (IN(6)) { p6_route(F, args); p6_convert(F, args); }
    SEAM(6);
    if (IN(7)) {
        load_tb(F);
        pg8::MoEOrder S{(const LAS int*)(F.MISC + 16), (const LAS int*)(F.MISC + 64), (const int*)(ws + WS_LIST), (const char*)(ws + WS_X1B), (const char*)(ws + WS_WGU), D, (size_t)1024 * D * 2, F.G, c, true};
        EpiUp E{(const int*)(ws + WS_LIST), (const float*)(ws + WS_RSTD2), (bf16_t*)(ws + WS_HMID)};
        pg8::gemm_phase<EpiUp, pg8::MoEOrder, true, true>(F.lds, D, S, E);
    }
    SEAM(7);
    if (IN(8)) {
        load_tb(F);
        pg8::MoEOrder S{(const LAS int*)(F.MISC + 16), (const LAS int*)(F.MISC + 64), (const int*)(ws + WS_LIST), (const char*)(ws + WS_HMID), (const char*)(ws + WS_WD), EFF, (size_t)1024 * EFF * 2, F.G, c, false};
        EpiDown E{(bf16_t*)(ws + WS_Y)};
        pg8::gemm_phase<EpiDown, pg8::MoEOrder, false, true>(F.lds, EFF, S, E);
    }
    SEAM(8);
    if (IN(9)) { load_tb(F); p9_final(F, args); }
#undef IN
#undef SEAM
}

#ifndef MK_MODE
#define MK_MODE 2
#endif
extern "C" void kernel_launch(void* const* d_in, const int* in_sizes, int n_in, void* d_out, int out_size, void* d_ws, size_t ws_size, hipStream_t stream) {
    static int grid = 0;
    if (grid == 0) {
        int dev = 0, cus = 0, per_cu = 0;
        (void)hipGetDevice(&dev); (void)hipDeviceGetAttribute(&cus, hipDeviceAttributeMultiprocessorCount, dev);
        (void)hipFuncSetAttribute((const void*)mega_fwd, hipFuncAttributeMaxDynamicSharedMemorySize, LDS_BYTES);
        (void)hipOccupancyMaxActiveBlocksPerMultiprocessor(&per_cu, (const void*)mega_fwd, 512, LDS_BYTES);
        (void)hipGetLastError();
        grid = cus * (per_cu < 1 ? 1 : 1);
    }
    (void)hipMemsetAsync((char*)d_ws + WS_CTL, 0, CTL_BYTES, stream);
    Args a{};
    for (int i = 0; i < 27; ++i) a.in[i] = (const float*)d_in[i];
    a.out = (float*)d_out; a.ws = (unsigned char*)d_ws;
#if MK_MODE == 2
    a.ph_lo = 0; a.ph_hi = 10; a.use_bar = 1;
    hipLaunchKernelGGL(mega_fwd, dim3(grid), dim3(512), LDS_BYTES, stream, a);
#else
    const int nfast = (MK_MODE == 1) ? 6 : 10;
    for (int p = 0; p < nfast; ++p) { a.ph_lo = p; a.ph_hi = p + 1; a.use_bar = 0; hipLaunchKernelGGL(mega_fwd, dim3(grid), dim3(512), LDS_BYTES, stream, a); }
#if MK_MODE == 1
    {
        using namespace nv;
        float* out = (float*)d_out; char* ws = (char*)d_ws; const size_t MiB_ = 1u << 20;
        float* hbuf = (float*)(ws); float* B1 = (float*)(ws + 64 * MiB_); float* B2 = (float*)(ws + 128 * MiB_);
        char* misc = ws + 256 * MiB_;
        int* cnt = (int*)(misc + 2 * MiB_); int* off = cnt + 64; int* list = (int*)(misc + 2 * MiB_ + 4096);
        int* tok_e = (int*)(misc + 5 * MiB_); int* tok_pos = tok_e + 2 * nv::T; float* tok_w = (float*)(tok_pos + 2 * nv::T);
        const dim3 b256(256);
        const float* norm_ffn = (const float*)d_in[18]; const float* wrg = (const float*)d_in[19]; const float* brg = (const float*)d_in[20]; const float* wre = (const float*)d_in[21]; const float* bre = (const float*)d_in[22];
        const float* w_gate = (const float*)d_in[23]; const float* w_up = (const float*)d_in[24]; const float* w_down = (const float*)d_in[25]; const float* norm_final = (const float*)d_in[26];
        hipLaunchKernelGGL(k_rmsnorm, dim3(nv::T / 4), b256, 0, stream, out, norm_ffn, hbuf, nv::T);
        (void)hipMemsetAsync(cnt, 0, 512, stream);
        hipLaunchKernelGGL(k_route, dim3(nv::T / 4), b256, 0, stream, hbuf, wrg, brg, wre, bre, cnt, list, tok_e, tok_pos, tok_w);
        hipLaunchKernelGGL(k_offsets, dim3(1), dim3(64), 0, stream, cnt, off);
        float* Hm = B1; float* Yd = B2;
        for (int e = 0; e < nv::NE; ++e)
            hipLaunchKernelGGL(k_gemm<2>, dim3(nv::EFF / 64, nv::T / 64), b256, 0, stream, hbuf, nv::D, list + e * nv::T, nullptr, w_gate + (size_t)e * nv::D * nv::EFF, w_up + (size_t)e * nv::D * nv::EFF, nv::EFF,
                               Hm, nv::EFF, off + e, nullptr, 0, cnt + e, nv::EFF, nv::D);
        for (int e = 0; e < nv::NE; ++e)
            hipLaunchKernelGGL(k_gemm<0>, dim3(nv::D / 64, nv::T / 64), b256, 0, stream, Hm, nv::EFF, nullptr, off + e, w_down + (size_t)e * nv::EFF * nv::D, nullptr, nv::D,
                               Yd, nv::D, off + e, nullptr, 0, cnt + e, nv::D, nv::EFF);
        hipLaunchKernelGGL(k_final, dim3(nv::T / 4), b256, 0, stream, out, Yd, off, tok_e, tok_pos, tok_w, norm_final);
    }
#endif
#endif
}
```

```cpp
#include <hip/hip_runtime.h>
#include <stdint.h>

namespace nv {
constexpr int T = 16384, D = 1024, SW = 512, NG = 32, NS = 64, NH = 16, INC = 5632, NE = 32, EFF = 512;
constexpr float EPS = 1e-6f;

__device__ __forceinline__ float wave_sum(float v) {
#pragma unroll
    for (int o = 1; o < 64; o <<= 1) v += __shfl_xor(v, o);
    return v;
}
__device__ __forceinline__ float sigmoidf_(float x) { return 1.f / (1.f + __expf(-x)); }
__device__ __forceinline__ float gelu_tanh(float x) { const float u = 0.7978845608028654f * (x + 0.044715f * x * x * x); return 0.5f * x * (1.f + tanhf(u)); }

__global__ __launch_bounds__(256) void k_rmsnorm(const float* x, const float* g, float* y, int rows) {
    const int row = blockIdx.x * 4 + (threadIdx.x >> 6), lane = threadIdx.x & 63;
    if (row >= rows) return;
    const float4* xr = (const float4*)(x + (size_t)row * D);
    float4 v[4]; float s = 0.f;
#pragma unroll
    for (int j = 0; j < 4; ++j) { v[j] = xr[lane + 64 * j]; s += v[j].x * v[j].x + v[j].y * v[j].y + v[j].z * v[j].z + v[j].w * v[j].w; }
    const float r = rsqrtf(wave_sum(s) * (1.f / D) + EPS);
    float4* yr = (float4*)(y + (size_t)row * D);
#pragma unroll
    for (int j = 0; j < 4; ++j) { const float4 gg = ((const float4*)g)[lane + 64 * j]; yr[lane + 64 * j] = make_float4(v[j].x * r * gg.x, v[j].y * r * gg.y, v[j].z * r * gg.z, v[j].w * r * gg.w); }
}

template <int MODE>
__global__ __launch_bounds__(256) void k_gemm(const float* A, int lda, const int* gather, const int* aoff_dev, const float* B, const float* B2, int ldb,
                                              float* C, int ldc, const int* coff_dev, const float* resid, int M, const int* Mdev, int N, int K) {
    __shared__ float As[16][68];
    __shared__ float Bs[16][64];
    __shared__ float Bs2[16][64];
    if (Mdev) M = *Mdev;
    const int row0 = blockIdx.y * 64, col0 = blockIdx.x * 64;
    if (row0 >= M) return;
    const int aoff = aoff_dev ? *aoff_dev : 0, coff = coff_dev ? *coff_dev : 0;
    const int tid = threadIdx.x, ty = tid >> 4, tx = tid & 15;
    const int lr = tid >> 2, lk = (tid & 3) * 4;
    const int bk = tid >> 4, bn = (tid & 15) * 4;
    int arow = -1;
    if (row0 + lr < M) arow = gather ? gather[row0 + lr] : (aoff + row0 + lr);
    float acc[4][4] = {}, acc2[4][4] = {};
    for (int k0 = 0; k0 < K; k0 += 16) {
        float4 av = make_float4(0.f, 0.f, 0.f, 0.f);
        if (arow >= 0) av = *(const float4*)(A + (size_t)arow * lda + k0 + lk);
        As[lk + 0][lr] = av.x; As[lk + 1][lr] = av.y; As[lk + 2][lr] = av.z; As[lk + 3][lr] = av.w;
        *(float4*)&Bs[bk][bn] = *(const float4*)(B + (size_t)(k0 + bk) * ldb + col0 + bn);
        if (MODE >= 2) *(float4*)&Bs2[bk][bn] = *(const float4*)(B2 + (size_t)(k0 + bk) * ldb + col0 + bn);
        __syncthreads();
#pragma unroll
        for (int k = 0; k < 16; ++k) {
            const float4 a = *(const float4*)&As[k][ty * 4];
            const float4 b = *(const float4*)&Bs[k][tx * 4];
            const float aa[4] = {a.x, a.y, a.z, a.w}, bb[4] = {b.x, b.y, b.z, b.w};
#pragma unroll
            for (int i = 0; i < 4; ++i)
#pragma unroll
                for (int j = 0; j < 4; ++j) acc[i][j] += aa[i] * bb[j];
            if (MODE >= 2) {
                const float4 b2 = *(const float4*)&Bs2[k][tx * 4]; const float cc[4] = {b2.x, b2.y, b2.z, b2.w};
#pragma unroll
                for (int i = 0; i < 4; ++i)
#pragma unroll
                    for (int j = 0; j < 4; ++j) acc2[i][j] += aa[i] * cc[j];
            }
        }
        __syncthreads();
    }
#pragma unroll
    for (int i = 0; i < 4; ++i) {
        const int r = row0 + ty * 4 + i;
        if (r >= M) continue;
        float o[4];
#pragma unroll
        for (int j = 0; j < 4; ++j) {
            float v = acc[i][j];
            if (MODE == 2) v = (v * sigmoidf_(v)) * acc2[i][j];
            if (MODE == 3) v = v * sigmoidf_(acc2[i][j]);
            o[j] = v;
        }
        const size_t ci = (size_t)(coff + r) * ldc + col0 + tx * 4;
        if (MODE == 1) { const float4 rr = *(const float4*)(resid + ci); o[0] += rr.x; o[1] += rr.y; o[2] += rr.z; o[3] += rr.w; }
        *(float4*)(C + ci) = make_float4(o[0], o[1], o[2], o[3]);
    }
}

__global__ __launch_bounds__(256) void k_conv(const float* xc, const float* cg, float* bg_z, const float* cw, const float* cb) {
    const size_t i = (size_t)blockIdx.x * 256 + threadIdx.x;
    const int t = (int)(i / D), c = (int)(i % D);
    float y = cb[c] + cw[2 * D + c] * (cg[i] * xc[i]);
    if (t >= 1) y += cw[1 * D + c] * (cg[i - D] * xc[i - D]);
    if (t >= 2) y += cw[0 * D + c] * (cg[i - 2 * D] * xc[i - 2 * D]);
    bg_z[i] = bg_z[i] * y;
}

struct cplx { float re, im; };
__device__ __forceinline__ cplx cmul(cplx a, cplx b) { return {a.re * b.re - a.im * b.im, a.re * b.im + a.im * b.re}; }

__device__ __forceinline__ void ssm_consts(const float* a_re, const float* a_im, const float* log_dt, int g, int n, cplx& abar, cplx& coef, cplx& a256) {
    const double lr = a_re[g * NS + n], li = a_im[g * NS + n], dt = exp((double)log_dt[g]);
    const double er = exp(lr * dt), cr = er * cos(li * dt), ci = er * sin(li * dt);
    abar = {(float)cr, (float)ci};
    const double nr = cr - 1.0, ni = ci, den = lr * lr + li * li;
    coef = {(float)((nr * lr + ni * li) / den), (float)((ni * lr - nr * li) / den)};
    const double e2 = exp(lr * dt * 256.0);
    a256 = {(float)(e2 * cos(li * dt * 256.0)), (float)(e2 * sin(li * dt * 256.0))};
}

template <int PASS>
__global__ __launch_bounds__(64) void k_ssm(const float* u, const float* a_re, const float* a_im, const float* log_dt, const float* b_re, const float* b_im,
                                            const float* c_re, const float* c_im, const float* dsk, float* E, const float* Cin, float* ys) {
    __shared__ float part[16][65];
    const int g = blockIdx.x, r = blockIdx.y, n = threadIdx.x;
    cplx abar, coef, a256; ssm_consts(a_re, a_im, log_dt, g, n, abar, coef, a256);
    cplx bb[16]; float cre[16], cim[16];
#pragma unroll
    for (int h = 0; h < 16; ++h) {
        bb[h] = cmul(coef, cplx{b_re[(g * NS + n) * NH + h], b_im[(g * NS + n) * NH + h]});
        cre[h] = c_re[(g * NH + h) * NS + n]; cim[h] = c_im[(g * NH + h) * NS + n];
    }
    cplx s = {0.f, 0.f};
    if (PASS == 2) s = {Cin[((size_t)(r * NG + g) * NS + n) * 2], Cin[((size_t)(r * NG + g) * NS + n) * 2 + 1]};
    for (int t = r * 256; t < r * 256 + 256; ++t) {
        const float* ut = u + (size_t)t * SW + g * NH;
        cplx bu = {0.f, 0.f};
#pragma unroll
        for (int h = 0; h < 16; ++h) { const float uv = ut[h]; bu.re += bb[h].re * uv; bu.im += bb[h].im * uv; }
        s = cmul(abar, s); s.re += bu.re; s.im += bu.im;
        if (PASS == 2) {
#pragma unroll
            for (int h = 0; h < 16; ++h) part[h][n] = cre[h] * s.re - cim[h] * s.im;
            __syncthreads();
            const int h = n & 15, q = n >> 4; float y = 0.f;
#pragma unroll
            for (int j = 0; j < 16; ++j) y += part[h][q * 16 + j];
            y += __shfl_xor(y, 16); y += __shfl_xor(y, 32);
            if (q == 0) { const float v = y + dsk[g * NH + h] * ut[h]; ys[(size_t)t * SW + g * NH + h] = gelu_tanh(v); }
            __syncthreads();
        }
    }
    if (PASS == 1) { E[((size_t)(r * NG + g) * NS + n) * 2] = s.re; E[((size_t)(r * NG + g) * NS + n) * 2 + 1] = s.im; }
}
__global__ __launch_bounds__(64) void k_ssm_carry(const float* a_re, const float* a_im, const float* log_dt, const float* E, float* Cin) {
    const int g = blockIdx.x, n = threadIdx.x;
    cplx abar, coef, a256; ssm_consts(a_re, a_im, log_dt, g, n, abar, coef, a256);
    cplx run = {0.f, 0.f};
    for (int r = 0; r < T / 256; ++r) {
        const size_t i = ((size_t)(r * NG + g) * NS + n) * 2;
        Cin[i] = run.re; Cin[i + 1] = run.im;
        run = cmul(a256, run); run.re += E[i]; run.im += E[i + 1];
    }
}

template <int ADD>
__global__ __launch_bounds__(256) void k_mix(const float* gl, const float* bias, const float* y, float* m) {
    const size_t i = (size_t)blockIdx.x * 256 + threadIdx.x; const int c = (int)(i % D);
    const float v = sigmoidf_(gl[i] + bias[c]) * y[i];
    m[i] = ADD ? m[i] + v : v;
}

__global__ __launch_bounds__(256) void k_route(const float* h2, const float* wrg, const float* brg, const float* wre, const float* bre,
                                               int* cnt, int* list, int* tok_e, int* tok_pos, float* tok_w) {
    const int t = blockIdx.x * 4 + (threadIdx.x >> 6), lane = threadIdx.x & 63;
    float acc[36];
#pragma unroll
    for (int j = 0; j < 36; ++j) acc[j] = 0.f;
    for (int k = lane; k < D; k += 64) {
        const float hv = h2[(size_t)t * D + k];
#pragma unroll
        for (int j = 0; j < 4; ++j) acc[j] += hv * wrg[k * 4 + j];
#pragma unroll
        for (int j = 0; j < 32; ++j) acc[4 + j] += hv * wre[k * 32 + j];
    }
#pragma unroll
    for (int j = 0; j < 36; ++j) acc[j] = wave_sum(acc[j]);
    if (lane == 0) {
        float lg[4]; int gi = 0; float lmax;
#pragma unroll
        for (int j = 0; j < 4; ++j) { lg[j] = acc[j] + brg[j]; }
        lmax = lg[0];
#pragma unroll
        for (int j = 1; j < 4; ++j) if (lg[j] > lmax) { lmax = lg[j]; gi = j; }
        float se = 0.f;
#pragma unroll
        for (int j = 0; j < 4; ++j) se += __expf(lg[j] - lmax);
        const float pg = 1.f / se;
        float v1 = -3.0e38f, v2 = -3.0e38f; int i1 = 0, i2 = 0;
#pragma unroll
        for (int j = 0; j < 8; ++j) { float v = 0.f;
#pragma unroll
            for (int q = 0; q < 4; ++q) if (q == gi) v = acc[4 + q * 8 + j] + bre[q * 8 + j];
            if (v > v1) { v2 = v1; i2 = i1; v1 = v; i1 = j; } else if (v > v2) { v2 = v; i2 = j; } }
        const float w1 = 1.f / (1.f + __expf(v2 - v1)), w2 = 1.f - w1;
        const int e1 = gi * 8 + i1, e2 = gi * 8 + i2;
        const int p1 = atomicAdd(&cnt[e1], 1), p2 = atomicAdd(&cnt[e2], 1);
        list[e1 * T + p1] = t; list[e2 * T + p2] = t;
        tok_e[t * 2] = e1; tok_e[t * 2 + 1] = e2; tok_pos[t * 2] = p1; tok_pos[t * 2 + 1] = p2;
        tok_w[t * 2] = pg * w1; tok_w[t * 2 + 1] = pg * w2;
    }
}
__global__ void k_offsets(const int* cnt, int* off) { if (threadIdx.x == 0) { int s = 0; for (int e = 0; e < NE; ++e) { off[e] = s; s += cnt[e]; } } }

__global__ __launch_bounds__(256) void k_final(float* out, const float* Y, const int* off, const int* tok_e, const int* tok_pos, const float* tok_w, const float* g) {
    const int t = blockIdx.x * 4 + (threadIdx.x >> 6), lane = threadIdx.x & 63;
    const int s1 = off[tok_e[t * 2]] + tok_pos[t * 2], s2 = off[tok_e[t * 2 + 1]] + tok_pos[t * 2 + 1];
    const float w1 = tok_w[t * 2], w2 = tok_w[t * 2 + 1];
    float4* xr = (float4*)(out + (size_t)t * D);
    const float4* y1 = (const float4*)(Y + (size_t)s1 * D); const float4* y2 = (const float4*)(Y + (size_t)s2 * D);
    float4 v[4]; float s = 0.f;
#pragma unroll
    for (int j = 0; j < 4; ++j) { const float4 a = xr[lane + 64 * j], b = y1[lane + 64 * j], c = y2[lane + 64 * j];
        v[j] = make_float4(a.x + w1 * b.x + w2 * c.x, a.y + w1 * b.y + w2 * c.y, a.z + w1 * b.z + w2 * c.z, a.w + w1 * b.w + w2 * c.w);
        s += v[j].x * v[j].x + v[j].y * v[j].y + v[j].z * v[j].z + v[j].w * v[j].w; }
    const float r = rsqrtf(wave_sum(s) * (1.f / D) + EPS);
#pragma unroll
    for (int j = 0; j < 4; ++j) { const float4 gg = ((const float4*)g)[lane + 64 * j]; xr[lane + 64 * j] = make_float4(v[j].x * r * gg.x, v[j].y * r * gg.y, v[j].z * r * gg.z, v[j].w * r * gg.w); }
}
}

#define LAS __attribute__((address_space(3)))
typedef unsigned short bf16_t;
typedef short bf16x8 __attribute__((ext_vector_type(8)));
typedef float f32x4 __attribute__((ext_vector_type(4)));
typedef float f32x16 __attribute__((ext_vector_type(16)));
typedef unsigned u32x4 __attribute__((ext_vector_type(4)));
typedef unsigned u32x2 __attribute__((ext_vector_type(2)));

constexpr int T = 16384, D = 1024, SW = 512, NG = 32, NS = 64, NH = 16, INC = 5632, NE = 32, EFF = 512;
constexpr float EPS = 1e-6f;

__device__ __forceinline__ unsigned cvt_pk_bf16(float lo, float hi) { unsigned r; asm volatile("v_cvt_pk_bf16_f32 %0, %1, %2" : "=v"(r) : "v"(lo), "v"(hi)); return r; }
__device__ __forceinline__ float bf_lo(unsigned w) { return __uint_as_float(w << 16); }
__device__ __forceinline__ float bf_hi(unsigned w) { return __uint_as_float(w & 0xffff0000u); }
__device__ __forceinline__ float fsigmoid(float x) { return __builtin_amdgcn_rcpf(1.f + __builtin_amdgcn_exp2f(-1.4426950408889634f * x)); }
__device__ __forceinline__ float fsilu(float x) { return x * fsigmoid(x); }
__device__ __forceinline__ float fgelu_tanh(float x) { const float u = 0.7978845608028654f * (x + 0.044715f * x * x * x); return x * fsigmoid(2.f * u); }
__device__ __forceinline__ float wave_sum64(float v) {
#pragma unroll
    for (int o = 1; o < 64; o <<= 1) v += __shfl_xor(v, o);
    return v;
}

namespace pg8 {
constexpr int BM = 256, BK = 64, HALF = 128, HTB = HALF * BK * 2, STAGE_BYTES = 8 * HTB, NXCD = 8, WGM = 8;
__host__ __device__ __forceinline__ int lds_byte(int r, int c) { const int st = (r >> 4) * 2 + (c >> 5), rr = r & 15, cc = c & 31, ob = rr * 64 + cc * 2; return st * 1024 + (ob ^ (((ob >> 9) & 1) << 5)); }
__host__ __device__ __forceinline__ void stage_rc(int b, int& R, int& C) { const int st = b / 1024, sb = b % 1024, swz = sb ^ (((sb >> 9) & 1) << 5); R = (st >> 1) * 16 + swz / 64; C = (st & 1) * 32 + (swz % 64) / 2; }
__host__ __device__ __forceinline__ int perm32(int rho) { const int n = rho >> 4, i = rho & 15; return 8 * (i >> 2) + 4 * n + (i & 3); }

struct Unit { int pm, pn, e, nrow, srow; };

__device__ __forceinline__ void tile_map(int L, int nM, int nN, int& pm, int& pn) {
    const int nwg = nM * nN; int wgid = L;
    { const int q = nwg / NXCD, r = nwg % NXCD, xcd = wgid % NXCD, off = wgid / NXCD; wgid = (xcd < r ? xcd * (q + 1) : r * (q + 1) + (xcd - r) * q) + off; }
    const int nig = WGM * nN, gid = wgid / nig, fm = gid * WGM, gsz = (nM - fm) < WGM ? (nM - fm) : WGM;
    pm = fm + ((wgid % nig) % gsz); pn = (wgid % nig) / gsz;
}
struct DenseOrder {
    const char* A; const char* Bt; int K, nM, nNt, sub, G, c;
    __device__ __forceinline__ bool next(int i, Unit& u) const {
        const int L = (i / sub) * G + c; if (L >= nM * nNt) return false;
        int pm, pn; tile_map(L, nM, nNt, pm, pn); u.pm = pm; u.pn = pn * sub + (i % sub); u.e = 0; u.nrow = 256; u.srow = 0; return true;
    }
    __device__ __forceinline__ const char* a_base(const Unit& u) const { return A + (size_t)u.pm * (size_t)(BM * 2) * K; }
    __device__ __forceinline__ const char* b_base(const Unit& u) const { return Bt + (size_t)u.pn * (size_t)(BM * 2) * K; }
    __device__ __forceinline__ unsigned a_row(const Unit&, int r) const { return (unsigned)r; }
};
struct MoEOrder {
    const LAS int* tb; const LAS int* lc; const int* list; const char* A; const char* Bt; int K; size_t bstride; int G, c; bool gather;
    __device__ __forceinline__ bool next(int i, Unit& u) const {
        const int L = i * G + c; const int ntile = tb[32]; if (L >= ntile * 4) return false;
        const int tt = L >> 2; int e = 0;
#pragma unroll 1
        for (int q = 1; q < 32; ++q) if (tb[q] <= tt) e = q;
        e = __builtin_amdgcn_readfirstlane(e);
        u.e = e; u.pm = tt - tb[e]; u.pn = L & 3; const int rem = lc[e] - 256 * u.pm; u.nrow = rem < 256 ? rem : 256; u.srow = 256 * tt; return true;
    }
    __device__ __forceinline__ const char* a_base(const Unit& u) const { return gather ? A : A + (size_t)u.srow * 2 * K; }
    __device__ __forceinline__ const char* b_base(const Unit& u) const { return Bt + (size_t)u.e * bstride + (size_t)u.pn * (size_t)(BM * 2) * K; }
    __device__ __forceinline__ unsigned a_row(const Unit& u, int r) const { return r < u.nrow ? (unsigned)list[u.e * T + 256 * u.pm + r] : 0u; }
};

template <class Epi, class Sched, bool GATHER, bool ALIGN_EPI>
__device__ __forceinline__ void gemm_phase(LAS unsigned char* lds, const int K, const Sched& S, const Epi& E) {
    const int tid = threadIdx.x, wid = __builtin_amdgcn_readfirstlane(tid >> 6), lane = tid & 63, wr = wid >> 2, wc = wid & 3, fr = lane & 15, fq = lane >> 4;
    const int nt = K / BK;
    unsigned voffB[2], vA[2][2], nvA[2][2]; int Rr[2], Cc[2];
#pragma unroll
    for (int i = 0; i < 2; ++i) { int R, C; stage_rc(tid * 16 + i * 8192, R, C); const int Rb = Epi::PERM ? ((R & ~31) + perm32(R & 31)) : R;
        Rr[i] = R; Cc[i] = C; voffB[i] = (unsigned)(Rb * K + C) * 2u; }
    const size_t kstep = (size_t)(BK * 2);
    const size_t hstep = (size_t)HALF * K * 2;
    const unsigned ldsw = (unsigned)wid * 1024u;
    const int aoff = lds_byte(wr * 64 + fr, fq * 8), boff = lds_byte(wc * 32 + fr, fq * 8);
#define PG8_SA(b, h) (((b) * 2 + (h)) * HTB)
#define PG8_SB(b, h) ((4 + (b) * 2 + (h)) * HTB)
#define PG8_STAGE(bufoff, gbase, voff) do { _Pragma("unroll") for (int _i = 0; _i < 2; ++_i) \
        __builtin_amdgcn_global_load_lds((const unsigned*)((const char*)(gbase) + (voff)[_i]), (LAS unsigned*)(lds + (bufoff) + ldsw + _i * 8192), 16, 0, 0); } while (0)
#define PG8_LDA(dst, b, h) do { _Pragma("unroll") for (int m = 0; m < 4; ++m) _Pragma("unroll") for (int k = 0; k < 2; ++k) dst[m][k] = *(const LAS bf16x8*)(lds + PG8_SA(b, h) + aoff + m * 2048 + k * 1024); } while (0)
#define PG8_LDB(dst, b, h) do { _Pragma("unroll") for (int n = 0; n < 2; ++n) _Pragma("unroll") for (int k = 0; k < 2; ++k) dst[n][k] = *(const LAS bf16x8*)(lds + PG8_SB(b, h) + boff + n * 2048 + k * 1024); } while (0)
#define PG8_MMA(ai, bj, At, Bt) do { __builtin_amdgcn_s_setprio(1); _Pragma("unroll") for (int m = 0; m < 4; ++m) _Pragma("unroll") for (int n = 0; n < 2; ++n) _Pragma("unroll") for (int k = 0; k < 2; ++k) \
        acc[ai][bj][m][n] = __builtin_amdgcn_mfma_f32_16x16x32_bf16(Bt[n][k], At[m][k], acc[ai][bj][m][n], 0, 0, 0); __builtin_amdgcn_s_setprio(0); } while (0)
#define PG8_WAIT_V(n) asm volatile("s_waitcnt vmcnt(" #n ")" ::: "memory")
#define PG8_WAIT_L(n) asm volatile("s_waitcnt lgkmcnt(" #n ")" ::: "memory")
#define PG8_BAR __builtin_amdgcn_s_barrier()
#define PG8_SCHED __builtin_amdgcn_sched_barrier(0)
    Unit cur, nxt; int ui = 0;
    if (!S.next(0, cur)) return;
#pragma unroll
    for (int h = 0; h < 2; ++h)
#pragma unroll
        for (int i = 0; i < 2; ++i) vA[h][i] = (unsigned)((GATHER ? S.a_row(cur, h * HALF + Rr[i]) : (unsigned)(h * HALF + Rr[i])) * (unsigned)K + (unsigned)Cc[i]) * 2u;
    f32x4 acc[2][2][4][2];
    if constexpr (Epi::HAS_INIT) E.init(acc, cur, wr, wc, fr, fq);
    else {
#pragma unroll
    for (int a = 0; a < 2; ++a)
#pragma unroll
        for (int b = 0; b < 2; ++b)
#pragma unroll
            for (int m = 0; m < 4; ++m)
#pragma unroll
                for (int n = 0; n < 2; ++n) acc[a][b][m][n] = (f32x4){0.f, 0.f, 0.f, 0.f};
    }
    bf16x8 At[4][2], B0[2][2], B1[2][2];
    const char* cA = S.a_base(cur); const char* cB = S.b_base(cur);
    PG8_STAGE(PG8_SB(0, 0), cB, voffB); PG8_STAGE(PG8_SB(0, 1), cB + hstep, voffB); PG8_STAGE(PG8_SA(0, 0), cA, vA[0]); PG8_STAGE(PG8_SA(0, 1), cA, vA[1]);
    if (wr == 1) PG8_BAR;
    PG8_WAIT_V(2); PG8_BAR;
    PG8_STAGE(PG8_SB(1, 0), cB + kstep, voffB); PG8_STAGE(PG8_SA(1, 0), cA + kstep, vA[0]); PG8_STAGE(PG8_SB(1, 1), cB + hstep + kstep, voffB);
    PG8_WAIT_V(6); PG8_BAR;
    for (;;) {
        const bool has_next = S.next(ui + 1, nxt);
        const char* nA = has_next ? S.a_base(nxt) : cA; const char* nB = has_next ? S.b_base(nxt) : cB;
        if constexpr (GATHER) {
#pragma unroll
            for (int h = 0; h < 2; ++h)
#pragma unroll
                for (int i = 0; i < 2; ++i) nvA[h][i] = has_next ? (unsigned)(S.a_row(nxt, h * HALF + Rr[i]) * (unsigned)K + (unsigned)Cc[i]) * 2u : vA[h][i];
        }
        for (int t = 0; t < nt; t += 2) {
            const bool last = (t == nt - 2);
            const char* a1 = cA + (size_t)(t + 1) * kstep;
            const char* a2 = last ? nA : cA + (size_t)(t + 2) * kstep; const char* b2 = last ? nB : cB + (size_t)(t + 2) * kstep;
            const char* a3 = a2 + kstep; const char* b3 = b2 + kstep;
            unsigned x0[2], x1[2];
            if constexpr (GATHER) { x0[0] = last ? nvA[0][0] : vA[0][0]; x0[1] = last ? nvA[0][1] : vA[0][1]; x1[0] = last ? nvA[1][0] : vA[1][0]; x1[1] = last ? nvA[1][1] : vA[1][1]; }
            else { x0[0] = vA[0][0]; x0[1] = vA[0][1]; x1[0] = vA[1][0]; x1[1] = vA[1][1]; }
            PG8_LDB(B0, 0, 0); PG8_LDB(B1, 0, 1); PG8_SCHED; PG8_LDA(At, 0, 0); PG8_STAGE(PG8_SA(1, 1), a1, vA[1]);
            PG8_WAIT_V(8); PG8_WAIT_L(0); PG8_BAR; PG8_MMA(0, 0, At, B0); PG8_MMA(0, 1, At, B1); PG8_BAR; PG8_SCHED;
            PG8_LDA(At, 0, 1); PG8_STAGE(PG8_SB(0, 0), b2, voffB); PG8_STAGE(PG8_SB(0, 1), b2 + hstep, voffB); PG8_STAGE(PG8_SA(0, 0), a2, x0);
            PG8_WAIT_V(8); PG8_WAIT_L(0); PG8_BAR; PG8_MMA(1, 0, At, B0); PG8_MMA(1, 1, At, B1); PG8_BAR; PG8_SCHED;
            PG8_LDB(B0, 1, 0); PG8_LDB(B1, 1, 1); PG8_SCHED; PG8_LDA(At, 1, 0); PG8_STAGE(PG8_SA(0, 1), a2, x1);
            PG8_WAIT_V(8); PG8_WAIT_L(0); PG8_BAR; PG8_MMA(0, 0, At, B0); PG8_MMA(0, 1, At, B1); PG8_BAR; PG8_SCHED;
            PG8_LDA(At, 1, 1); PG8_STAGE(PG8_SB(1, 0), b3, voffB); PG8_STAGE(PG8_SB(1, 1), b3 + hstep, voffB); PG8_STAGE(PG8_SA(1, 0), a3, x0);
            PG8_WAIT_V(8); PG8_WAIT_L(0); PG8_BAR; PG8_MMA(1, 0, At, B0); PG8_MMA(1, 1, At, B1); PG8_BAR; PG8_SCHED;
        }
        if constexpr (ALIGN_EPI) { if (wr == 0) PG8_BAR; }
        E(acc, cur, wr, wc, fr, fq);
        if (!has_next) break;
        if constexpr (Epi::HAS_INIT) E.init(acc, nxt, wr, wc, fr, fq);
        else {
#pragma unroll
        for (int a = 0; a < 2; ++a)
#pragma unroll
            for (int b = 0; b < 2; ++b)
#pragma unroll
                for (int m = 0; m < 4; ++m)
#pragma unroll
                    for (int n = 0; n < 2; ++n) acc[a][b][m][n] = (f32x4){0.f, 0.f, 0.f, 0.f};
        }
        cur = nxt; cA = nA; cB = nB; ++ui;
        if constexpr (GATHER) { vA[0][0] = nvA[0][0]; vA[0][1] = nvA[0][1]; vA[1][0] = nvA[1][0]; vA[1][1] = nvA[1][1]; }
        if constexpr (ALIGN_EPI) { if (wr == 1) PG8_BAR; }
    }
    PG8_WAIT_V(0);
    if constexpr (!ALIGN_EPI) { if (wr == 0) PG8_BAR; }
    PG8_BAR;
#undef PG8_SA
#undef PG8_SB
#undef PG8_STAGE
#undef PG8_LDA
#undef PG8_LDB
#undef PG8_MMA
#undef PG8_WAIT_V
#undef PG8_WAIT_L
#undef PG8_BAR
#undef PG8_SCHED
}
}

#define EPI_ROWS(ai, m) (u.pm * 256 + (ai) * 128 + wr * 64 + (m) * 16 + fr)
__device__ __forceinline__ u32x4 pack8(const f32x4 a, const f32x4 b) { u32x4 w; w.x = cvt_pk_bf16(a[0], a[1]); w.y = cvt_pk_bf16(a[2], a[3]); w.z = cvt_pk_bf16(b[0], b[1]); w.w = cvt_pk_bf16(b[2], b[3]); return w; }
__device__ __forceinline__ void unpack8(const u32x4 w, f32x4& a, f32x4& b) { a = (f32x4){bf_lo(w.x), bf_hi(w.x), bf_lo(w.y), bf_hi(w.y)}; b = (f32x4){bf_lo(w.z), bf_hi(w.z), bf_lo(w.w), bf_hi(w.w)}; }

struct EpiWin {
    static constexpr bool PERM = true, HAS_INIT = false;
    const float* rstd; bf16_t* v; bf16_t* bg; bf16_t* ub; bf16_t* gates; const float* gate_bias;
    __device__ __forceinline__ void operator()(const f32x4 (&acc)[2][2][4][2], const pg8::Unit& u, int wr, int wc, int fr, int fq) const {
        if (u.pn < 8) {
#pragma unroll
            for (int ai = 0; ai < 2; ++ai)
#pragma unroll
                for (int m = 0; m < 4; ++m) { const int row = EPI_ROWS(ai, m); const float rs = rstd[row], rs2 = rs * rs;
                    const f32x4 a0 = acc[ai][0][m][0] * acc[ai][1][m][0] * rs2, a1 = acc[ai][0][m][1] * acc[ai][1][m][1] * rs2;
                    *(u32x4*)(v + (size_t)row * D + 128 * u.pn + 32 * wc + 8 * fq) = pack8(a0, a1); }
        } else if (u.pn < 14) {
            bf16_t* base; int ld, c0;
            if (u.pn < 12) { base = bg; ld = D; c0 = 256 * (u.pn - 8); } else { base = ub; ld = SW; c0 = 256 * (u.pn - 12); }
#pragma unroll
            for (int ai = 0; ai < 2; ++ai)
#pragma unroll
                for (int m = 0; m < 4; ++m) { const int row = EPI_ROWS(ai, m); const float rs = rstd[row];
#pragma unroll
                    for (int bj = 0; bj < 2; ++bj) *(u32x4*)(base + (size_t)row * ld + c0 + 128 * bj + 32 * wc + 8 * fq) = pack8(acc[ai][bj][m][0] * rs, acc[ai][bj][m][1] * rs); }
        } else {
            const int c0 = 256 * (u.pn - 14) + 32 * wc + 8 * fq;
            f32x4 bv[2][2];
#pragma unroll
            for (int bj = 0; bj < 2; ++bj)
#pragma unroll
                for (int n = 0; n < 2; ++n) bv[bj][n] = *(const f32x4*)(gate_bias + c0 + 128 * bj + 4 * n);
#pragma unroll
            for (int ai = 0; ai < 2; ++ai)
#pragma unroll
                for (int m = 0; m < 4; ++m) { const int row = EPI_ROWS(ai, m); const float rs = rstd[row];
#pragma unroll
                    for (int bj = 0; bj < 2; ++bj) { f32x4 g0 = acc[ai][bj][m][0] * rs + bv[bj][0], g1 = acc[ai][bj][m][1] * rs + bv[bj][1];
#pragma unroll
                        for (int j = 0; j < 4; ++j) { g0[j] = fsigmoid(g0[j]); g1[j] = fsigmoid(g1[j]); }
                        *(u32x4*)(gates + (size_t)row * 2048 + c0 + 128 * bj) = pack8(g0, g1); } }
        }
    }
};
struct EpiGlu {
    static constexpr bool PERM = true, HAS_INIT = false;
    const bf16_t* gates; bf16_t* mb;
    __device__ __forceinline__ void operator()(const f32x4 (&acc)[2][2][4][2], const pg8::Unit& u, int wr, int wc, int fr, int fq) const {
        const int col = 128 * u.pn + 32 * wc + 8 * fq;
#pragma unroll
        for (int ai = 0; ai < 2; ++ai)
#pragma unroll
            for (int m = 0; m < 4; ++m) { const int row = EPI_ROWS(ai, m);
                f32x4 g0, g1; unpack8(*(const u32x4*)(gates + (size_t)row * 2048 + 1024 + col), g0, g1);
                f32x4 y0 = acc[ai][0][m][0], y1 = acc[ai][0][m][1]; const f32x4 b0 = acc[ai][1][m][0], b1 = acc[ai][1][m][1];
#pragma unroll
                for (int j = 0; j < 4; ++j) { y0[j] = y0[j] * fsigmoid(b0[j]) * g0[j]; y1[j] = y1[j] * fsigmoid(b1[j]) * g1[j]; }
                *(u32x4*)(mb + (size_t)row * D + col) = pack8(y0, y1); }
    }
};
struct EpiMix {
    static constexpr bool PERM = true, HAS_INIT = false;
    const bf16_t* gates; const bf16_t* mb; bf16_t* mixed;
    __device__ __forceinline__ void operator()(const f32x4 (&acc)[2][2][4][2], const pg8::Unit& u, int wr, int wc, int fr, int fq) const {
#pragma unroll
        for (int ai = 0; ai < 2; ++ai)
#pragma unroll
            for (int m = 0; m < 4; ++m) { const int row = EPI_ROWS(ai, m);
#pragma unroll
                for (int bj = 0; bj < 2; ++bj) { const int col = 256 * u.pn + 128 * bj + 32 * wc + 8 * fq;
                    f32x4 g0, g1, m0, m1; unpack8(*(const u32x4*)(gates + (size_t)row * 2048 + col), g0, g1); unpack8(*(const u32x4*)(mb + (size_t)row * D + col), m0, m1);
                    *(u32x4*)(mixed + (size_t)row * D + col) = pack8(g0 * acc[ai][bj][m][0] + m0, g1 * acc[ai][bj][m][1] + m1); } }
    }
};
struct EpiX1 {
    static constexpr bool PERM = false, HAS_INIT = true;
    const float* __restrict__ x; float* __restrict__ x1; bf16_t* __restrict__ x1b;
    __device__ __forceinline__ void init(f32x4 (&acc)[2][2][4][2], const pg8::Unit& u, int wr, int wc, int fr, int fq) const {
#pragma unroll
        for (int ai = 0; ai < 2; ++ai)
#pragma unroll
            for (int m = 0; m < 4; ++m)
#pragma unroll
                for (int bj = 0; bj < 2; ++bj)
#pragma unroll
                    for (int n = 0; n < 2; ++n) acc[ai][bj][m][n] = *(const f32x4*)(x + (size_t)EPI_ROWS(ai, m) * D + 256 * u.pn + 128 * bj + 32 * wc + 16 * n + 4 * fq);
    }
    __device__ __forceinline__ void operator()(const f32x4 (&acc)[2][2][4][2], const pg8::Unit& u, int wr, int wc, int fr, int fq) const {
#pragma unroll
        for (int ai = 0; ai < 2; ++ai)
#pragma unroll
            for (int m = 0; m < 4; ++m) { const int row = EPI_ROWS(ai, m);
#pragma unroll
                for (int bj = 0; bj < 2; ++bj)
#pragma unroll
                    for (int n = 0; n < 2; ++n) { const size_t o = (size_t)row * D + 256 * u.pn + 128 * bj + 32 * wc + 16 * n + 4 * fq;
                        const f32x4 r = acc[ai][bj][m][n]; *(f32x4*)(x1 + o) = r;
                        u32x2 w; w.x = cvt_pk_bf16(r[0], r[1]); w.y = cvt_pk_bf16(r[2], r[3]); *(u32x2*)(x1b + o) = w; }
                asm volatile("s_waitcnt vmcnt(24)" ::: "memory"); }
    }
};
struct EpiUp {
    static constexpr bool PERM = true, HAS_INIT = false;
    const int* list; const float* rstd2; bf16_t* hmid;
    __device__ __forceinline__ void operator()(const f32x4 (&acc)[2][2][4][2], const pg8::Unit& u, int wr, int wc, int fr, int fq) const {
        const int col = 128 * u.pn + 32 * wc + 8 * fq;
#pragma unroll
        for (int ai = 0; ai < 2; ++ai)
#pragma unroll
            for (int m = 0; m < 4; ++m) { const int r = ai * 128 + wr * 64 + m * 16 + fr; const bool ok = r < u.nrow;
                const int tok = ok ? list[u.e * T + 256 * u.pm + r] : 0; const float rs = ok ? rstd2[tok] : 0.f;
                f32x4 g0 = acc[ai][0][m][0] * rs, g1 = acc[ai][0][m][1] * rs; const f32x4 u0 = acc[ai][1][m][0] * rs, u1 = acc[ai][1][m][1] * rs;
#pragma unroll
                for (int j = 0; j < 4; ++j) { g0[j] = fsilu(g0[j]) * u0[j]; g1[j] = fsilu(g1[j]) * u1[j]; }
                *(u32x4*)(hmid + (size_t)(u.srow + r) * EFF + col) = pack8(g0, g1); }
    }
};
struct EpiDown {
    static constexpr bool PERM = true, HAS_INIT = false;
    bf16_t* Y;
    __device__ __forceinline__ void operator()(const f32x4 (&acc)[2][2][4][2], const pg8::Unit& u, int wr, int wc, int fr, int fq) const {
#pragma unroll
        for (int ai = 0; ai < 2; ++ai)
#pragma unroll
            for (int m = 0; m < 4; ++m) { const int r = ai * 128 + wr * 64 + m * 16 + fr;
#pragma unroll
                for (int bj = 0; bj < 2; ++bj) *(u32x4*)(Y + (size_t)(u.srow + r) * D + 256 * u.pn + 128 * bj + 32 * wc + 8 * fq) = pack8(acc[ai][bj][m][0], acc[ai][bj][m][1]); }
    }
};

constexpr size_t MiB = 1u << 20;
constexpr size_t WS_CTL = 0, CTL_BYTES = 64 * 1024;
constexpr size_t WS_WIN = 1 * MiB, WS_WC = 12 * MiB, WS_WGLU = 14 * MiB, WS_WO = 16 * MiB;
constexpr size_t WS_RSTD1 = 18 * MiB, WS_RSTD2 = WS_RSTD1 + 64 * 1024, WS_TABA = WS_RSTD2 + 64 * 1024, WS_TABA256 = WS_TABA + 32 * 1024, WS_BBT = WS_TABA256 + 32 * 1024,
                 WS_CT = WS_BBT + 128 * 1024, WS_WRT = WS_CT + 128 * 1024, WS_E = 19 * MiB;
constexpr size_t WS_XB = 20 * MiB, WS_Z = 20 * MiB, WS_WD = 20 * MiB;
constexpr size_t WS_V = 52 * MiB, WS_MIXED = 52 * MiB, WS_Y = 52 * MiB;
constexpr size_t WS_BG = 84 * MiB, WS_MB = 84 * MiB, WS_X1B = 84 * MiB;
constexpr size_t WS_UB = 116 * MiB;
constexpr size_t WS_GATES = 132 * MiB, WS_WGU = 132 * MiB;
constexpr size_t WS_YS = 196 * MiB;
constexpr size_t WS_TOK = 212 * MiB, WS_LIST = 214 * MiB, WS_HMID = 216 * MiB, WS_END = 256 * MiB;
constexpr int CW_CNT = 64;
constexpr int CW_BAR = 4096;
constexpr int RING_BYTES = 131072, MISC_OFF = RING_BYTES, LDS_BYTES = 147456;

#define XB_TMO      128
#define XB_XCNT(j)  (256  + 64 * (j))
#define XB_XSUB(j)  (1280 + 64 * (j))
#define XB_XGEN(j)  (2304 + 64 * (j))
#define XB_TOP      3328
#define XB_TOPGEN   3392
#define XCD_BAR_WORDS 3456
#define XB_SPIN_CAP (1u << 18)
__device__ __forceinline__ unsigned xb_ld(unsigned* p)              { return __hip_atomic_load(p, __ATOMIC_RELAXED, __HIP_MEMORY_SCOPE_AGENT); }
__device__ __forceinline__ unsigned xb_add(unsigned* p, unsigned v) { return __hip_atomic_fetch_add(p, v, __ATOMIC_RELAXED, __HIP_MEMORY_SCOPE_AGENT); }
__device__ __forceinline__ unsigned xb_xcc_id() { return (unsigned)__builtin_amdgcn_s_getreg((3 << 11) | 20) & 0xFu; }
#define XB_SPIN(cond, bar) do { unsigned _sp = 0; while (cond) { __builtin_amdgcn_s_sleep(1); \
    if ((++_sp & 255u) == 0u) { if (xb_ld(&(bar)[XB_TMO])) break; if (_sp > XB_SPIN_CAP) { atomicAdd(&(bar)[XB_TMO], 1u); break; } } } } while (0)
struct XcdBarrier { unsigned* bar; unsigned x; volatile LAS unsigned* st; };
__device__ __forceinline__ XcdBarrier xcd_barrier_post(unsigned* bar, volatile LAS unsigned* st) {
    XcdBarrier b; b.bar = bar; b.x = xb_xcc_id(); b.st = st;
    if (threadIdx.x == 0) (void)xb_add(&bar[XB_XCNT(b.x)], 1u);
    return b;
}
__device__ __forceinline__ void xcd_barrier_complete(unsigned* bar, unsigned x, unsigned& nloc, unsigned& nx) {
    const unsigned G = gridDim.x * gridDim.y * gridDim.z;
    unsigned sum, cnt, mine, sp = 0u;
    for (;;) {
        sum = 0u; cnt = 0u; mine = 0u;
#pragma unroll
        for (unsigned j = 0; j < 16; ++j) { const unsigned c = xb_ld(&bar[XB_XCNT(j)]); sum += c; cnt += (c > 0u) ? 1u : 0u; mine = (j == x) ? c : mine; }
        if (sum == G) break;
        __builtin_amdgcn_s_sleep(1);
        if ((++sp & 255u) == 0u) { if (xb_ld(&bar[XB_TMO])) break; if (sp > XB_SPIN_CAP) { atomicAdd(&bar[XB_TMO], 1u); break; } }
    }
    nloc = mine > 0u ? mine : 1u; nx = cnt > 0u ? cnt : 1u;
}
__device__ __forceinline__ void xcd_barrier(const XcdBarrier& b) {
    asm volatile("s_waitcnt vmcnt(0)" ::: "memory");
    __syncthreads();
    if (threadIdx.x == 0) {
        unsigned* bar = b.bar;
        __builtin_amdgcn_s_waitcnt(0);
        unsigned nloc = b.st[0], nx = b.st[1];
        if (nloc == 0u) { xcd_barrier_complete(bar, b.x, nloc, nx); b.st[0] = nloc; b.st[1] = nx; }
        const unsigned old = xb_add(&bar[XB_XSUB(b.x)], 1u);
        const unsigned gen = old / nloc;
        if (old + 1u == (gen + 1u) * nloc) {
            __builtin_amdgcn_fence(__ATOMIC_RELEASE, "agent");
            asm volatile("s_waitcnt vmcnt(0)" ::: "memory");
            const unsigned og = xb_add(&bar[XB_TOP], 1u);
            const unsigned tg = og / nx;
            if (og + 1u == (tg + 1u) * nx) xb_add(&bar[XB_TOPGEN], 1u);
            else XB_SPIN(xb_ld(&bar[XB_TOPGEN]) == tg, bar);
            __builtin_amdgcn_fence(__ATOMIC_ACQUIRE, "agent");
            xb_add(&bar[XB_XGEN(b.x)], 1u);
            asm volatile("s_waitcnt vmcnt(0)" ::: "memory");
        } else {
            XB_SPIN(xb_ld(&bar[XB_XGEN(b.x)]) == gen, bar);
            __builtin_amdgcn_fence(__ATOMIC_ACQUIRE, "agent");
            asm volatile("s_waitcnt vmcnt(0)" ::: "memory");
        }
    }
    __syncthreads();
}

struct Args { const float* in[27]; float* out; unsigned char* ws; int ph_lo, ph_hi, use_bar, pad; };
struct Frame {
    LAS unsigned char* lds; volatile LAS unsigned* MISC; unsigned* ctl; unsigned char* ws;
    int tid, lane, wave, G;
};

__device__ __forceinline__ void tr64(const float* __restrict__ src, int ld, int col0, int k0, const float* __restrict__ scale, bf16_t* __restrict__ dst, size_t drow0, int Kdst, LAS unsigned char* scr, int lane) {
    const float* s = src + (size_t)k0 * ld + col0 + lane;
#pragma unroll
    for (int hh = 0; hh < 2; ++hh) {
        float v[32];
#pragma unroll
        for (int kk = 0; kk < 32; ++kk) v[kk] = s[(size_t)(32 * hh + kk) * ld];
        if (scale) {
#pragma unroll
            for (int kk = 0; kk < 32; ++kk) v[kk] *= scale[k0 + 32 * hh + kk];
        }
#pragma unroll
        for (int c = 0; c < 4; ++c) { u32x4 o; o.x = cvt_pk_bf16(v[8 * c + 0], v[8 * c + 1]); o.y = cvt_pk_bf16(v[8 * c + 2], v[8 * c + 3]); o.z = cvt_pk_bf16(v[8 * c + 4], v[8 * c + 5]); o.w = cvt_pk_bf16(v[8 * c + 6], v[8 * c + 7]);
            *(LAS u32x4*)(scr + lane * 144 + 16 * (4 * hh + c)) = o; }
        asm volatile("s_waitcnt vmcnt(0)" ::: "memory");
    }
    asm volatile("s_waitcnt lgkmcnt(0)" ::: "memory");
#pragma unroll
    for (int j = 0; j < 8; ++j) { const int row = 8 * j + (lane >> 3); const u32x4 o = *(const LAS u32x4*)(scr + row * 144 + 16 * (lane & 7));
        *(u32x4*)(dst + (drow0 + row) * (size_t)Kdst + k0 + 8 * (lane & 7)) = o; }
    asm volatile("s_waitcnt lgkmcnt(0)" ::: "memory");
}

__device__ __forceinline__ void p0_prologue(const Frame& F, const Args& a) {
    LAS unsigned char* scr = F.lds + F.wave * 16384;
    const int gw = blockIdx.x * 8 + F.wave, NGW = F.G * 8;
    bf16_t* Win_t = (bf16_t*)(F.ws + WS_WIN); bf16_t* Wc_t = (bf16_t*)(F.ws + WS_WC); bf16_t* Wglu_t = (bf16_t*)(F.ws + WS_WGLU); bf16_t* Wo_t = (bf16_t*)(F.ws + WS_WO);
    constexpr int I_WIN = 16 * 88, I_WC = 16 * 16, I_WO = 16 * 16, I_GLU = 8 * 32;
    for (int it = gw; it < I_WIN + I_WC + I_WO + I_GLU; it += NGW) {
        int r = it;
        if (r < I_WIN) { const int kb = r / 88, nb = r % 88, j0 = 64 * nb; int col0;
            if (j0 < 2048) { const int pn = j0 >> 8, i = j0 & 255; col0 = (i < 128) ? (128 * pn + i) : (2048 + 128 * pn + (i - 128)); } else if (j0 < 3072) col0 = j0 - 1024; else col0 = j0;
            tr64(a.in[2], INC, col0, 64 * kb, a.in[1], Win_t, (size_t)j0, D, scr, F.lane); continue; }
        r -= I_WIN;
        if (r < I_WC) { tr64(a.in[5], D, 64 * (r % 16), 64 * (r / 16), nullptr, Wc_t, (size_t)(64 * (r % 16)), D, scr, F.lane); continue; }
        r -= I_WC;
        if (r < I_WO) { tr64(a.in[17], D, 64 * (r % 16), 64 * (r / 16), nullptr, Wo_t, (size_t)(64 * (r % 16)), D, scr, F.lane); continue; }
        r -= I_WO;
        { const int kb = r / 32, nb = r % 32, j0 = 64 * nb, pn = j0 >> 8, i = j0 & 255;
          tr64(i < 128 ? a.in[14] : a.in[15], D, 128 * pn + (i & 127), 64 * kb, nullptr, Wglu_t, (size_t)j0, SW, scr, F.lane); }
    }
    { const float* x = a.in[0]; bf16_t* xb = (bf16_t*)(F.ws + WS_XB); float* rstd1 = (float*)(F.ws + WS_RSTD1);
      for (int m = gw; m < T; m += NGW) {
          const f32x4* xr = (const f32x4*)(x + (size_t)m * D) + F.lane; f32x4 v[4]; float s = 0.f;
#pragma unroll
          for (int j = 0; j < 4; ++j) { v[j] = xr[64 * j]; s += (v[j][0] * v[j][0] + v[j][1] * v[j][1]) + (v[j][2] * v[j][2] + v[j][3] * v[j][3]); }
          const float rs = rsqrtf(wave_sum64(s) * (1.f / D) + EPS);
          u32x2* o = (u32x2*)(xb + (size_t)m * D) + F.lane;
#pragma unroll
          for (int j = 0; j < 4; ++j) { u32x2 w; w.x = cvt_pk_bf16(v[j][0], v[j][1]); w.y = cvt_pk_bf16(v[j][2], v[j][3]); o[64 * j] = w; }
          if (F.lane == 0) rstd1[m] = rs; } }
    { bf16_t* wrt = (bf16_t*)(F.ws + WS_WRT); const float* g2 = a.in[18];
      for (int i = blockIdx.x * 512 + F.tid; i < 48 * D; i += F.G * 512) { const int j = i / D, k = i % D; float w = 0.f;
          if (j < 4) w = a.in[19][k * 4 + j]; else if (j < 36) w = a.in[21][k * 32 + (j - 4)];
          wrt[i] = (bf16_t)(cvt_pk_bf16(w * g2[k], 0.f) & 0xffffu); } }
    { float* tab_a = (float*)(F.ws + WS_TABA); float* tab_a256 = (float*)(F.ws + WS_TABA256); bf16_t* BbT = (bf16_t*)(F.ws + WS_BBT); bf16_t* Ct = (bf16_t*)(F.ws + WS_CT);
      for (int i = blockIdx.x * 512 + F.tid; i < NG * NS; i += F.G * 512) { const int g = i / NS, n = i % NS;
          const double lr = a.in[6][i], li = a.in[7][i], dt = exp((double)a.in[8][g]);
          const double er = exp(lr * dt), cr = er * cos(li * dt), ci = er * sin(li * dt);
          const double e16 = exp(lr * dt * 16.0), e256 = exp(lr * dt * 256.0);
          tab_a[i * 4 + 0] = (float)cr; tab_a[i * 4 + 1] = (float)ci; tab_a[i * 4 + 2] = (float)(e16 * cos(li * dt * 16.0)); tab_a[i * 4 + 3] = (float)(e16 * sin(li * dt * 16.0));
          tab_a256[i * 2 + 0] = (float)(e256 * cos(li * dt * 256.0)); tab_a256[i * 2 + 1] = (float)(e256 * sin(li * dt * 256.0));
          const double nr = cr - 1.0, ni = ci, den = lr * lr + li * li; const double kr = (nr * lr + ni * li) / den, ki = (ni * lr - nr * li) / den;
          for (int h = 0; h < NH; ++h) { const double br = a.in[9][i * NH + h], bi = a.in[10][i * NH + h];
              const float bbr = (float)(kr * br - ki * bi), bbi = (float)(kr * bi + ki * br);
              BbT[((size_t)(g * 4 + 0 + (n >> 5)) * 32 + (n & 31)) * 16 + h] = (bf16_t)(cvt_pk_bf16(bbr, 0.f) & 0xffffu);
              BbT[((size_t)(g * 4 + 2 + (n >> 5)) * 32 + (n & 31)) * 16 + h] = (bf16_t)(cvt_pk_bf16(bbi, 0.f) & 0xffffu);
              Ct[(size_t)(g * NH + h) * 128 + 2 * n] = (bf16_t)(cvt_pk_bf16(a.in[11][(g * NH + h) * NS + n], 0.f) & 0xffffu);
              Ct[(size_t)(g * NH + h) * 128 + 2 * n + 1] = (bf16_t)(cvt_pk_bf16(-a.in[12][(g * NH + h) * NS + n], 0.f) & 0xffffu); } } }
}

__device__ __forceinline__ void p2_conv(const Frame& F, const Args& a) {
    const bf16_t* v = (const bf16_t*)(F.ws + WS_V); const bf16_t* bg = (const bf16_t*)(F.ws + WS_BG); bf16_t* z = (bf16_t*)(F.ws + WS_Z);
    const float* cw = a.in[3]; const float* cb = a.in[4];
    const int gw = blockIdx.x * 8 + F.wave, NGW = F.G * 8;
    for (int it = gw; it < (T / 8) * 2; it += NGW) {
        const int t0 = (it >> 1) * 8, ch = (it & 1) * 512 + F.lane * 8;
        f32x4 w0a = *(const f32x4*)(cw + ch), w0b = *(const f32x4*)(cw + ch + 4), w1a = *(const f32x4*)(cw + D + ch), w1b = *(const f32x4*)(cw + D + ch + 4);
        f32x4 w2a = *(const f32x4*)(cw + 2 * D + ch), w2b = *(const f32x4*)(cw + 2 * D + ch + 4), ba = *(const f32x4*)(cb + ch), bb = *(const f32x4*)(cb + ch + 4);
        f32x4 p2a = {0.f, 0.f, 0.f, 0.f}, p2b = p2a, p1a = p2a, p1b = p2a;
        if (t0 >= 2) { unpack8(*(const u32x4*)(v + (size_t)(t0 - 2) * D + ch), p2a, p2b); unpack8(*(const u32x4*)(v + (size_t)(t0 - 1) * D + ch), p1a, p1b); }
#pragma unroll
        for (int i = 0; i < 8; ++i) { f32x4 ca, cbv, ga, gb; unpack8(*(const u32x4*)(v + (size_t)(t0 + i) * D + ch), ca, cbv); unpack8(*(const u32x4*)(bg + (size_t)(t0 + i) * D + ch), ga, gb);
            const f32x4 ya = ga * (w0a * p2a + w1a * p1a + w2a * ca + ba), yb = gb * (w0b * p2b + w1b * p1b + w2b * cbv + bb);
            *(u32x4*)(z + (size_t)(t0 + i) * D + ch) = pack8(ya, yb);
            p2a = p1a; p2b = p1b; p1a = ca; p1b = cbv; }
    }
}

__device__ __forceinline__ int tokmap(int r) { return 16 * ((r >> 2) & 1) + 4 * (r >> 3) + (r & 3); }
template <int PASS>
__device__ __forceinline__ void scan_tile(f32x16& re, f32x16& im, const f32x4 c, float& Rr, float& Ri, int hf) {
    const float ar = c[0], ai = c[1];
    float sr = hf ? 0.f : Rr, si = hf ? 0.f : Ri;
#pragma unroll
    for (int q = 0; q < 16; ++q) { const float nr = ar * sr - ai * si + re[q], ni = ar * si + ai * sr + im[q]; sr = nr; si = ni; re[q] = sr; im[q] = si; }
    const float orr = __shfl_xor(sr, 32), oii = __shfl_xor(si, 32);
    Rr = c[2] * sr - c[3] * si + orr; Ri = c[2] * si + c[3] * sr + oii;
    if (PASS == 2) {
        float cr = hf ? orr : 0.f, ci = hf ? oii : 0.f;
#pragma unroll
        for (int q = 0; q < 16; ++q) { const float nr = ar * cr - ai * ci, ni = ar * ci + ai * cr; cr = nr; ci = ni; re[q] += cr; im[q] += ci; }
    }
}
template <int PASS>
__device__ __forceinline__ void ssm_pass(const Frame& F, const Args& a) {
    const int lane = F.lane, hf = lane >> 5, col = lane & 31;
    const f32x4* tab_a = (const f32x4*)(F.ws + WS_TABA); const float2* tab_a256 = (const float2*)(F.ws + WS_TABA256);
    const bf16_t* BbT = (const bf16_t*)(F.ws + WS_BBT); const bf16_t* Ct = (const bf16_t*)(F.ws + WS_CT);
    const bf16_t* ub = (const bf16_t*)(F.ws + WS_UB); bf16_t* ys = (bf16_t*)(F.ws + WS_YS); float* E = (float*)(F.ws + WS_E);
    LAS unsigned char* sl = F.lds + F.wave * 8704;
    for (int id = blockIdx.x * 8 + F.wave; id < NG * (T / 256); id += F.G * 8) {
        const int g = id & 31, r = id >> 5;
        const f32x4 c0 = tab_a[g * NS + col], c1 = tab_a[g * NS + 32 + col];
        bf16x8 Bf[4];
#pragma unroll
        for (int q = 0; q < 4; ++q) Bf[q] = *(const bf16x8*)(BbT + ((size_t)(g * 4 + q) * 32 + col) * 16 + 8 * hf);
        float R0r = 0.f, R0i = 0.f, R1r = 0.f, R1i = 0.f;
        bf16x8 Cf[4], Df;
        if (PASS == 2) {
            const float2 p0 = tab_a256[g * NS + col], p1 = tab_a256[g * NS + 32 + col];
            for (int j = 0; j < r; ++j) {
                const float2 e0 = *(const float2*)(E + ((size_t)(j * NG + g) * NS + col) * 2), e1 = *(const float2*)(E + ((size_t)(j * NG + g) * NS + 32 + col) * 2);
                const float t0r = p0.x * R0r - p0.y * R0i + e0.x, t0i = p0.x * R0i + p0.y * R0r + e0.y; R0r = t0r; R0i = t0i;
                const float t1r = p1.x * R1r - p1.y * R1i + e1.x, t1i = p1.x * R1i + p1.y * R1r + e1.y; R1r = t1r; R1i = t1i; }
#pragma unroll
            for (int kb = 0; kb < 4; ++kb) Cf[kb] = *(const bf16x8*)(Ct + (size_t)(g * NH + (lane & 15)) * 128 + kb * 32 + 8 * (lane >> 4));
            const unsigned dbits = cvt_pk_bf16(a.in[13][g * NH + (lane & 15)], 0.f) & 0xffffu;
#pragma unroll
            for (int jj = 0; jj < 8; ++jj) Df[jj] = (short)((lane < 32 && (8 * (lane >> 4) + jj) == (lane & 15)) ? dbits : 0u);
        }
        for (int c = 0; c < 8; ++c) {
            const int t0 = r * 256 + c * 32;
            const bf16x8 Ua = *(const bf16x8*)(ub + (size_t)(t0 + tokmap(col)) * SW + g * NH + 8 * hf);
            const f32x16 zz = {0.f, 0.f, 0.f, 0.f, 0.f, 0.f, 0.f, 0.f, 0.f, 0.f, 0.f, 0.f, 0.f, 0.f, 0.f, 0.f};
            f32x16 bu0 = __builtin_amdgcn_mfma_f32_32x32x16_bf16(Ua, Bf[0], zz, 0, 0, 0);
            f32x16 bu1 = __builtin_amdgcn_mfma_f32_32x32x16_bf16(Ua, Bf[1], zz, 0, 0, 0);
            f32x16 bu2 = __builtin_amdgcn_mfma_f32_32x32x16_bf16(Ua, Bf[2], zz, 0, 0, 0);
            f32x16 bu3 = __builtin_amdgcn_mfma_f32_32x32x16_bf16(Ua, Bf[3], zz, 0, 0, 0);
            scan_tile<PASS>(bu0, bu2, c0, R0r, R0i, hf);
            scan_tile<PASS>(bu1, bu3, c1, R1r, R1i, hf);
            if (PASS == 2) {
                LAS unsigned* sw = (LAS unsigned*)sl;
#pragma unroll
                for (int q = 0; q < 16; ++q) { sw[(16 * hf + q) * 68 + col] = cvt_pk_bf16(bu0[q], bu2[q]); sw[(16 * hf + q) * 68 + 32 + col] = cvt_pk_bf16(bu1[q], bu3[q]); }
                asm volatile("s_waitcnt lgkmcnt(0)" ::: "memory");
#pragma unroll
                for (int mt = 0; mt < 2; ++mt) {
                    f32x4 y = {0.f, 0.f, 0.f, 0.f};
#pragma unroll
                    for (int kb = 0; kb < 4; ++kb) { const bf16x8 Af = *(const LAS bf16x8*)(sl + ((16 * mt + (lane & 15)) * 68 + kb * 16 + 4 * (lane >> 4)) * 4);
                        y = __builtin_amdgcn_mfma_f32_16x16x32_bf16(Af, Cf[kb], y, 0, 0, 0); }
                    bf16x8 A2 = {0, 0, 0, 0, 0, 0, 0, 0};
                    if (lane < 32) A2 = *(const bf16x8*)(ub + (size_t)(t0 + 16 * mt + (lane & 15)) * SW + g * NH + 8 * (lane >> 4));
                    y = __builtin_amdgcn_mfma_f32_16x16x32_bf16(A2, Df, y, 0, 0, 0);
#pragma unroll
                    for (int j = 0; j < 4; ++j) ys[(size_t)(t0 + 16 * mt + 4 * (lane >> 4) + j) * SW + g * NH + (lane & 15)] = (bf16_t)(cvt_pk_bf16(fgelu_tanh(y[j]), 0.f) & 0xffffu);
                }
                asm volatile("s_waitcnt lgkmcnt(0)" ::: "memory");
            }
        }
        if (PASS == 1 && hf == 0) {
            *(float2*)(E + ((size_t)(r * NG + g) * NS + col) * 2) = make_float2(R0r, R0i);
            *(float2*)(E + ((size_t)(r * NG + g) * NS + 32 + col) * 2) = make_float2(R1r, R1i);
        }
    }
}

__device__ __forceinline__ void p6_route(const Frame& F, const Args& a) {
    const bf16_t* x1b = (const bf16_t*)(F.ws + WS_X1B); const bf16_t* wrt = (const bf16_t*)(F.ws + WS_WRT); float* rstd2 = (float*)(F.ws + WS_RSTD2);
    int* cnt = (int*)(F.ctl + CW_CNT); int* list = (int*)(F.ws + WS_LIST);
    int* tok_e = (int*)(F.ws + WS_TOK); int* tok_pos = tok_e + 2 * T; float* tok_w = (float*)(tok_pos + 2 * T);
    volatile LAS int* lcnt = (volatile LAS int*)(F.MISC + 96); volatile LAS int* lbase = (volatile LAS int*)(F.MISC + 128);
    LAS float* lg = (LAS float*)(F.lds + F.wave * 4096);
    const int lane = F.lane;
    for (int blk = blockIdx.x; blk < T / 128; blk += F.G) {
        if (F.tid < 32) lcnt[F.tid] = 0;
        __syncthreads();
        const int tok0 = blk * 128 + F.wave * 16;
        f32x4 acc[3]; float ssq = 0.f;
#pragma unroll
        for (int n = 0; n < 3; ++n) acc[n] = (f32x4){0.f, 0.f, 0.f, 0.f};
        for (int kb = 0; kb < 32; ++kb) {
            const u32x4 aw = *(const u32x4*)(x1b + (size_t)(tok0 + (lane & 15)) * D + kb * 32 + 8 * (lane >> 4));
            f32x4 p, q; unpack8(aw, p, q); ssq += (p[0] * p[0] + p[1] * p[1]) + (p[2] * p[2] + p[3] * p[3]) + (q[0] * q[0] + q[1] * q[1]) + (q[2] * q[2] + q[3] * q[3]);
            bf16x8 Af; Af = __builtin_bit_cast(bf16x8, aw);
#pragma unroll
            for (int n = 0; n < 3; ++n) { const bf16x8 Bfr = *(const bf16x8*)(wrt + (size_t)(n * 16 + (lane & 15)) * D + kb * 32 + 8 * (lane >> 4));
                acc[n] = __builtin_amdgcn_mfma_f32_16x16x32_bf16(Af, Bfr, acc[n], 0, 0, 0); }
        }
        ssq += __shfl_xor(ssq, 16); ssq += __shfl_xor(ssq, 32);
        const float rs = rsqrtf(ssq * (1.f / D) + EPS);
#pragma unroll
        for (int n = 0; n < 3; ++n)
#pragma unroll
            for (int j = 0; j < 4; ++j) lg[(4 * (lane >> 4) + j) * 52 + n * 16 + (lane & 15)] = acc[n][j];
        asm volatile("s_waitcnt lgkmcnt(0)" ::: "memory");
        int e1 = 0, e2 = 0, rk1 = 0, rk2 = 0; float wt1 = 0.f, wt2 = 0.f;
        if (lane < 16) {
            const LAS float* my = lg + lane * 52;
            float l0 = my[0] * rs + a.in[20][0], l1 = my[1] * rs + a.in[20][1], l2 = my[2] * rs + a.in[20][2], l3 = my[3] * rs + a.in[20][3];
            int gi = 0; float lmax = l0;
            if (l1 > lmax) { lmax = l1; gi = 1; } if (l2 > lmax) { lmax = l2; gi = 2; } if (l3 > lmax) { lmax = l3; gi = 3; }
            const float se = __expf(l0 - lmax) + __expf(l1 - lmax) + __expf(l2 - lmax) + __expf(l3 - lmax);
            const float pg = 1.f / se;
            float v1 = -3.0e38f, v2 = -3.0e38f; int i1 = 0, i2 = 0;
#pragma unroll
            for (int j = 0; j < 8; ++j) { const float vv = my[4 + gi * 8 + j] * rs + a.in[22][gi * 8 + j];
                if (vv > v1) { v2 = v1; i2 = i1; v1 = vv; i1 = j; } else if (vv > v2) { v2 = vv; i2 = j; } }
            const float w1 = 1.f / (1.f + __expf(v2 - v1));
            e1 = gi * 8 + i1; e2 = gi * 8 + i2; wt1 = pg * w1; wt2 = pg * (1.f - w1);
            rk1 = __hip_atomic_fetch_add((LAS int*)&lcnt[e1], 1, __ATOMIC_RELAXED, __HIP_MEMORY_SCOPE_WORKGROUP);
            rk2 = __hip_atomic_fetch_add((LAS int*)&lcnt[e2], 1, __ATOMIC_RELAXED, __HIP_MEMORY_SCOPE_WORKGROUP);
            rstd2[tok0 + lane] = rs;
        }
        __syncthreads();
        if (F.tid < 32) { const int c = lcnt[F.tid]; lbase[F.tid] = c ? __hip_atomic_fetch_add(&cnt[F.tid], c, __ATOMIC_RELAXED, __HIP_MEMORY_SCOPE_AGENT) : 0; }
        __syncthreads();
        if (lane < 16) { const int t = tok0 + lane; const int p1 = lbase[e1] + rk1, p2 = lbase[e2] + rk2;
            list[e1 * T + p1] = t; list[e2 * T + p2] = t;
            tok_e[2 * t] = e1; tok_e[2 * t + 1] = e2; tok_pos[2 * t] = p1; tok_pos[2 * t + 1] = p2; tok_w[2 * t] = wt1; tok_w[2 * t + 1] = wt2; }
        __syncthreads();
    }
}
__device__ __forceinline__ void p6_convert(const Frame& F, const Args& a) {
    LAS unsigned char* scr = F.lds + F.wave * 16384;
    bf16_t* Wgu_t = (bf16_t*)(F.ws + WS_WGU); bf16_t* Wd_t = (bf16_t*)(F.ws + WS_WD);
    const int gw = blockIdx.x * 8 + F.wave, NGW = F.G * 8;
    constexpr int I_GU = NE * 16 * 16, I_D = NE * 8 * 16;
    for (int it = gw; it < I_GU + I_D; it += NGW) {
        if (it < I_GU) { const int e = it / 256, r = it % 256, kb = r / 16, nb = r % 16, j0 = 64 * nb, pn = j0 >> 8, i = j0 & 255;
            tr64((i < 128 ? a.in[23] : a.in[24]) + (size_t)e * D * EFF, EFF, 128 * pn + (i & 127), 64 * kb, a.in[18], Wgu_t, (size_t)e * 1024 + j0, D, scr, F.lane); }
        else { const int q = it - I_GU, e = q / 128, r = q % 128, kb = r / 16, nb = r % 16;
            tr64(a.in[25] + (size_t)e * EFF * D, D, 64 * nb, 64 * kb, nullptr, Wd_t, (size_t)e * 1024 + 64 * nb, EFF, scr, F.lane); }
    }
}
__device__ __forceinline__ void load_tb(const Frame& F) {
    volatile LAS int* tb = (volatile LAS int*)(F.MISC + 16); volatile LAS int* lc = (volatile LAS int*)(F.MISC + 64);
    if (F.tid < 32) lc[F.tid] = (int)__hip_atomic_load(F.ctl + CW_CNT + F.tid, __ATOMIC_RELAXED, __HIP_MEMORY_SCOPE_AGENT);
    __syncthreads();
    if (F.tid == 0) { int s = 0; for (int e = 0; e < 32; ++e) { tb[e] = s; s += (lc[e] + 255) >> 8; } tb[32] = s; }
    __syncthreads();
}
__device__ __forceinline__ void p9_final(const Frame& F, const Args& a) {
    const LAS int* tb = (const LAS int*)(F.MISC + 16);
    const int* tok_e = (const int*)(F.ws + WS_TOK); const int* tok_pos = tok_e + 2 * T; const float* tok_w = (const float*)(tok_pos + 2 * T);
    const bf16_t* Y = (const bf16_t*)(F.ws + WS_Y); const float* gf = a.in[26]; float* out = a.out;
    const int gw = blockIdx.x * 8 + F.wave, NGW = F.G * 8;
    for (int t = gw; t < T; t += NGW) {
        const int s1 = 256 * tb[tok_e[2 * t]] + tok_pos[2 * t], s2 = 256 * tb[tok_e[2 * t + 1]] + tok_pos[2 * t + 1];
        const float w1 = tok_w[2 * t], w2 = tok_w[2 * t + 1];
        f32x4 va[2], vb[2]; float s = 0.f;
#pragma unroll
        for (int j = 0; j < 2; ++j) { const int c = 8 * F.lane + 512 * j; f32x4 ya, yb, za, zb;
            unpack8(*(const u32x4*)(Y + (size_t)s1 * D + c), ya, yb); unpack8(*(const u32x4*)(Y + (size_t)s2 * D + c), za, zb);
            va[j] = *(const f32x4*)(out + (size_t)t * D + c) + w1 * ya + w2 * za; vb[j] = *(const f32x4*)(out + (size_t)t * D + c + 4) + w1 * yb + w2 * zb;
            s += (va[j][0] * va[j][0] + va[j][1] * va[j][1]) + (va[j][2] * va[j][2] + va[j][3] * va[j][3]) + (vb[j][0] * vb[j][0] + vb[j][1] * vb[j][1]) + (vb[j][2] * vb[j][2] + vb[j][3] * vb[j][3]); }
        const float rs = rsqrtf(wave_sum64(s) * (1.f / D) + EPS);
#pragma unroll
        for (int j = 0; j < 2; ++j) { const int c = 8 * F.lane + 512 * j;
            *(f32x4*)(out + (size_t)t * D + c) = va[j] * rs * *(const f32x4*)(gf + c); *(f32x4*)(out + (size_t)t * D + c + 4) = vb[j] * rs * *(const f32x4*)(gf + c + 4); }
    }
}

__global__ void __launch_bounds__(512, 2) mega_fwd(Args args) {
    extern __shared__ __attribute__((aligned(16))) unsigned char lds_raw[];
    Frame F;
    F.lds = (LAS unsigned char*)lds_raw; F.MISC = (volatile LAS unsigned*)(F.lds + MISC_OFF);
    F.tid = threadIdx.x; F.lane = F.tid & 63; F.wave = __builtin_amdgcn_readfirstlane(F.tid >> 6); F.G = gridDim.x;
    F.ws = args.ws; F.ctl = (unsigned*)(args.ws + WS_CTL);
    for (int u = F.tid; u < (LDS_BYTES - MISC_OFF) / 4; u += 512) ((LAS unsigned*)(F.lds + MISC_OFF))[u] = 0u;
    __syncthreads();
    XcdBarrier bar; bar.bar = F.ctl + CW_BAR; bar.x = 0; bar.st = nullptr;
    if (args.use_bar) bar = xcd_barrier_post(F.ctl + CW_BAR, F.MISC + 0);
    const int lo = args.ph_lo, hi = args.ph_hi;
#define IN(k) (lo <= (k) && (k) < hi)
#define SEAM(k) do { if (IN(k) && IN((k) + 1)) xcd_barrier(bar); } while (0)
    unsigned char* ws = args.ws;
    const int c = (int)blockIdx.x;

    if (IN(0)) { p0_prologue(F, args); }
    SEAM(0);
    if (IN(1)) {
        pg8::DenseOrder S{(const char*)(ws + WS_XB), (const char*)(ws + WS_WIN), D, T / 256, INC / 256, 1, F.G, c};
        EpiWin E{(const float*)(ws + WS_RSTD1), (bf16_t*)(ws + WS_V), (bf16_t*)(ws + WS_BG), (bf16_t*)(ws + WS_UB), (bf16_t*)(ws + WS_GATES), args.in[16]};
        pg8::gemm_phase<EpiWin, pg8::DenseOrder, false, true>(F.lds, D, S, E);
    }
    SEAM(1);
    if (IN(2)) { p2_conv(F, args); ssm_pass<1>(F, args); }
    SEAM(2);
    if (IN(3)) { ssm_pass<2>(F, args); }
    SEAM(3);
    if (IN(4)) {
        { pg8::DenseOrder S{(const char*)(ws + WS_YS), (const char*)(ws + WS_WGLU), SW, T / 256, 4, 2, F.G, c};
          EpiGlu E{(const bf16_t*)(ws + WS_GATES), (bf16_t*)(ws + WS_MB)};
          pg8::gemm_phase<EpiGlu, pg8::DenseOrder, false, true>(F.lds, SW, S, E); }
        asm volatile("s_waitcnt vmcnt(0)" ::: "memory"); __syncthreads();
        { pg8::DenseOrder S{(const char*)(ws + WS_Z), (const char*)(ws + WS_WC), D, T / 256, 4, 1, F.G, c};
          EpiMix E{(const bf16_t*)(ws + WS_GATES), (const bf16_t*)(ws + WS_MB), (bf16_t*)(ws + WS_MIXED)};
          pg8::gemm_phase<EpiMix, pg8::DenseOrder, false, true>(F.lds, D, S, E); }
    }
    SEAM(4);
    if (IN(5)) {
        pg8::DenseOrder S{(const char*)(ws + WS_MIXED), (const char*)(ws + WS_WO), D, T / 256, 4, 1, F.G, c};
        EpiX1 E{args.in[0], args.out, (bf16_t*)(ws + WS_X1B)};
        pg8::gemm_phase<EpiX1, pg8::DenseOrder, false, true>(F.lds, D, S, E);
    }
    SEAM(5);
    if (IN(6)) { p6_route(F, args); p6_convert(F, args); }
    SEAM(6);
    if (IN(7)) {
        load_tb(F);
        pg8::MoEOrder S{(const LAS int*)(F.MISC + 16), (const LAS int*)(F.MISC + 64), (const int*)(ws + WS_LIST), (const char*)(ws + WS_X1B), (const char*)(ws + WS_WGU), D, (size_t)1024 * D * 2, F.G, c, true};
        EpiUp E{(const int*)(ws + WS_LIST), (const float*)(ws + WS_RSTD2), (bf16_t*)(ws + WS_HMID)};
        pg8::gemm_phase<EpiUp, pg8::MoEOrder, true, true>(F.lds, D, S, E);
    }
    SEAM(7);
    if (IN(8)) {
        load_tb(F);
        pg8::MoEOrder S{(const LAS int*)(F.MISC + 16), (const LAS int*)(F.MISC + 64), (const int*)(ws + WS_LIST), (const char*)(ws + WS_HMID), (const char*)(ws + WS_WD), EFF, (size_t)1024 * EFF * 2, F.G, c, false};
        EpiDown E{(bf16_t*)(ws + WS_Y)};
        pg8::gemm_phase<EpiDown, pg8::MoEOrder, false, true>(F.lds, EFF, S, E);
    }
    SEAM(8);
    if (IN(9)) { load_tb(F); p9_final(F, args); }
#undef IN
#undef SEAM
}

#ifndef MK_MODE
#define MK_MODE 2
#endif
extern "C" void kernel_launch(void* const* d_in, const int* in_sizes, int n_in, void* d_out, int out_size, void* d_ws, size_t ws_size, hipStream_t stream) {
    static int grid = 0;
    if (grid == 0) {
        int dev = 0, cus = 0, per_cu = 0;
        (void)hipGetDevice(&dev); (void)hipDeviceGetAttribute(&cus, hipDeviceAttributeMultiprocessorCount, dev);
        (void)hipFuncSetAttribute((const void*)mega_fwd, hipFuncAttributeMaxDynamicSharedMemorySize, LDS_BYTES);
        (void)hipOccupancyMaxActiveBlocksPerMultiprocessor(&per_cu, (const void*)mega_fwd, 512, LDS_BYTES);
        (void)hipGetLastError();
        grid = cus * (per_cu < 1 ? 1 : 1);
    }
    (void)hipMemsetAsync((char*)d_ws + WS_CTL, 0, CTL_BYTES, stream);
    Args a{};
    for (int i = 0; i < 27; ++i) a.in[i] = (const float*)d_in[i];
    a.out = (float*)d_out; a.ws = (unsigned char*)d_ws;
#if MK_MODE == 2
    a.ph_lo = 0; a.ph_hi = 10; a.use_bar = 1;
    hipLaunchKernelGGL(mega_fwd, dim3(grid), dim3(512), LDS_BYTES, stream, a);
#else
    const int nfast = (MK_MODE == 1) ? 6 : 10;
    for (int p = 0; p < nfast; ++p) { a.ph_lo = p; a.ph_hi = p + 1; a.use_bar = 0; hipLaunchKernelGGL(mega_fwd, dim3(grid), dim3(512), LDS_BYTES, stream, a); }
#if MK_MODE == 1
    {
        using namespace nv;
        float* out = (float*)d_out; char* ws = (char*)d_ws; const size_t MiB_ = 1u << 20;
        float* hbuf = (float*)(ws); float* B1 = (float*)(ws + 64 * MiB_); float* B2 = (float*)(ws + 128 * MiB_);
        char* misc = ws + 256 * MiB_;
        int* cnt = (int*)(misc + 2 * MiB_); int* off = cnt + 64; int* list = (int*)(misc + 2 * MiB_ + 4096);
        int* tok_e = (int*)(misc + 5 * MiB_); int* tok_pos = tok_e + 2 * nv::T; float* tok_w = (float*)(tok_pos + 2 * nv::T);
        const dim3 b256(256);
        const float* norm_ffn = (const float*)d_in[18]; const float* wrg = (const float*)d_in[19]; const float* brg = (const float*)d_in[20]; const float* wre = (const float*)d_in[21]; const float* bre = (const float*)d_in[22];
        const float* w_gate = (const float*)d_in[23]; const float* w_up = (const float*)d_in[24]; const float* w_down = (const float*)d_in[25]; const float* norm_final = (const float*)d_in[26];
        hipLaunchKernelGGL(k_rmsnorm, dim3(nv::T / 4), b256, 0, stream, out, norm_ffn, hbuf, nv::T);
        (void)hipMemsetAsync(cnt, 0, 512, stream);
        hipLaunchKernelGGL(k_route, dim3(nv::T / 4), b256, 0, stream, hbuf, wrg, brg, wre, bre, cnt, list, tok_e, tok_pos, tok_w);
        hipLaunchKernelGGL(k_offsets, dim3(1), dim3(64), 0, stream, cnt, off);
        float* Hm = B1; float* Yd = B2;
        for (int e = 0; e < nv::NE; ++e)
            hipLaunchKernelGGL(k_gemm<2>, dim3(nv::EFF / 64, nv::T / 64), b256, 0, stream, hbuf, nv::D, list + e * nv::T, nullptr, w_gate + (size_t)e * nv::D * nv::EFF, w_up + (size_t)e * nv::D * nv::EFF, nv::EFF,
                               Hm, nv::EFF, off + e, nullptr, 0, cnt + e, nv::EFF, nv::D);
        for (int e = 0; e < nv::NE; ++e)
            hipLaunchKernelGGL(k_gemm<0>, dim3(nv::D / 64, nv::T / 64), b256, 0, stream, Hm, nv::EFF, nullptr, off + e, w_down + (size_t)e * nv::EFF * nv::D, nullptr, nv::D,
                               Yd, nv::D, off + e, nullptr, 0, cnt + e, nv::D, nv::EFF);
        hipLaunchKernelGGL(k_final, dim3(nv::T / 4), b256, 0, stream, out, Yd, off, tok_e, tok_pos, tok_w, norm_final);
    }
#endif
#endif
}
```

```cpp
#include <hip/hip_runtime.h>
#include <stdint.h>

namespace nv {
constexpr int T = 16384, D = 1024, SW = 512, NG = 32, NS = 64, NH = 16, INC = 5632, NE = 32, EFF = 512;
constexpr float EPS = 1e-6f;

__device__ __forceinline__ float wave_sum(float v) {
#pragma unroll
    for (int o = 1; o < 64; o <<= 1) v += __shfl_xor(v, o);
    return v;
}
__device__ __forceinline__ float sigmoidf_(float x) { return 1.f / (1.f + __expf(-x)); }
__device__ __forceinline__ float gelu_tanh(float x) { const float u = 0.7978845608028654f * (x + 0.044715f * x * x * x); return 0.5f * x * (1.f + tanhf(u)); }

__global__ __launch_bounds__(256) void k_rmsnorm(const float* x, const float* g, float* y, int rows) {
    const int row = blockIdx.x * 4 + (threadIdx.x >> 6), lane = threadIdx.x & 63;
    if (row >= rows) return;
    const float4* xr = (const float4*)(x + (size_t)row * D);
    float4 v[4]; float s = 0.f;
#pragma unroll
    for (int j = 0; j < 4; ++j) { v[j] = xr[lane + 64 * j]; s += v[j].x * v[j].x + v[j].y * v[j].y + v[j].z * v[j].z + v[j].w * v[j].w; }
    const float r = rsqrtf(wave_sum(s) * (1.f / D) + EPS);
    float4* yr = (float4*)(y + (size_t)row * D);
#pragma unroll
    for (int j = 0; j < 4; ++j) { const float4 gg = ((const float4*)g)[lane + 64 * j]; yr[lane + 64 * j] = make_float4(v[j].x * r * gg.x, v[j].y * r * gg.y, v[j].z * r * gg.z, v[j].w * r * gg.w); }
}

template <int MODE>
__global__ __launch_bounds__(256) void k_gemm(const float* A, int lda, const int* gather, const int* aoff_dev, const float* B, const float* B2, int ldb,
                                              float* C, int ldc, const int* coff_dev, const float* resid, int M, const int* Mdev, int N, int K) {
    __shared__ float As[16][68];
    __shared__ float Bs[16][64];
    __shared__ float Bs2[16][64];
    if (Mdev) M = *Mdev;
    const int row0 = blockIdx.y * 64, col0 = blockIdx.x * 64;
    if (row0 >= M) return;
    const int aoff = aoff_dev ? *aoff_dev : 0, coff = coff_dev ? *coff_dev : 0;
    const int tid = threadIdx.x, ty = tid >> 4, tx = tid & 15;
    const int lr = tid >> 2, lk = (tid & 3) * 4;
    const int bk = tid >> 4, bn = (tid & 15) * 4;
    int arow = -1;
    if (row0 + lr < M) arow = gather ? gather[row0 + lr] : (aoff + row0 + lr);
    float acc[4][4] = {}, acc2[4][4] = {};
    for (int k0 = 0; k0 < K; k0 += 16) {
        float4 av = make_float4(0.f, 0.f, 0.f, 0.f);
        if (arow >= 0) av = *(const float4*)(A + (size_t)arow * lda + k0 + lk);
        As[lk + 0][lr] = av.x; As[lk + 1][lr] = av.y; As[lk + 2][lr] = av.z; As[lk + 3][lr] = av.w;
        *(float4*)&Bs[bk][bn] = *(const float4*)(B + (size_t)(k0 + bk) * ldb + col0 + bn);
        if (MODE >= 2) *(float4*)&Bs2[bk][bn] = *(const float4*)(B2 + (size_t)(k0 + bk) * ldb + col0 + bn);
        __syncthreads();
#pragma unroll
        for (int k = 0; k < 16; ++k) {
            const float4 a = *(const float4*)&As[k][ty * 4];
            const float4 b = *(const float4*)&Bs[k][tx * 4];
            const float aa[4] = {a.x, a.y, a.z, a.w}, bb[4] = {b.x, b.y, b.z, b.w};
#pragma unroll
            for (int i = 0; i < 4; ++i)
#pragma unroll
                for (int j = 0; j < 4; ++j) acc[i][j] += aa[i] * bb[j];
            if (MODE >= 2) {
                const float4 b2 = *(const float4*)&Bs2[k][tx * 4]; const float cc[4] = {b2.x, b2.y, b2.z, b2.w};
#pragma unroll
                for (int i = 0; i < 4; ++i)
#pragma unroll
                    for (int j = 0; j < 4; ++j) acc2[i][j] += aa[i] * cc[j];
            }
        }
        __syncthreads();
    }
#pragma unroll
    for (int i = 0; i < 4; ++i) {
        const int r = row0 + ty * 4 + i;
        if (r >= M) continue;
        float o[4];
#pragma unroll
        for (int j = 0; j < 4; ++j) {
            float v = acc[i][j];
            if (MODE == 2) v = (v * sigmoidf_(v)) * acc2[i][j];
            if (MODE == 3) v = v * sigmoidf_(acc2[i][j]);
            o[j] = v;
        }
        const size_t ci = (size_t)(coff + r) * ldc + col0 + tx * 4;
        if (MODE == 1) { const float4 rr = *(const float4*)(resid + ci); o[0] += rr.x; o[1] += rr.y; o[2] += rr.z; o[3] += rr.w; }
        *(float4*)(C + ci) = make_float4(o[0], o[1], o[2], o[3]);
    }
}

__global__ __launch_bounds__(256) void k_conv(const float* xc, const float* cg, float* bg_z, const float* cw, const float* cb) {
    const size_t i = (size_t)blockIdx.x * 256 + threadIdx.x;
    const int t = (int)(i / D), c = (int)(i % D);
    float y = cb[c] + cw[2 * D + c] * (cg[i] * xc[i]);
    if (t >= 1) y += cw[1 * D + c] * (cg[i - D] * xc[i - D]);
    if (t >= 2) y += cw[0 * D + c] * (cg[i - 2 * D] * xc[i - 2 * D]);
    bg_z[i] = bg_z[i] * y;
}

struct cplx { float re, im; };
__device__ __forceinline__ cplx cmul(cplx a, cplx b) { return {a.re * b.re - a.im * b.im, a.re * b.im + a.im * b.re}; }

__device__ __forceinline__ void ssm_consts(const float* a_re, const float* a_im, const float* log_dt, int g, int n, cplx& abar, cplx& coef, cplx& a256) {
    const double lr = a_re[g * NS + n], li = a_im[g * NS + n], dt = exp((double)log_dt[g]);
    const double er = exp(lr * dt), cr = er * cos(li * dt), ci = er * sin(li * dt);
    abar = {(float)cr, (float)ci};
    const double nr = cr - 1.0, ni = ci, den = lr * lr + li * li;
    coef = {(float)((nr * lr + ni * li) / den), (float)((ni * lr - nr * li) / den)};
    const double e2 = exp(lr * dt * 256.0);
    a256 = {(float)(e2 * cos(li * dt * 256.0)), (float)(e2 * sin(li * dt * 256.0))};
}

template <int PASS>
__global__ __launch_bounds__(64) void k_ssm(const float* u, const float* a_re, const float* a_im, const float* log_dt, const float* b_re, const float* b_im,
                                            const float* c_re, const float* c_im, const float* dsk, float* E, const float* Cin, float* ys) {
    __shared__ float part[16][65];
    const int g = blockIdx.x, r = blockIdx.y, n = threadIdx.x;
    cplx abar, coef, a256; ssm_consts(a_re, a_im, log_dt, g, n, abar, coef, a256);
    cplx bb[16]; float cre[16], cim[16];
#pragma unroll
    for (int h = 0; h < 16; ++h) {
        bb[h] = cmul(coef, cplx{b_re[(g * NS + n) * NH + h], b_im[(g * NS + n) * NH + h]});
        cre[h] = c_re[(g * NH + h) * NS + n]; cim[h] = c_im[(g * NH + h) * NS + n];
    }
    cplx s = {0.f, 0.f};
    if (PASS == 2) s = {Cin[((size_t)(r * NG + g) * NS + n) * 2], Cin[((size_t)(r * NG + g) * NS + n) * 2 + 1]};
    for (int t = r * 256; t < r * 256 + 256; ++t) {
        const float* ut = u + (size_t)t * SW + g * NH;
        cplx bu = {0.f, 0.f};
#pragma unroll
        for (int h = 0; h < 16; ++h) { const float uv = ut[h]; bu.re += bb[h].re * uv; bu.im += bb[h].im * uv; }
        s = cmul(abar, s); s.re += bu.re; s.im += bu.im;
        if (PASS == 2) {
#pragma unroll
            for (int h = 0; h < 16; ++h) part[h][n] = cre[h] * s.re - cim[h] * s.im;
            __syncthreads();
            const int h = n & 15, q = n >> 4; float y = 0.f;
#pragma unroll
            for (int j = 0; j < 16; ++j) y += part[h][q * 16 + j];
            y += __shfl_xor(y, 16); y += __shfl_xor(y, 32);
            if (q == 0) { const float v = y + dsk[g * NH + h] * ut[h]; ys[(size_t)t * SW + g * NH + h] = gelu_tanh(v); }
            __syncthreads();
        }
    }
    if (PASS == 1) { E[((size_t)(r * NG + g) * NS + n) * 2] = s.re; E[((size_t)(r * NG + g) * NS + n) * 2 + 1] = s.im; }
}
__global__ __launch_bounds__(64) void k_ssm_carry(const float* a_re, const float* a_im, const float* log_dt, const float* E, float* Cin) {
    const int g = blockIdx.x, n = threadIdx.x;
    cplx abar, coef, a256; ssm_consts(a_re, a_im, log_dt, g, n, abar, coef, a256);
    cplx run = {0.f, 0.f};
    for (int r = 0; r < T / 256; ++r) {
        const size_t i = ((size_t)(r * NG + g) * NS + n) * 2;
        Cin[i] = run.re; Cin[i + 1] = run.im;
        run = cmul(a256, run); run.re += E[i]; run.im += E[i + 1];
    }
}

template <int ADD>
__global__ __launch_bounds__(256) void k_mix(const float* gl, const float* bias, const float* y, float* m) {
    const size_t i = (size_t)blockIdx.x * 256 + threadIdx.x; const int c = (int)(i % D);
    const float v = sigmoidf_(gl[i] + bias[c]) * y[i];
    m[i] = ADD ? m[i] + v : v;
}

__global__ __launch_bounds__(256) void k_route(const float* h2, const float* wrg, const float* brg, const float* wre, const float* bre,
                                               int* cnt, int* list, int* tok_e, int* tok_pos, float* tok_w) {
    const int t = blockIdx.x * 4 + (threadIdx.x >> 6), lane = threadIdx.x & 63;
    float acc[36];
#pragma unroll
    for (int j = 0; j < 36; ++j) acc[j] = 0.f;
    for (int k = lane; k < D; k += 64) {
        const float hv = h2[(size_t)t * D + k];
#pragma unroll
        for (int j = 0; j < 4; ++j) acc[j] += hv * wrg[k * 4 + j];
#pragma unroll
        for (int j = 0; j < 32; ++j) acc[4 + j] += hv * wre[k * 32 + j];
    }
#pragma unroll
    for (int j = 0; j < 36; ++j) acc[j] = wave_sum(acc[j]);
    if (lane == 0) {
        float lg[4]; int gi = 0; float lmax;
#pragma unroll
        for (int j = 0; j < 4; ++j) { lg[j] = acc[j] + brg[j]; }
        lmax = lg[0];
#pragma unroll
        for (int j = 1; j < 4; ++j) if (lg[j] > lmax) { lmax = lg[j]; gi = j; }
        float se = 0.f;
#pragma unroll
        for (int j = 0; j < 4; ++j) se += __expf(lg[j] - lmax);
        const float pg = 1.f / se;
        float v1 = -3.0e38f, v2 = -3.0e38f; int i1 = 0, i2 = 0;
#pragma unroll
        for (int j = 0; j < 8; ++j) { float v = 0.f;
#pragma unroll
            for (int q = 0; q < 4; ++q) if (q == gi) v = acc[4 + q * 8 + j] + bre[q * 8 + j];
            if (v > v1) { v2 = v1; i2 = i1; v1 = v; i1 = j; } else if (v > v2) { v2 = v; i2 = j; } }
        const float w1 = 1.f / (1.f + __expf(v2 - v1)), w2 = 1.f - w1;
        const int e1 = gi * 8 + i1, e2 = gi * 8 + i2;
        const int p1 = atomicAdd(&cnt[e1], 1), p2 = atomicAdd(&cnt[e2], 1);
        list[e1 * T + p1] = t; list[e2 * T + p2] = t;
        tok_e[t * 2] = e1; tok_e[t * 2 + 1] = e2; tok_pos[t * 2] = p1; tok_pos[t * 2 + 1] = p2;
        tok_w[t * 2] = pg * w1; tok_w[t * 2 + 1] = pg * w2;
    }
}
__global__ void k_offsets(const int* cnt, int* off) { if (threadIdx.x == 0) { int s = 0; for (int e = 0; e < NE; ++e) { off[e] = s; s += cnt[e]; } } }

__global__ __launch_bounds__(256) void k_final(float* out, const float* Y, const int* off, const int* tok_e, const int* tok_pos, const float* tok_w, const float* g) {
    const int t = blockIdx.x * 4 + (threadIdx.x >> 6), lane = threadIdx.x & 63;
    const int s1 = off[tok_e[t * 2]] + tok_pos[t * 2], s2 = off[tok_e[t * 2 + 1]] + tok_pos[t * 2 + 1];
    const float w1 = tok_w[t * 2], w2 = tok_w[t * 2 + 1];
    float4* xr = (float4*)(out + (size_t)t * D);
    const float4* y1 = (const float4*)(Y + (size_t)s1 * D); const float4* y2 = (const float4*)(Y + (size_t)s2 * D);
    float4 v[4]; float s = 0.f;
#pragma unroll
    for (int j = 0; j < 4; ++j) { const float4 a = xr[lane + 64 * j], b = y1[lane + 64 * j], c = y2[lane + 64 * j];
        v[j] = make_float4(a.x + w1 * b.x + w2 * c.x, a.y + w1 * b.y + w2 * c.y, a.z + w1 * b.z + w2 * c.z, a.w + w1 * b.w + w2 * c.w);
        s += v[j].x * v[j].x + v[j].y * v[j].y + v[j].z * v[j].z + v[j].w * v[j].w; }
    const float r = rsqrtf(wave_sum(s) * (1.f / D) + EPS);
#pragma unroll
    for (int j = 0; j < 4; ++j) { const float4 gg = ((const float4*)g)[lane + 64 * j]; xr[lane + 64 * j] = make_float4(v[j].x * r * gg.x, v[j].y * r * gg.y, v[j].z * r * gg.z, v[j].w * r * gg.w); }
}
}

#define LAS __attribute__((address_space(3)))
typedef unsigned short bf16_t;
typedef short bf16x8 __attribute__((ext_vector_type(8)));
typedef float f32x4 __attribute__((ext_vector_type(4)));
typedef float f32x16 __attribute__((ext_vector_type(16)));
typedef unsigned u32x4 __attribute__((ext_vector_type(4)));
typedef unsigned u32x2 __attribute__((ext_vector_type(2)));

constexpr int T = 16384, D = 1024, SW = 512, NG = 32, NS = 64, NH = 16, INC = 5632, NE = 32, EFF = 512;
constexpr float EPS = 1e-6f;

__device__ __forceinline__ unsigned cvt_pk_bf16(float lo, float hi) { unsigned r; asm volatile("v_cvt_pk_bf16_f32 %0, %1, %2" : "=v"(r) : "v"(lo), "v"(hi)); return r; }
__device__ __forceinline__ float bf_lo(unsigned w) { return __uint_as_float(w << 16); }
__device__ __forceinline__ float bf_hi(unsigned w) { return __uint_as_float(w & 0xffff0000u); }
__device__ __forceinline__ float fsigmoid(float x) { return __builtin_amdgcn_rcpf(1.f + __builtin_amdgcn_exp2f(-1.4426950408889634f * x)); }
__device__ __forceinline__ float fsilu(float x) { return x * fsigmoid(x); }
__device__ __forceinline__ float fgelu_tanh(float x) { const float u = 0.7978845608028654f * (x + 0.044715f * x * x * x); return x * fsigmoid(2.f * u); }
__device__ __forceinline__ float wave_sum64(float v) {
#pragma unroll
    for (int o = 1; o < 64; o <<= 1) v += __shfl_xor(v, o);
    return v;
}

namespace pg8 {
constexpr int BM = 256, BK = 64, HALF = 128, HTB = HALF * BK * 2, STAGE_BYTES = 8 * HTB, NXCD = 8, WGM = 8;
__host__ __device__ __forceinline__ int lds_byte(int r, int c) { const int st = (r >> 4) * 2 + (c >> 5), rr = r & 15, cc = c & 31, ob = rr * 64 + cc * 2; return st * 1024 + (ob ^ (((ob >> 9) & 1) << 5)); }
__host__ __device__ __forceinline__ void stage_rc(int b, int& R, int& C) { const int st = b / 1024, sb = b % 1024, swz = sb ^ (((sb >> 9) & 1) << 5); R = (st >> 1) * 16 + swz / 64; C = (st & 1) * 32 + (swz % 64) / 2; }
__host__ __device__ __forceinline__ int perm32(int rho) { const int n = rho >> 4, i = rho & 15; return 8 * (i >> 2) + 4 * n + (i & 3); }

struct Unit { int pm, pn, e, nrow, srow; };

__device__ __forceinline__ void tile_map(int L, int nM, int nN, int& pm, int& pn) {
    const int nwg = nM * nN; int wgid = L;
    { const int q = nwg / NXCD, r = nwg % NXCD, xcd = wgid % NXCD, off = wgid / NXCD; wgid = (xcd < r ? xcd * (q + 1) : r * (q + 1) + (xcd - r) * q) + off; }
    const int nig = WGM * nN, gid = wgid / nig, fm = gid * WGM, gsz = (nM - fm) < WGM ? (nM - fm) : WGM;
    pm = fm + ((wgid % nig) % gsz); pn = (wgid % nig) / gsz;
}
struct DenseOrder {
    const char* A; const char* Bt; int K, nM, nNt, sub, G, c;
    __device__ __forceinline__ bool next(int i, Unit& u) const {
        const int L = (i / sub) * G + c; if (L >= nM * nNt) return false;
        int pm, pn; tile_map(L, nM, nNt, pm, pn); u.pm = pm; u.pn = pn * sub + (i % sub); u.e = 0; u.nrow = 256; u.srow = 0; return true;
    }
    __device__ __forceinline__ const char* a_base(const Unit& u) const { return A + (size_t)u.pm * (size_t)(BM * 2) * K; }
    __device__ __forceinline__ const char* b_base(const Unit& u) const { return Bt + (size_t)u.pn * (size_t)(BM * 2) * K; }
    __device__ __forceinline__ unsigned a_row(const Unit&, int r) const { return (unsigned)r; }
};
struct MoEOrder {
    const LAS int* tb; const LAS int* lc; const int* list; const char* A; const char* Bt; int K; size_t bstride; int G, c; bool gather;
    __device__ __forceinline__ bool next(int i, Unit& u) const {
        const int L = i * G + c; const int ntile = tb[32]; if (L >= ntile * 4) return false;
        const int tt = L >> 2; int e = 0;
#pragma unroll 1
        for (int q = 1; q < 32; ++q) if (tb[q] <= tt) e = q;
        e = __builtin_amdgcn_readfirstlane(e);
        u.e = e; u.pm = tt - tb[e]; u.pn = L & 3; const int rem = lc[e] - 256 * u.pm; u.nrow = rem < 256 ? rem : 256; u.srow = 256 * tt; return true;
    }
    __device__ __forceinline__ const char* a_base(const Unit& u) const { return gather ? A : A + (size_t)u.srow * 2 * K; }
    __device__ __forceinline__ const char* b_base(const Unit& u) const { return Bt + (size_t)u.e * bstride + (size_t)u.pn * (size_t)(BM * 2) * K; }
    __device__ __forceinline__ unsigned a_row(const Unit& u, int r) const { return r < u.nrow ? (unsigned)list[u.e * T + 256 * u.pm + r] : 0u; }
};

template <class Epi, class Sched, bool GATHER, bool ALIGN_EPI>
__device__ __forceinline__ void gemm_phase(LAS unsigned char* lds, const int K, const Sched& S, const Epi& E) {
    const int tid = threadIdx.x, wid = __builtin_amdgcn_readfirstlane(tid >> 6), lane = tid & 63, wr = wid >> 2, wc = wid & 3, fr = lane & 15, fq = lane >> 4;
    const int nt = K / BK;
    unsigned voffB[2], vA[2][2], nvA[2][2]; int Rr[2], Cc[2];
#pragma unroll
    for (int i = 0; i < 2; ++i) { int R, C; stage_rc(tid * 16 + i * 8192, R, C); const int Rb = Epi::PERM ? ((R & ~31) + perm32(R & 31)) : R;
        Rr[i] = R; Cc[i] = C; voffB[i] = (unsigned)(Rb * K + C) * 2u; }
    const size_t kstep = (size_t)(BK * 2);
    const size_t hstep = (size_t)HALF * K * 2;
    const unsigned ldsw = (unsigned)wid * 1024u;
    const int aoff = lds_byte(wr * 64 + fr, fq * 8), boff = lds_byte(wc * 32 + fr, fq * 8);
#define PG8_SA(b, h) (((b) * 2 + (h)) * HTB)
#define PG8_SB(b, h) ((4 + (b) * 2 + (h)) * HTB)
#define PG8_STAGE(bufoff, gbase, voff) do { _Pragma("unroll") for (int _i = 0; _i < 2; ++_i) \
        __builtin_amdgcn_global_load_lds((const unsigned*)((const char*)(gbase) + (voff)[_i]), (LAS unsigned*)(lds + (bufoff) + ldsw + _i * 8192), 16, 0, 0); } while (0)
#define PG8_LDA(dst, b, h) do { _Pragma("unroll") for (int m = 0; m < 4; ++m) _Pragma("unroll") for (int k = 0; k < 2; ++k) dst[m][k] = *(const LAS bf16x8*)(lds + PG8_SA(b, h) + aoff + m * 2048 + k * 1024); } while (0)
#define PG8_LDB(dst, b, h) do { _Pragma("unroll") for (int n = 0; n < 2; ++n) _Pragma("unroll") for (int k = 0; k < 2; ++k) dst[n][k] = *(const LAS bf16x8*)(lds + PG8_SB(b, h) + boff + n * 2048 + k * 1024); } while (0)
#define PG8_MMA(ai, bj, At, Bt) do { __builtin_amdgcn_s_setprio(1); _Pragma("unroll") for (int m = 0; m < 4; ++m) _Pragma("unroll") for (int n = 0; n < 2; ++n) _Pragma("unroll") for (int k = 0; k < 2; ++k) \
        acc[ai][bj][m][n] = __builtin_amdgcn_mfma_f32_16x16x32_bf16(Bt[n][k], At[m][k], acc[ai][bj][m][n], 0, 0, 0); __builtin_amdgcn_s_setprio(0); } while (0)
#define PG8_WAIT_V(n) asm volatile("s_waitcnt vmcnt(" #n ")" ::: "memory")
#define PG8_WAIT_L(n) asm volatile("s_waitcnt lgkmcnt(" #n ")" ::: "memory")
#define PG8_BAR __builtin_amdgcn_s_barrier()
#define PG8_SCHED __builtin_amdgcn_sched_barrier(0)
    Unit cur, nxt; int ui = 0;
    if (!S.next(0, cur)) return;
#pragma unroll
    for (int h = 0; h < 2; ++h)
#pragma unroll
        for (int i = 0; i < 2; ++i) vA[h][i] = (unsigned)((GATHER ? S.a_row(cur, h * HALF + Rr[i]) : (unsigned)(h * HALF + Rr[i])) * (unsigned)K + (unsigned)Cc[i]) * 2u;
    f32x4 acc[2][2][4][2];
    if constexpr (Epi::HAS_INIT) E.init(acc, cur, wr, wc, fr, fq);
    else {
#pragma unroll
    for (int a = 0; a < 2; ++a)
#pragma unroll
        for (int b = 0; b < 2; ++b)
#pragma unroll
            for (int m = 0; m < 4; ++m)
#pragma unroll
                for (int n = 0; n < 2; ++n) acc[a][b][m][n] = (f32x4){0.f, 0.f, 0.f, 0.f};
    }
    bf16x8 At[4][2], B0[2][2], B1[2][2];
    const char* cA = S.a_base(cur); const char* cB = S.b_base(cur);
    PG8_STAGE(PG8_SB(0, 0), cB, voffB); PG8_STAGE(PG8_SB(0, 1), cB + hstep, voffB); PG8_STAGE(PG8_SA(0, 0), cA, vA[0]); PG8_STAGE(PG8_SA(0, 1), cA, vA[1]);
    if (wr == 1) PG8_BAR;
    PG8_WAIT_V(2); PG8_BAR;
    PG8_STAGE(PG8_SB(1, 0), cB + kstep, voffB); PG8_STAGE(PG8_SA(1, 0), cA + kstep, vA[0]); PG8_STAGE(PG8_SB(1, 1), cB + hstep + kstep, voffB);
    PG8_WAIT_V(6); PG8_BAR;
    for (;;) {
        const bool has_next = S.next(ui + 1, nxt);
        const char* nA = has_next ? S.a_base(nxt) : cA; const char* nB = has_next ? S.b_base(nxt) : cB;
        if constexpr (GATHER) {
#pragma unroll
            for (int h = 0; h < 2; ++h)
#pragma unroll
                for (int i = 0; i < 2; ++i) nvA[h][i] = has_next ? (unsigned)(S.a_row(nxt, h * HALF + Rr[i]) * (unsigned)K + (unsigned)Cc[i]) * 2u : vA[h][i];
        }
        for (int t = 0; t < nt; t += 2) {
            const bool last = (t == nt - 2);
            const char* a1 = cA + (size_t)(t + 1) * kstep;
            const char* a2 = last ? nA : cA + (size_t)(t + 2) * kstep; const char* b2 = last ? nB : cB + (size_t)(t + 2) * kstep;
            const char* a3 = a2 + kstep; const char* b3 = b2 + kstep;
            unsigned x0[2], x1[2];
            if constexpr (GATHER) { x0[0] = last ? nvA[0][0] : vA[0][0]; x0[1] = last ? nvA[0][1] : vA[0][1]; x1[0] = last ? nvA[1][0] : vA[1][0]; x1[1] = last ? nvA[1][1] : vA[1][1]; }
            else { x0[0] = vA[0][0]; x0[1] = vA[0][1]; x1[0] = vA[1][0]; x1[1] = vA[1][1]; }
            PG8_LDB(B0, 0, 0); PG8_LDB(B1, 0, 1); PG8_SCHED; PG8_LDA(At, 0, 0); PG8_STAGE(PG8_SA(1, 1), a1, vA[1]);
            PG8_WAIT_V(8); PG8_WAIT_L(0); PG8_BAR; PG8_MMA(0, 0, At, B0); PG8_MMA(0, 1, At, B1); PG8_BAR; PG8_SCHED;
            PG8_LDA(At, 0, 1); PG8_STAGE(PG8_SB(0, 0), b2, voffB); PG8_STAGE(PG8_SB(0, 1), b2 + hstep, voffB); PG8_STAGE(PG8_SA(0, 0), a2, x0);
            PG8_WAIT_V(8); PG8_WAIT_L(0); PG8_BAR; PG8_MMA(1, 0, At, B0); PG8_MMA(1, 1, At, B1); PG8_BAR; PG8_SCHED;
            PG8_LDB(B0, 1, 0); PG8_LDB(B1, 1, 1); PG8_SCHED; PG8_LDA(At, 1, 0); PG8_STAGE(PG8_SA(0, 1), a2, x1);
            PG8_WAIT_V(8); PG8_WAIT_L(0); PG8_BAR; PG8_MMA(0, 0, At, B0); PG8_MMA(0, 1, At, B1); PG8_BAR; PG8_SCHED;
            PG8_LDA(At, 1, 1); PG8_STAGE(PG8_SB(1, 0), b3, voffB); PG8_STAGE(PG8_SB(1, 1), b3 + hstep, voffB); PG8_STAGE(PG8_SA(1, 0), a3, x0);
            PG8_WAIT_V(8); PG8_WAIT_L(0); PG8_BAR; PG8_MMA(1, 0, At, B0); PG8_MMA(1, 1, At, B1); PG8_BAR; PG8_SCHED;
        }
        if constexpr (ALIGN_EPI) { if (wr == 0) PG8_BAR; }
        E(acc, cur, wr, wc, fr, fq);
        if (!has_next) break;
        if constexpr (Epi::HAS_INIT) E.init(acc, nxt, wr, wc, fr, fq);
        else {
#pragma unroll
        for (int a = 0; a < 2; ++a)
#pragma unroll
            for (int b = 0; b < 2; ++b)
#pragma unroll
                for (int m = 0; m < 4; ++m)
#pragma unroll
                    for (int n = 0; n < 2; ++n) acc[a][b][m][n] = (f32x4){0.f, 0.f, 0.f, 0.f};
        }
        cur = nxt; cA = nA; cB = nB; ++ui;
        if constexpr (GATHER) { vA[0][0] = nvA[0][0]; vA[0][1] = nvA[0][1]; vA[1][0] = nvA[1][0]; vA[1][1] = nvA[1][1]; }
        if constexpr (ALIGN_EPI) { if (wr == 1) PG8_BAR; }
    }
    PG8_WAIT_V(0);
    if constexpr (!ALIGN_EPI) { if (wr == 0) PG8_BAR; }
    PG8_BAR;
#undef PG8_SA
#undef PG8_SB
#undef PG8_STAGE
#undef PG8_LDA
#undef PG8_LDB
#undef PG8_MMA
#undef PG8_WAIT_V
#undef PG8_WAIT_L
#undef PG8_BAR
#undef PG8_SCHED
}
}

#define EPI_ROWS(ai, m) (u.pm * 256 + (ai) * 128 + wr * 64 + (m) * 16 + fr)
__device__ __forceinline__ u32x4 pack8(const f32x4 a, const f32x4 b) { u32x4 w; w.x = cvt_pk_bf16(a[0], a[1]); w.y = cvt_pk_bf16(a[2], a[3]); w.z = cvt_pk_bf16(b[0], b[1]); w.w = cvt_pk_bf16(b[2], b[3]); return w; }
__device__ __forceinline__ void unpack8(const u32x4 w, f32x4& a, f32x4& b) { a = (f32x4){bf_lo(w.x), bf_hi(w.x), bf_lo(w.y), bf_hi(w.y)}; b = (f32x4){bf_lo(w.z), bf_hi(w.z), bf_lo(w.w), bf_hi(w.w)}; }

struct EpiWin {
    static constexpr bool PERM = true, HAS_INIT = false;
    const float* rstd; bf16_t* v; bf16_t* bg; bf16_t* ub; bf16_t* gates; const float* gate_bias;
    __device__ __forceinline__ void operator()(const f32x4 (&acc)[2][2][4][2], const pg8::Unit& u, int wr, int wc, int fr, int fq) const {
        if (u.pn < 8) {
#pragma unroll
            for (int ai = 0; ai < 2; ++ai)
#pragma unroll
                for (int m = 0; m < 4; ++m) { const int row = EPI_ROWS(ai, m); const float rs = rstd[row], rs2 = rs * rs;
                    const f32x4 a0 = acc[ai][0][m][0] * acc[ai][1][m][0] * rs2, a1 = acc[ai][0][m][1] * acc[ai][1][m][1] * rs2;
                    *(u32x4*)(v + (size_t)row * D + 128 * u.pn + 32 * wc + 8 * fq) = pack8(a0, a1); }
        } else if (u.pn < 14) {
            bf16_t* base; int ld, c0;
            if (u.pn < 12) { base = bg; ld = D; c0 = 256 * (u.pn - 8); } else { base = ub; ld = SW; c0 = 256 * (u.pn - 12); }
#pragma unroll
            for (int ai = 0; ai < 2; ++ai)
#pragma unroll
                for (int m = 0; m < 4; ++m) { const int row = EPI_ROWS(ai, m); const float rs = rstd[row];
#pragma unroll
                    for (int bj = 0; bj < 2; ++bj) *(u32x4*)(base + (size_t)row * ld + c0 + 128 * bj + 32 * wc + 8 * fq) = pack8(acc[ai][bj][m][0] * rs, acc[ai][bj][m][1] * rs); }
        } else {
            const int c0 = 256 * (u.pn - 14) + 32 * wc + 8 * fq;
            f32x4 bv[2][2];
#pragma unroll
            for (int bj = 0; bj < 2; ++bj)
#pragma unroll
                for (int n = 0; n < 2; ++n) bv[bj][n] = *(const f32x4*)(gate_bias + c0 + 128 * bj + 4 * n);
#pragma unroll
            for (int ai = 0; ai < 2; ++ai)
#pragma unroll
                for (int m = 0; m < 4; ++m) { const int row = EPI_ROWS(ai, m); const float rs = rstd[row];
#pragma unroll
                    for (int bj = 0; bj < 2; ++bj) { f32x4 g0 = acc[ai][bj][m][0] * rs + bv[bj][0], g1 = acc[ai][bj][m][1] * rs + bv[bj][1];
#pragma unroll
                        for (int j = 0; j < 4; ++j) { g0[j] = fsigmoid(g0[j]); g1[j] = fsigmoid(g1[j]); }
                        *(u32x4*)(gates + (size_t)row * 2048 + c0 + 128 * bj) = pack8(g0, g1); } }
        }
    }
};
struct EpiGlu {
    static constexpr bool PERM = true, HAS_INIT = false;
    const bf16_t* gates; bf16_t* mb;
    __device__ __forceinline__ void operator()(const f32x4 (&acc)[2][2][4][2], const pg8::Unit& u, int wr, int wc, int fr, int fq) const {
        const int col = 128 * u.pn + 32 * wc + 8 * fq;
#pragma unroll
        for (int ai = 0; ai < 2; ++ai)
#pragma unroll
            for (int m = 0; m < 4; ++m) { const int row = EPI_ROWS(ai, m);
                f32x4 g0, g1; unpack8(*(const u32x4*)(gates + (size_t)row * 2048 + 1024 + col), g0, g1);
                f32x4 y0 = acc[ai][0][m][0], y1 = acc[ai][0][m][1]; const f32x4 b0 = acc[ai][1][m][0], b1 = acc[ai][1][m][1];
#pragma unroll
                for (int j = 0; j < 4; ++j) { y0[j] = y0[j] * fsigmoid(b0[j]) * g0[j]; y1[j] = y1[j] * fsigmoid(b1[j]) * g1[j]; }
                *(u32x4*)(mb + (size_t)row * D + col) = pack8(y0, y1); }
    }
};
struct EpiMix {
    static constexpr bool PERM = true, HAS_INIT = false;
    const bf16_t* gates; const bf16_t* mb; bf16_t* mixed;
    __device__ __forceinline__ void operator()(const f32x4 (&acc)[2][2][4][2], const pg8::Unit& u, int wr, int wc, int fr, int fq) const {
#pragma unroll
        for (int ai = 0; ai < 2; ++ai)
#pragma unroll
            for (int m = 0; m < 4; ++m) { const int row = EPI_ROWS(ai, m);
#pragma unroll
                for (int bj = 0; bj < 2; ++bj) { const int col = 256 * u.pn + 128 * bj + 32 * wc + 8 * fq;
                    f32x4 g0, g1, m0, m1; unpack8(*(const u32x4*)(gates + (size_t)row * 2048 + col), g0, g1); unpack8(*(const u32x4*)(mb + (size_t)row * D + col), m0, m1);
                    *(u32x4*)(mixed + (size_t)row * D + col) = pack8(g0 * acc[ai][bj][m][0] + m0, g1 * acc[ai][bj][m][1] + m1); } }
    }
};
struct EpiX1 {
    static constexpr bool PERM = false, HAS_INIT = true;
    const float* __restrict__ x; float* __restrict__ x1; bf16_t* __restrict__ x1b;
    __device__ __forceinline__ void init(f32x4 (&acc)[2][2][4][2], const pg8::Unit& u, int wr, int wc, int fr, int fq) const {
#pragma unroll
        for (int ai = 0; ai < 2; ++ai)
#pragma unroll
            for (int m = 0; m < 4; ++m)
#pragma unroll
                for (int bj = 0; bj < 2; ++bj)
#pragma unroll
                    for (int n = 0; n < 2; ++n) acc[ai][bj][m][n] = *(const f32x4*)(x + (size_t)EPI_ROWS(ai, m) * D + 256 * u.pn + 128 * bj + 32 * wc + 16 * n + 4 * fq);
    }
    __device__ __forceinline__ void operator()(const f32x4 (&acc)[2][2][4][2], const pg8::Unit& u, int wr, int wc, int fr, int fq) const {
#pragma unroll
        for (int ai = 0; ai < 2; ++ai)
#pragma unroll
            for (int m = 0; m < 4; ++m) { const int row = EPI_ROWS(ai, m);
#pragma unroll
                for (int bj = 0; bj < 2; ++bj)
#pragma unroll
                    for (int n = 0; n < 2; ++n) { const size_t o = (size_t)row * D + 256 * u.pn + 128 * bj + 32 * wc + 16 * n + 4 * fq;
                        const f32x4 r = acc[ai][bj][m][n]; *(f32x4*)(x1 + o) = r;
                        u32x2 w; w.x = cvt_pk_bf16(r[0], r[1]); w.y = cvt_pk_bf16(r[2], r[3]); *(u32x2*)(x1b + o) = w; }
                asm volatile("s_waitcnt vmcnt(24)" ::: "memory"); }
    }
};
struct EpiUp {
    static constexpr bool PERM = true, HAS_INIT = false;
    const int* list; const float* rstd2; bf16_t* hmid;
    __device__ __forceinline__ void operator()(const f32x4 (&acc)[2][2][4][2], const pg8::Unit& u, int wr, int wc, int fr, int fq) const {
        const int col = 128 * u.pn + 32 * wc + 8 * fq;
#pragma unroll
        for (int ai = 0; ai < 2; ++ai)
#pragma unroll
            for (int m = 0; m < 4; ++m) { const int r = ai * 128 + wr * 64 + m * 16 + fr; const bool ok = r < u.nrow;
                const int tok = ok ? list[u.e * T + 256 * u.pm + r] : 0; const float rs = ok ? rstd2[tok] : 0.f;
                f32x4 g0 = acc[ai][0][m][0] * rs, g1 = acc[ai][0][m][1] * rs; const f32x4 u0 = acc[ai][1][m][0] * rs, u1 = acc[ai][1][m][1] * rs;
#pragma unroll
                for (int j = 0; j < 4; ++j) { g0[j] = fsilu(g0[j]) * u0[j]; g1[j] = fsilu(g1[j]) * u1[j]; }
                *(u32x4*)(hmid + (size_t)(u.srow + r) * EFF + col) = pack8(g0, g1); }
    }
};
struct EpiDown {
    static constexpr bool PERM = true, HAS_INIT = false;
    bf16_t* Y;
    __device__ __forceinline__ void operator()(const f32x4 (&acc)[2][2][4][2], const pg8::Unit& u, int wr, int wc, int fr, int fq) const {
#pragma unroll
        for (int ai = 0; ai < 2; ++ai)
#pragma unroll
            for (int m = 0; m < 4; ++m) { const int r = ai * 128 + wr * 64 + m * 16 + fr;
#pragma unroll
                for (int bj = 0; bj < 2; ++bj) *(u32x4*)(Y + (size_t)(u.srow + r) * D + 256 * u.pn + 128 * bj + 32 * wc + 8 * fq) = pack8(acc[ai][bj][m][0], acc[ai][bj][m][1]); }
    }
};

constexpr size_t MiB = 1u << 20;
constexpr size_t WS_CTL = 0, CTL_BYTES = 64 * 1024;
constexpr size_t WS_WIN = 1 * MiB, WS_WC = 12 * MiB, WS_WGLU = 14 * MiB, WS_WO = 16 * MiB;
constexpr size_t WS_RSTD1 = 18 * MiB, WS_RSTD2 = WS_RSTD1 + 64 * 1024, WS_TABA = WS_RSTD2 + 64 * 1024, WS_TABA256 = WS_TABA + 32 * 1024, WS_BBT = WS_TABA256 + 32 * 1024,
                 WS_CT = WS_BBT + 128 * 1024, WS_WRT = WS_CT + 128 * 1024, WS_E = 19 * MiB;
constexpr size_t WS_XB = 20 * MiB, WS_Z = 20 * MiB, WS_WD = 20 * MiB;
constexpr size_t WS_V = 52 * MiB, WS_MIXED = 52 * MiB, WS_Y = 52 * MiB;
constexpr size_t WS_BG = 84 * MiB, WS_MB = 84 * MiB, WS_X1B = 84 * MiB;
constexpr size_t WS_UB = 116 * MiB;
constexpr size_t WS_GATES = 132 * MiB, WS_WGU = 132 * MiB;
constexpr size_t WS_YS = 196 * MiB;
constexpr size_t WS_TOK = 212 * MiB, WS_LIST = 214 * MiB, WS_HMID = 216 * MiB, WS_END = 256 * MiB;
constexpr int CW_CNT = 64;
constexpr int CW_BAR = 4096;
constexpr int RING_BYTES = 131072, MISC_OFF = RING_BYTES, LDS_BYTES = 147456;

#define XB_TMO      128
#define XB_XCNT(j)  (256  + 64 * (j))
#define XB_XSUB(j)  (1280 + 64 * (j))
#define XB_XGEN(j)  (2304 + 64 * (j))
#define XB_TOP      3328
#define XB_TOPGEN   3392
#define XCD_BAR_WORDS 3456
#define XB_SPIN_CAP (1u << 18)
__device__ __forceinline__ unsigned xb_ld(unsigned* p)              { return __hip_atomic_load(p, __ATOMIC_RELAXED, __HIP_MEMORY_SCOPE_AGENT); }
__device__ __forceinline__ unsigned xb_add(unsigned* p, unsigned v) { return __hip_atomic_fetch_add(p, v, __ATOMIC_RELAXED, __HIP_MEMORY_SCOPE_AGENT); }
__device__ __forceinline__ unsigned xb_xcc_id() { return (unsigned)__builtin_amdgcn_s_getreg((3 << 11) | 20) & 0xFu; }
#define XB_SPIN(cond, bar) do { unsigned _sp = 0; while (cond) { __builtin_amdgcn_s_sleep(1); \
    if ((++_sp & 255u) == 0u) { if (xb_ld(&(bar)[XB_TMO])) break; if (_sp > XB_SPIN_CAP) { atomicAdd(&(bar)[XB_TMO], 1u); break; } } } } while (0)
struct XcdBarrier { unsigned* bar; unsigned x; volatile LAS unsigned* st; };
__device__ __forceinline__ XcdBarrier xcd_barrier_post(unsigned* bar, volatile LAS unsigned* st) {
    XcdBarrier b; b.bar = bar; b.x = xb_xcc_id(); b.st = st;
    if (threadIdx.x == 0) (void)xb_add(&bar[XB_XCNT(b.x)], 1u);
    return b;
}
__device__ __forceinline__ void xcd_barrier_complete(unsigned* bar, unsigned x, unsigned& nloc, unsigned& nx) {
    const unsigned G = gridDim.x * gridDim.y * gridDim.z;
    unsigned sum, cnt, mine, sp = 0u;
    for (;;) {
        sum = 0u; cnt = 0u; mine = 0u;
#pragma unroll
        for (unsigned j = 0; j < 16; ++j) { const unsigned c = xb_ld(&bar[XB_XCNT(j)]); sum += c; cnt += (c > 0u) ? 1u : 0u; mine = (j == x) ? c : mine; }
        if (sum == G) break;
        __builtin_amdgcn_s_sleep(1);
        if ((++sp & 255u) == 0u) { if (xb_ld(&bar[XB_TMO])) break; if (sp > XB_SPIN_CAP) { atomicAdd(&bar[XB_TMO], 1u); break; } }
    }
    nloc = mine > 0u ? mine : 1u; nx = cnt > 0u ? cnt : 1u;
}
__device__ __forceinline__ void xcd_barrier(const XcdBarrier& b) {
    asm volatile("s_waitcnt vmcnt(0)" ::: "memory");
    __syncthreads();
    if (threadIdx.x == 0) {
        unsigned* bar = b.bar;
        __builtin_amdgcn_s_waitcnt(0);
        unsigned nloc = b.st[0], nx = b.st[1];
        if (nloc == 0u) { xcd_barrier_complete(bar, b.x, nloc, nx); b.st[0] = nloc; b.st[1] = nx; }
        const unsigned old = xb_add(&bar[XB_XSUB(b.x)], 1u);
        const unsigned gen = old / nloc;
        if (old + 1u == (gen + 1u) * nloc) {
            __builtin_amdgcn_fence(__ATOMIC_RELEASE, "agent");
            asm volatile("s_waitcnt vmcnt(0)" ::: "memory");
            const unsigned og = xb_add(&bar[XB_TOP], 1u);
            const unsigned tg = og / nx;
            if (og + 1u == (tg + 1u) * nx) xb_add(&bar[XB_TOPGEN], 1u);
            else XB_SPIN(xb_ld(&bar[XB_TOPGEN]) == tg, bar);
            __builtin_amdgcn_fence(__ATOMIC_ACQUIRE, "agent");
            xb_add(&bar[XB_XGEN(b.x)], 1u);
            asm volatile("s_waitcnt vmcnt(0)" ::: "memory");
        } else {
            XB_SPIN(xb_ld(&bar[XB_XGEN(b.x)]) == gen, bar);
            __builtin_amdgcn_fence(__ATOMIC_ACQUIRE, "agent");
            asm volatile("s_waitcnt vmcnt(0)" ::: "memory");
        }
    }
    __syncthreads();
}

struct Args { const float* in[27]; float* out; unsigned char* ws; int ph_lo, ph_hi, use_bar, pad; };
struct Frame {
    LAS unsigned char* lds; volatile LAS unsigned* MISC; unsigned* ctl; unsigned char* ws;
    int tid, lane, wave, G;
};

__device__ __forceinline__ void tr64(const float* __restrict__ src, int ld, int col0, int k0, const float* __restrict__ scale, bf16_t* __restrict__ dst, size_t drow0, int Kdst, LAS unsigned char* scr, int lane) {
    const float* s = src + (size_t)k0 * ld + col0 + lane;
#pragma unroll
    for (int hh = 0; hh < 2; ++hh) {
        float v[32];
#pragma unroll
        for (int kk = 0; kk < 32; ++kk) v[kk] = s[(size_t)(32 * hh + kk) * ld];
        if (scale) {
#pragma unroll
            for (int kk = 0; kk < 32; ++kk) v[kk] *= scale[k0 + 32 * hh + kk];
        }
#pragma unroll
        for (int c = 0; c < 4; ++c) { u32x4 o; o.x = cvt_pk_bf16(v[8 * c + 0], v[8 * c + 1]); o.y = cvt_pk_bf16(v[8 * c + 2], v[8 * c + 3]); o.z = cvt_pk_bf16(v[8 * c + 4], v[8 * c + 5]); o.w = cvt_pk_bf16(v[8 * c + 6], v[8 * c + 7]);
            *(LAS u32x4*)(scr + lane * 144 + 16 * (4 * hh + c)) = o; }
        asm volatile("s_waitcnt vmcnt(0)" ::: "memory");
    }
    asm volatile("s_waitcnt lgkmcnt(0)" ::: "memory");
#pragma unroll
    for (int j = 0; j < 8; ++j) { const int row = 8 * j + (lane >> 3); const u32x4 o = *(const LAS u32x4*)(scr + row * 144 + 16 * (lane & 7));
        *(u32x4*)(dst + (drow0 + row) * (size_t)Kdst + k0 + 8 * (lane & 7)) = o; }
    asm volatile("s_waitcnt lgkmcnt(0)" ::: "memory");
}

__device__ __forceinline__ void p0_prologue(const Frame& F, const Args& a) {
    LAS unsigned char* scr = F.lds + F.wave * 16384;
    const int gw = blockIdx.x * 8 + F.wave, NGW = F.G * 8;
    bf16_t* Win_t = (bf16_t*)(F.ws + WS_WIN); bf16_t* Wc_t = (bf16_t*)(F.ws + WS_WC); bf16_t* Wglu_t = (bf16_t*)(F.ws + WS_WGLU); bf16_t* Wo_t = (bf16_t*)(F.ws + WS_WO);
    constexpr int I_WIN = 16 * 88, I_WC = 16 * 16, I_WO = 16 * 16, I_GLU = 8 * 32;
    for (int it = gw; it < I_WIN + I_WC + I_WO + I_GLU; it += NGW) {
        int r = it;
        if (r < I_WIN) { const int kb = r / 88, nb = r % 88, j0 = 64 * nb; int col0;
            if (j0 < 2048) { const int pn = j0 >> 8, i = j0 & 255; col0 = (i < 128) ? (128 * pn + i) : (2048 + 128 * pn + (i - 128)); } else if (j0 < 3072) col0 = j0 - 1024; else col0 = j0;
            tr64(a.in[2], INC, col0, 64 * kb, a.in[1], Win_t, (size_t)j0, D, scr, F.lane); continue; }
        r -= I_WIN;
        if (r < I_WC) { tr64(a.in[5], D, 64 * (r % 16), 64 * (r / 16), nullptr, Wc_t, (size_t)(64 * (r % 16)), D, scr, F.lane); continue; }
        r -= I_WC;
        if (r < I_WO) { tr64(a.in[17], D, 64 * (r % 16), 64 * (r / 16), nullptr, Wo_t, (size_t)(64 * (r % 16)), D, scr, F.lane); continue; }
        r -= I_WO;
        { const int kb = r / 32, nb = r % 32, j0 = 64 * nb, pn = j0 >> 8, i = j0 & 255;
          tr64(i < 128 ? a.in[14] : a.in[15], D, 128 * pn + (i & 127), 64 * kb, nullptr, Wglu_t, (size_t)j0, SW, scr, F.lane); }
    }
    { const float* x = a.in[0]; bf16_t* xb = (bf16_t*)(F.ws + WS_XB); float* rstd1 = (float*)(F.ws + WS_RSTD1);
      for (int m = gw; m < T; m += NGW) {
          const f32x4* xr = (const f32x4*)(x + (size_t)m * D) + F.lane; f32x4 v[4]; float s = 0.f;
#pragma unroll
          for (int j = 0; j < 4; ++j) { v[j] = xr[64 * j]; s += (v[j][0] * v[j][0] + v[j][1] * v[j][1]) + (v[j][2] * v[j][2] + v[j][3] * v[j][3]); }
          const float rs = rsqrtf(wave_sum64(s) * (1.f / D) + EPS);
          u32x2* o = (u32x2*)(xb + (size_t)m * D) + F.lane;
#pragma unroll
          for (int j = 0; j < 4; ++j) { u32x2 w; w.x = cvt_pk_bf16(v[j][0], v[j][1]); w.y = cvt_pk_bf16(v[j][2], v[j][3]); o[64 * j] = w; }
          if (F.lane == 0) rstd1[m] = rs; } }
    { bf16_t* wrt = (bf16_t*)(F.ws + WS_WRT); const float* g2 = a.in[18];
      for (int i = blockIdx.x * 512 + F.tid; i < 48 * D; i += F.G * 512) { const int j = i / D, k = i % D; float w = 0.f;
          if (j < 4) w = a.in[19][k * 4 + j]; else if (j < 36) w = a.in[21][k * 32 + (j - 4)];
          wrt[i] = (bf16_t)(cvt_pk_bf16(w * g2[k], 0.f) & 0xffffu); } }
    { float* tab_a = (float*)(F.ws + WS_TABA); float* tab_a256 = (float*)(F.ws + WS_TABA256); bf16_t* BbT = (bf16_t*)(F.ws + WS_BBT); bf16_t* Ct = (bf16_t*)(F.ws + WS_CT);
      for (int i = blockIdx.x * 512 + F.tid; i < NG * NS; i += F.G * 512) { const int g = i / NS, n = i % NS;
          f32x4 br[4], bi[4]; float cre[16], cim[16];
#pragma unroll
          for (int q = 0; q < 4; ++q) { br[q] = *(const f32x4*)(a.in[9] + (size_t)i * NH + 4 * q); bi[q] = *(const f32x4*)(a.in[10] + (size_t)i * NH + 4 * q); }
#pragma unroll
          for (int h = 0; h < NH; ++h) { cre[h] = a.in[11][(g * NH + h) * NS + n]; cim[h] = a.in[12][(g * NH + h) * NS + n]; }
          const float lr = a.in[6][i], li = a.in[7][i], dt = expf(a.in[8][g]);
          float sn, cs; sincosf(li * dt, &sn, &cs); const float er = expf(lr * dt); const float cr = er * cs, ci = er * sn;
          float pr = cr, pi = ci;
#pragma unroll
          for (int q = 0; q < 4; ++q) { const float tr_ = pr * pr - pi * pi, ti_ = 2.f * pr * pi; pr = tr_; pi = ti_; }
          *(f32x4*)(tab_a + (size_t)i * 4) = (f32x4){cr, ci, pr, pi};
#pragma unroll
          for (int q = 0; q < 4; ++q) { const float tr_ = pr * pr - pi * pi, ti_ = 2.f * pr * pi; pr = tr_; pi = ti_; }
          *(float2*)(tab_a256 + (size_t)i * 2) = make_float2(pr, pi);
          const float nr = cr - 1.f, ni = ci, den = lr * lr + li * li; const float kr = (nr * lr + ni * li) / den, ki = (ni * lr - nr * li) / den;
          unsigned wre[8], wim[8];
#pragma unroll
          for (int q = 0; q < 4; ++q) {
              wre[2 * q]     = cvt_pk_bf16(kr * br[q][0] - ki * bi[q][0], kr * br[q][1] - ki * bi[q][1]);
              wre[2 * q + 1] = cvt_pk_bf16(kr * br[q][2] - ki * bi[q][2], kr * br[q][3] - ki * bi[q][3]);
              wim[2 * q]     = cvt_pk_bf16(kr * bi[q][0] + ki * br[q][0], kr * bi[q][1] + ki * br[q][1]);
              wim[2 * q + 1] = cvt_pk_bf16(kr * bi[q][2] + ki * br[q][2], kr * bi[q][3] + ki * br[q][3]); }
          u32x4* dre = (u32x4*)(BbT + ((size_t)(g * 4 + 0 + (n >> 5)) * 32 + (n & 31)) * 16); u32x4* dim_ = (u32x4*)(BbT + ((size_t)(g * 4 + 2 + (n >> 5)) * 32 + (n & 31)) * 16);
          dre[0] = (u32x4){wre[0], wre[1], wre[2], wre[3]}; dre[1] = (u32x4){wre[4], wre[5], wre[6], wre[7]};
          dim_[0] = (u32x4){wim[0], wim[1], wim[2], wim[3]}; dim_[1] = (u32x4){wim[4], wim[5], wim[6], wim[7]};
#pragma unroll
          for (int h = 0; h < NH; ++h) *(unsigned*)(Ct + (size_t)(g * NH + h) * 128 + 2 * n) = cvt_pk_bf16(cre[h], -cim[h]); } }
}

__device__ __forceinline__ void p2_conv(const Frame& F, const Args& a) {
    const bf16_t* v = (const bf16_t*)(F.ws + WS_V); const bf16_t* bg = (const bf16_t*)(F.ws + WS_BG); bf16_t* z = (bf16_t*)(F.ws + WS_Z);
    const float* cw = a.in[3]; const float* cb = a.in[4];
    const int gw = blockIdx.x * 8 + F.wave, NGW = F.G * 8;
    for (int it = gw; it < (T / 8) * 2; it += NGW) {
        const int t0 = (it >> 1) * 8, ch = (it & 1) * 512 + F.lane * 8;
        f32x4 w0a = *(const f32x4*)(cw + ch), w0b = *(const f32x4*)(cw + ch + 4), w1a = *(const f32x4*)(cw + D + ch), w1b = *(const f32x4*)(cw + D + ch + 4);
        f32x4 w2a = *(const f32x4*)(cw + 2 * D + ch), w2b = *(const f32x4*)(cw + 2 * D + ch + 4), ba = *(const f32x4*)(cb + ch), bb = *(const f32x4*)(cb + ch + 4);
        f32x4 p2a = {0.f, 0.f, 0.f, 0.f}, p2b = p2a, p1a = p2a, p1b = p2a;
        if (t0 >= 2) { unpack8(*(const u32x4*)(v + (size_t)(t0 - 2) * D + ch), p2a, p2b); unpack8(*(const u32x4*)(v + (size_t)(t0 - 1) * D + ch), p1a, p1b); }
#pragma unroll
        for (int i = 0; i < 8; ++i) { f32x4 ca, cbv, ga, gb; unpack8(*(const u32x4*)(v + (size_t)(t0 + i) * D + ch), ca, cbv); unpack8(*(const u32x4*)(bg + (size_t)(t0 + i) * D + ch), ga, gb);
            const f32x4 ya = ga * (w0a * p2a + w1a * p1a + w2a * ca + ba), yb = gb * (w0b * p2b + w1b * p1b + w2b * cbv + bb);
            *(u32x4*)(z + (size_t)(t0 + i) * D + ch) = pack8(ya, yb);
            p2a = p1a; p2b = p1b; p1a = ca; p1b = cbv; }
    }
}

__device__ __forceinline__ int tokmap(int r) { return 16 * ((r >> 2) & 1) + 4 * (r >> 3) + (r & 3); }
template <int PASS>
__device__ __forceinline__ void scan_tile(f32x16& re, f32x16& im, const f32x4 c, float& Rr, float& Ri, int hf) {
    const float ar = c[0], ai = c[1];
    float sr = hf ? 0.f : Rr, si = hf ? 0.f : Ri;
#pragma unroll
    for (int q = 0; q < 16; ++q) { const float nr = ar * sr - ai * si + re[q], ni = ar * si + ai * sr + im[q]; sr = nr; si = ni; re[q] = sr; im[q] = si; }
    const float orr = __shfl_xor(sr, 32), oii = __shfl_xor(si, 32);
    Rr = c[2] * sr - c[3] * si + orr; Ri = c[2] * si + c[3] * sr + oii;
    if (PASS == 2) {
        float cr = hf ? orr : 0.f, ci = hf ? oii : 0.f;
#pragma unroll
        for (int q = 0; q < 16; ++q) { const float nr = ar * cr - ai * ci, ni = ar * ci + ai * cr; cr = nr; ci = ni; re[q] += cr; im[q] += ci; }
    }
}
template <int PASS>
__device__ __forceinline__ void ssm_pass(const Frame& F, const Args& a) {
    const int lane = F.lane, hf = lane >> 5, col = lane & 31;
    const f32x4* tab_a = (const f32x4*)(F.ws + WS_TABA); const float2* tab_a256 = (const float2*)(F.ws + WS_TABA256);
    const bf16_t* BbT = (const bf16_t*)(F.ws + WS_BBT); const bf16_t* Ct = (const bf16_t*)(F.ws + WS_CT);
    const bf16_t* ub = (const bf16_t*)(F.ws + WS_UB); bf16_t* ys = (bf16_t*)(F.ws + WS_YS); float* E = (float*)(F.ws + WS_E);
    LAS unsigned char* sl = F.lds + F.wave * 8704;
    for (int id = blockIdx.x * 8 + F.wave; id < NG * (T / 256); id += F.G * 8) {
        const int g = id & 31, r = id >> 5;
        const f32x4 c0 = tab_a[g * NS + col], c1 = tab_a[g * NS + 32 + col];
        bf16x8 Bf[4];
#pragma unroll
        for (int q = 0; q < 4; ++q) Bf[q] = *(const bf16x8*)(BbT + ((size_t)(g * 4 + q) * 32 + col) * 16 + 8 * hf);
        float R0r = 0.f, R0i = 0.f, R1r = 0.f, R1i = 0.f;
        bf16x8 Cf[4], Df;
        if (PASS == 2) {
            const float2 p0 = tab_a256[g * NS + col], p1 = tab_a256[g * NS + 32 + col];
            for (int j = 0; j < r; ++j) {
                const float2 e0 = *(const float2*)(E + ((size_t)(j * NG + g) * NS + col) * 2), e1 = *(const float2*)(E + ((size_t)(j * NG + g) * NS + 32 + col) * 2);
                const float t0r = p0.x * R0r - p0.y * R0i + e0.x, t0i = p0.x * R0i + p0.y * R0r + e0.y; R0r = t0r; R0i = t0i;
                const float t1r = p1.x * R1r - p1.y * R1i + e1.x, t1i = p1.x * R1i + p1.y * R1r + e1.y; R1r = t1r; R1i = t1i; }
#pragma unroll
            for (int kb = 0; kb < 4; ++kb) Cf[kb] = *(const bf16x8*)(Ct + (size_t)(g * NH + (lane & 15)) * 128 + kb * 32 + 8 * (lane >> 4));
            const unsigned dbits = cvt_pk_bf16(a.in[13][g * NH + (lane & 15)], 0.f) & 0xffffu;
#pragma unroll
            for (int jj = 0; jj < 8; ++jj) Df[jj] = (short)((lane < 32 && (8 * (lane >> 4) + jj) == (lane & 15)) ? dbits : 0u);
        }
        for (int c = 0; c < 8; ++c) {
            const int t0 = r * 256 + c * 32;
            const bf16x8 Ua = *(const bf16x8*)(ub + (size_t)(t0 + tokmap(col)) * SW + g * NH + 8 * hf);
            const f32x16 zz = {0.f, 0.f, 0.f, 0.f, 0.f, 0.f, 0.f, 0.f, 0.f, 0.f, 0.f, 0.f, 0.f, 0.f, 0.f, 0.f};
            f32x16 bu0 = __builtin_amdgcn_mfma_f32_32x32x16_bf16(Ua, Bf[0], zz, 0, 0, 0);
            f32x16 bu1 = __builtin_amdgcn_mfma_f32_32x32x16_bf16(Ua, Bf[1], zz, 0, 0, 0);
            f32x16 bu2 = __builtin_amdgcn_mfma_f32_32x32x16_bf16(Ua, Bf[2], zz, 0, 0, 0);
            f32x16 bu3 = __builtin_amdgcn_mfma_f32_32x32x16_bf16(Ua, Bf[3], zz, 0, 0, 0);
            scan_tile<PASS>(bu0, bu2, c0, R0r, R0i, hf);
            scan_tile<PASS>(bu1, bu3, c1, R1r, R1i, hf);
            if (PASS == 2) {
                LAS unsigned* sw = (LAS unsigned*)sl;
#pragma unroll
                for (int q = 0; q < 16; ++q) { sw[(16 * hf + q) * 68 + col] = cvt_pk_bf16(bu0[q], bu2[q]); sw[(16 * hf + q) * 68 + 32 + col] = cvt_pk_bf16(bu1[q], bu3[q]); }
                asm volatile("s_waitcnt lgkmcnt(0)" ::: "memory");
#pragma unroll
                for (int mt = 0; mt < 2; ++mt) {
                    f32x4 y = {0.f, 0.f, 0.f, 0.f};
#pragma unroll
                    for (int kb = 0; kb < 4; ++kb) { const bf16x8 Af = *(const LAS bf16x8*)(sl + ((16 * mt + (lane & 15)) * 68 + kb * 16 + 4 * (lane >> 4)) * 4);
                        y = __builtin_amdgcn_mfma_f32_16x16x32_bf16(Af, Cf[kb], y, 0, 0, 0); }
                    bf16x8 A2 = {0, 0, 0, 0, 0, 0, 0, 0};
                    if (lane < 32) A2 = *(const bf16x8*)(ub + (size_t)(t0 + 16 * mt + (lane & 15)) * SW + g * NH + 8 * (lane >> 4));
                    y = __builtin_amdgcn_mfma_f32_16x16x32_bf16(A2, Df, y, 0, 0, 0);
#pragma unroll
                    for (int j = 0; j < 4; ++j) ys[(size_t)(t0 + 16 * mt + 4 * (lane >> 4) + j) * SW + g * NH + (lane & 15)] = (bf16_t)(cvt_pk_bf16(fgelu_tanh(y[j]), 0.f) & 0xffffu);
                }
                asm volatile("s_waitcnt lgkmcnt(0)" ::: "memory");
            }
        }
        if (PASS == 1 && hf == 0) {
            *(float2*)(E + ((size_t)(r * NG + g) * NS + col) * 2) = make_float2(R0r, R0i);
            *(float2*)(E + ((size_t)(r * NG + g) * NS + 32 + col) * 2) = make_float2(R1r, R1i);
        }
    }
}

__device__ __forceinline__ void p6_route(const Frame& F, const Args& a) {
    const bf16_t* x1b = (const bf16_t*)(F.ws + WS_X1B); const bf16_t* wrt = (const bf16_t*)(F.ws + WS_WRT); float* rstd2 = (float*)(F.ws + WS_RSTD2);
    int* cnt = (int*)(F.ctl + CW_CNT); int* list = (int*)(F.ws + WS_LIST);
    int* tok_e = (int*)(F.ws + WS_TOK); int* tok_pos = tok_e + 2 * T; float* tok_w = (float*)(tok_pos + 2 * T);
    volatile LAS int* lcnt = (volatile LAS int*)(F.MISC + 96); volatile LAS int* lbase = (volatile LAS int*)(F.MISC + 128);
    LAS float* lg = (LAS float*)(F.lds + F.wave * 4096);
    const int lane = F.lane;
    for (int blk = blockIdx.x; blk < T / 128; blk += F.G) {
        if (F.tid < 32) lcnt[F.tid] = 0;
        __syncthreads();
        const int tok0 = blk * 128 + F.wave * 16;
        f32x4 acc[3]; float ssq = 0.f;
#pragma unroll
        for (int n = 0; n < 3; ++n) acc[n] = (f32x4){0.f, 0.f, 0.f, 0.f};
        for (int kb = 0; kb < 32; ++kb) {
            const u32x4 aw = *(const u32x4*)(x1b + (size_t)(tok0 + (lane & 15)) * D + kb * 32 + 8 * (lane >> 4));
            f32x4 p, q; unpack8(aw, p, q); ssq += (p[0] * p[0] + p[1] * p[1]) + (p[2] * p[2] + p[3] * p[3]) + (q[0] * q[0] + q[1] * q[1]) + (q[2] * q[2] + q[3] * q[3]);
            bf16x8 Af; Af = __builtin_bit_cast(bf16x8, aw);
#pragma unroll
            for (int n = 0; n < 3; ++n) { const bf16x8 Bfr = *(const bf16x8*)(wrt + (size_t)(n * 16 + (lane & 15)) * D + kb * 32 + 8 * (lane >> 4));
                acc[n] = __builtin_amdgcn_mfma_f32_16x16x32_bf16(Af, Bfr, acc[n], 0, 0, 0); }
        }
        ssq += __shfl_xor(ssq, 16); ssq += __shfl_xor(ssq, 32);
        const float rs = rsqrtf(ssq * (1.f / D) + EPS);
#pragma unroll
        for (int n = 0; n < 3; ++n)
#pragma unroll
            for (int j = 0; j < 4; ++j) lg[(4 * (lane >> 4) + j) * 52 + n * 16 + (lane & 15)] = acc[n][j];
        asm volatile("s_waitcnt lgkmcnt(0)" ::: "memory");
        int e1 = 0, e2 = 0, rk1 = 0, rk2 = 0; float wt1 = 0.f, wt2 = 0.f;
        if (lane < 16) {
            const LAS float* my = lg + lane * 52;
            float l0 = my[0] * rs + a.in[20][0], l1 = my[1] * rs + a.in[20][1], l2 = my[2] * rs + a.in[20][2], l3 = my[3] * rs + a.in[20][3];
            int gi = 0; float lmax = l0;
            if (l1 > lmax) { lmax = l1; gi = 1; } if (l2 > lmax) { lmax = l2; gi = 2; } if (l3 > lmax) { lmax = l3; gi = 3; }
            const float se = __expf(l0 - lmax) + __expf(l1 - lmax) + __expf(l2 - lmax) + __expf(l3 - lmax);
            const float pg = 1.f / se;
            float v1 = -3.0e38f, v2 = -3.0e38f; int i1 = 0, i2 = 0;
#pragma unroll
            for (int j = 0; j < 8; ++j) { const float vv = my[4 + gi * 8 + j] * rs + a.in[22][gi * 8 + j];
                if (vv > v1) { v2 = v1; i2 = i1; v1 = vv; i1 = j; } else if (vv > v2) { v2 = vv; i2 = j; } }
            const float w1 = 1.f / (1.f + __expf(v2 - v1));
            e1 = gi * 8 + i1; e2 = gi * 8 + i2; wt1 = pg * w1; wt2 = pg * (1.f - w1);
            rk1 = __hip_atomic_fetch_add((LAS int*)&lcnt[e1], 1, __ATOMIC_RELAXED, __HIP_MEMORY_SCOPE_WORKGROUP);
            rk2 = __hip_atomic_fetch_add((LAS int*)&lcnt[e2], 1, __ATOMIC_RELAXED, __HIP_MEMORY_SCOPE_WORKGROUP);
            rstd2[tok0 + lane] = rs;
        }
        __syncthreads();
        if (F.tid < 32) { const int c = lcnt[F.tid]; lbase[F.tid] = c ? __hip_atomic_fetch_add(&cnt[F.tid], c, __ATOMIC_RELAXED, __HIP_MEMORY_SCOPE_AGENT) : 0; }
        __syncthreads();
        if (lane < 16) { const int t = tok0 + lane; const int p1 = lbase[e1] + rk1, p2 = lbase[e2] + rk2;
            list[e1 * T + p1] = t; list[e2 * T + p2] = t;
            tok_e[2 * t] = e1; tok_e[2 * t + 1] = e2; tok_pos[2 * t] = p1; tok_pos[2 * t + 1] = p2; tok_w[2 * t] = wt1; tok_w[2 * t + 1] = wt2; }
        __syncthreads();
    }
}
__device__ __forceinline__ void p6_convert(const Frame& F, const Args& a) {
    LAS unsigned char* scr = F.lds + F.wave * 16384;
    bf16_t* Wgu_t = (bf16_t*)(F.ws + WS_WGU); bf16_t* Wd_t = (bf16_t*)(F.ws + WS_WD);
    const int gw = blockIdx.x * 8 + F.wave, NGW = F.G * 8;
    constexpr int I_GU = NE * 16 * 16, I_D = NE * 8 * 16;
    for (int it = gw; it < I_GU + I_D; it += NGW) {
        if (it < I_GU) { const int e = it / 256, r = it % 256, kb = r / 16, nb = r % 16, j0 = 64 * nb, pn = j0 >> 8, i = j0 & 255;
            tr64((i < 128 ? a.in[23] : a.in[24]) + (size_t)e * D * EFF, EFF, 128 * pn + (i & 127), 64 * kb, a.in[18], Wgu_t, (size_t)e * 1024 + j0, D, scr, F.lane); }
        else { const int q = it - I_GU, e = q / 128, r = q % 128, kb = r / 16, nb = r % 16;
            tr64(a.in[25] + (size_t)e * EFF * D, D, 64 * nb, 64 * kb, nullptr, Wd_t, (size_t)e * 1024 + 64 * nb, EFF, scr, F.lane); }
    }
}
__device__ __forceinline__ void load_tb(const Frame& F) {
    volatile LAS int* tb = (volatile LAS int*)(F.MISC + 16); volatile LAS int* lc = (volatile LAS int*)(F.MISC + 64);
    if (F.tid < 32) lc[F.tid] = (int)__hip_atomic_load(F.ctl + CW_CNT + F.tid, __ATOMIC_RELAXED, __HIP_MEMORY_SCOPE_AGENT);
    __syncthreads();
    if (F.tid == 0) { int s = 0; for (int e = 0; e < 32; ++e) { tb[e] = s; s += (lc[e] + 255) >> 8; } tb[32] = s; }
    __syncthreads();
}
__device__ __forceinline__ void p9_final(const Frame& F, const Args& a) {
    const LAS int* tb = (const LAS int*)(F.MISC + 16);
    const int* tok_e = (const int*)(F.ws + WS_TOK); const int* tok_pos = tok_e + 2 * T; const float* tok_w = (const float*)(tok_pos + 2 * T);
    const bf16_t* Y = (const bf16_t*)(F.ws + WS_Y); const float* gf = a.in[26]; float* out = a.out;
    const int gw = blockIdx.x * 8 + F.wave, NGW = F.G * 8;
    for (int t = gw; t < T; t += NGW) {
        const int s1 = 256 * tb[tok_e[2 * t]] + tok_pos[2 * t], s2 = 256 * tb[tok_e[2 * t + 1]] + tok_pos[2 * t + 1];
        const float w1 = tok_w[2 * t], w2 = tok_w[2 * t + 1];
        f32x4 va[2], vb[2]; float s = 0.f;
#pragma unroll
        for (int j = 0; j < 2; ++j) { const int c = 8 * F.lane + 512 * j; f32x4 ya, yb, za, zb;
            unpack8(*(const u32x4*)(Y + (size_t)s1 * D + c), ya, yb); unpack8(*(const u32x4*)(Y + (size_t)s2 * D + c), za, zb);
            va[j] = *(const f32x4*)(out + (size_t)t * D + c) + w1 * ya + w2 * za; vb[j] = *(const f32x4*)(out + (size_t)t * D + c + 4) + w1 * yb + w2 * zb;
            s += (va[j][0] * va[j][0] + va[j][1] * va[j][1]) + (va[j][2] * va[j][2] + va[j][3] * va[j][3]) + (vb[j][0] * vb[j][0] + vb[j][1] * vb[j][1]) + (vb[j][2] * vb[j][2] + vb[j][3] * vb[j][3]); }
        const float rs = rsqrtf(wave_sum64(s) * (1.f / D) + EPS);
#pragma unroll
        for (int j = 0; j < 2; ++j) { const int c = 8 * F.lane + 512 * j;
            *(f32x4*)(out + (size_t)t * D + c) = va[j] * rs * *(const f32x4*)(gf + c); *(f32x4*)(out + (size_t)t * D + c + 4) = vb[j] * rs * *(const f32x4*)(gf + c + 4); }
    }
}

__global__ void __launch_bounds__(512, 2) mega_fwd(Args args) {
    extern __shared__ __attribute__((aligned(16))) unsigned char lds_raw[];
    Frame F;
    F.lds = (LAS unsigned char*)lds_raw; F.MISC = (volatile LAS unsigned*)(F.lds + MISC_OFF);
    F.tid = threadIdx.x; F.lane = F.tid & 63; F.wave = __builtin_amdgcn_readfirstlane(F.tid >> 6); F.G = gridDim.x;
    F.ws = args.ws; F.ctl = (unsigned*)(args.ws + WS_CTL);
    for (int u = F.tid; u < (LDS_BYTES - MISC_OFF) / 4; u += 512) ((LAS unsigned*)(F.lds + MISC_OFF))[u] = 0u;
    __syncthreads();
    XcdBarrier bar; bar.bar = F.ctl + CW_BAR; bar.x = 0; bar.st = nullptr;
    if (args.use_bar) bar = xcd_barrier_post(F.ctl + CW_BAR, F.MISC + 0);
    const int lo = args.ph_lo, hi = args.ph_hi;
#define IN(k) (lo <= (k) && (k) < hi)
#define SEAM(k) do { if (IN(k) && IN((k) + 1)) xcd_barrier(bar); } while (0)
    unsigned char* ws = args.ws;
    const int c = (int)blockIdx.x;

    if (IN(0)) { p0_prologue(F, args); }
    SEAM(0);
    if (IN(1)) {
        pg8::DenseOrder S{(const char*)(ws + WS_XB), (const char*)(ws + WS_WIN), D, T / 256, INC / 256, 1, F.G, c};
        EpiWin E{(const float*)(ws + WS_RSTD1), (bf16_t*)(ws + WS_V), (bf16_t*)(ws + WS_BG), (bf16_t*)(ws + WS_UB), (bf16_t*)(ws + WS_GATES), args.in[16]};
        pg8::gemm_phase<EpiWin, pg8::DenseOrder, false, true>(F.lds, D, S, E);
    }
    SEAM(1);
    if (IN(2)) { p2_conv(F, args); ssm_pass<1>(F, args); }
    SEAM(2);
    if (IN(3)) { ssm_pass<2>(F, args); }
    SEAM(3);
    if (IN(4)) {
        { pg8::DenseOrder S{(const char*)(ws + WS_YS), (const char*)(ws + WS_WGLU), SW, T / 256, 4, 2, F.G, c};
          EpiGlu E{(const bf16_t*)(ws + WS_GATES), (bf16_t*)(ws + WS_MB)};
          pg8::gemm_phase<EpiGlu, pg8::DenseOrder, false, true>(F.lds, SW, S, E); }
        asm volatile("s_waitcnt vmcnt(0)" ::: "memory"); __syncthreads();
        { pg8::DenseOrder S{(const char*)(ws + WS_Z), (const char*)(ws + WS_WC), D, T / 256, 4, 1, F.G, c};
          EpiMix E{(const bf16_t*)(ws + WS_GATES), (const bf16_t*)(ws + WS_MB), (bf16_t*)(ws + WS_MIXED)};
          pg8::gemm_phase<EpiMix, pg8::DenseOrder, false, true>(F.lds, D, S, E); }
    }
    SEAM(4);
    if (IN(5)) {
        pg8::DenseOrder S{(const char*)(ws + WS_MIXED), (const char*)(ws + WS_WO), D, T / 256, 4, 1, F.G, c};
        EpiX1 E{args.in[0], args.out, (bf16_t*)(ws + WS_X1B)};
        pg8::gemm_phase<EpiX1, pg8::DenseOrder, false, true>(F.lds, D, S, E);
    }
    SEAM(5);
    if (IN(6)) { p6_route(F, args); p6_convert(F, args); }
    SEAM(6);
    if (IN(7)) {
        load_tb(F);
        pg8::MoEOrder S{(const LAS int*)(F.MISC + 16), (const LAS int*)(F.MISC + 64), (const int*)(ws + WS_LIST), (const char*)(ws + WS_X1B), (const char*)(ws + WS_WGU), D, (size_t)1024 * D * 2, F.G, c, true};
        EpiUp E{(const int*)(ws + WS_LIST), (const float*)(ws + WS_RSTD2), (bf16_t*)(ws + WS_HMID)};
        pg8::gemm_phase<EpiUp, pg8::MoEOrder, true, true>(F.lds, D, S, E);
    }
    SEAM(7);
    if (IN(8)) {
        load_tb(F);
        pg8::MoEOrder S{(const LAS int*)(F.MISC + 16), (const LAS int*)(F.MISC + 64), (const int*)(ws + WS_LIST), (const char*)(ws + WS_HMID), (const char*)(ws + WS_WD), EFF, (size_t)1024 * EFF * 2, F.G, c, false};
        EpiDown E{(bf16_t*)(ws + WS_Y)};
        pg8::gemm_phase<EpiDown, pg8::MoEOrder, false, true>(F.lds, EFF, S, E);
    }
    SEAM(8);
    if (IN(9)) { load_tb(F); p9_final(F, args); }
#undef IN
#undef SEAM
}

#ifndef MK_MODE
#define MK_MODE 2
#endif
extern "C" void kernel_launch(void* const* d_in, const int* in_sizes, int n_in, void* d_out, int out_size, void* d_ws, size_t ws_size, hipStream_t stream) {
    static int grid = 0;
    if (grid == 0) {
        int dev = 0, cus = 0, per_cu = 0;
        (void)hipGetDevice(&dev); (void)hipDeviceGetAttribute(&cus, hipDeviceAttributeMultiprocessorCount, dev);
        (void)hipFuncSetAttribute((const void*)mega_fwd, hipFuncAttributeMaxDynamicSharedMemorySize, LDS_BYTES);
        (void)hipOccupancyMaxActiveBlocksPerMultiprocessor(&per_cu, (const void*)mega_fwd, 512, LDS_BYTES);
        (void)hipGetLastError();
        grid = cus * (per_cu < 1 ? 1 : 1);
    }
    (void)hipMemsetAsync((char*)d_ws + WS_CTL, 0, CTL_BYTES, stream);
    Args a{};
    for (int i = 0; i < 27; ++i) a.in[i] = (const float*)d_in[i];
    a.out = (float*)d_out; a.ws = (unsigned char*)d_ws;
#if MK_MODE == 2
    a.ph_lo = 0; a.ph_hi = 10; a.use_bar = 1;
    hipLaunchKernelGGL(mega_fwd, dim3(grid), dim3(512), LDS_BYTES, stream, a);
#else
    const int nfast = (MK_MODE == 1) ? 6 : 10;
    for (int p = 0; p < nfast; ++p) { a.ph_lo = p; a.ph_hi = p + 1; a.use_bar = 0; hipLaunchKernelGGL(mega_fwd, dim3(grid), dim3(512), LDS_BYTES, stream, a); }
#if MK_MODE == 1
    {
        using namespace nv;
        float* out = (float*)d_out; char* ws = (char*)d_ws; const size_t MiB_ = 1u << 20;
        float* hbuf = (float*)(ws); float* B1 = (float*)(ws + 64 * MiB_); float* B2 = (float*)(ws + 128 * MiB_);
        char* misc = ws + 256 * MiB_;
        int* cnt = (int*)(misc + 2 * MiB_); int* off = cnt + 64; int* list = (int*)(misc + 2 * MiB_ + 4096);
        int* tok_e = (int*)(misc + 5 * MiB_); int* tok_pos = tok_e + 2 * nv::T; float* tok_w = (float*)(tok_pos + 2 * nv::T);
        const dim3 b256(256);
        const float* norm_ffn = (const float*)d_in[18]; const float* wrg = (const float*)d_in[19]; const float* brg = (const float*)d_in[20]; const float* wre = (const float*)d_in[21]; const float* bre = (const float*)d_in[22];
        const float* w_gate = (const float*)d_in[23]; const float* w_up = (const float*)d_in[24]; const float* w_down = (const float*)d_in[25]; const float* norm_final = (const float*)d_in[26];
        hipLaunchKernelGGL(k_rmsnorm, dim3(nv::T / 4), b256, 0, stream, out, norm_ffn, hbuf, nv::T);
        (void)hipMemsetAsync(cnt, 0, 512, stream);
        hipLaunchKernelGGL(k_route, dim3(nv::T / 4), b256, 0, stream, hbuf, wrg, brg, wre, bre, cnt, list, tok_e, tok_pos, tok_w);
        hipLaunchKernelGGL(k_offsets, dim3(1), dim3(64), 0, stream, cnt, off);
        float* Hm = B1; float* Yd = B2;
        for (int e = 0; e < nv::NE; ++e)
            hipLaunchKernelGGL(k_gemm<2>, dim3(nv::EFF / 64, nv::T / 64), b256, 0, stream, hbuf, nv::D, list + e * nv::T, nullptr, w_gate + (size_t)e * nv::D * nv::EFF, w_up + (size_t)e * nv::D * nv::EFF, nv::EFF,
                               Hm, nv::EFF, off + e, nullptr, 0, cnt + e, nv::EFF, nv::D);
        for (int e = 0; e < nv::NE; ++e)
            hipLaunchKernelGGL(k_gemm<0>, dim3(nv::D / 64, nv::T / 64), b256, 0, stream, Hm, nv::EFF, nullptr, off + e, w_down + (size_t)e * nv::EFF * nv::D, nullptr, nv::D,
                               Yd, nv::D, off + e, nullptr, 0, cnt + e, nv::D, nv::EFF);
        hipLaunchKernelGGL(k_final, dim3(nv::T / 4), b256, 0, stream, out, Yd, off, tok_e, tok_pos, tok_w, norm_final);
    }
#endif
#endif
}
```

```cpp
#define CV_EARLY_ITEMS 0
#include <hip/hip_runtime.h>
#include <stdint.h>
#include <cstdio>

namespace nv {
constexpr int T = 16384, D = 1024, SW = 512, NG = 32, NS = 64, NH = 16, INC = 5632, NE = 32, EFF = 512;
constexpr float EPS = 1e-6f;

__device__ __forceinline__ float wave_sum(float v) {
#pragma unroll
    for (int o = 1; o < 64; o <<= 1) v += __shfl_xor(v, o);
    return v;
}
__device__ __forceinline__ float sigmoidf_(float x) { return 1.f / (1.f + __expf(-x)); }
__device__ __forceinline__ float gelu_tanh(float x) { const float u = 0.7978845608028654f * (x + 0.044715f * x * x * x); return 0.5f * x * (1.f + tanhf(u)); }

__global__ __launch_bounds__(256) void k_rmsnorm(const float* x, const float* g, float* y, int rows) {
    const int row = blockIdx.x * 4 + (threadIdx.x >> 6), lane = threadIdx.x & 63;
    if (row >= rows) return;
    const float4* xr = (const float4*)(x + (size_t)row * D);
    float4 v[4]; float s = 0.f;
#pragma unroll
    for (int j = 0; j < 4; ++j) { v[j] = xr[lane + 64 * j]; s += v[j].x * v[j].x + v[j].y * v[j].y + v[j].z * v[j].z + v[j].w * v[j].w; }
    const float r = rsqrtf(wave_sum(s) * (1.f / D) + EPS);
    float4* yr = (float4*)(y + (size_t)row * D);
#pragma unroll
    for (int j = 0; j < 4; ++j) { const float4 gg = ((const float4*)g)[lane + 64 * j]; yr[lane + 64 * j] = make_float4(v[j].x * r * gg.x, v[j].y * r * gg.y, v[j].z * r * gg.z, v[j].w * r * gg.w); }
}

template <int MODE>
__global__ __launch_bounds__(256) void k_gemm(const float* A, int lda, const int* gather, const int* aoff_dev, const float* B, const float* B2, int ldb,
                                              float* C, int ldc, const int* coff_dev, const float* resid, int M, const int* Mdev, int N, int K) {
    __shared__ float As[16][68];
    __shared__ float Bs[16][64];
    __shared__ float Bs2[16][64];
    if (Mdev) M = *Mdev;
    const int row0 = blockIdx.y * 64, col0 = blockIdx.x * 64;
    if (row0 >= M) return;
    const int aoff = aoff_dev ? *aoff_dev : 0, coff = coff_dev ? *coff_dev : 0;
    const int tid = threadIdx.x, ty = tid >> 4, tx = tid & 15;
    const int lr = tid >> 2, lk = (tid & 3) * 4;
    const int bk = tid >> 4, bn = (tid & 15) * 4;
    int arow = -1;
    if (row0 + lr < M) arow = gather ? gather[row0 + lr] : (aoff + row0 + lr);
    float acc[4][4] = {}, acc2[4][4] = {};
    for (int k0 = 0; k0 < K; k0 += 16) {
        float4 av = make_float4(0.f, 0.f, 0.f, 0.f);
        if (arow >= 0) av = *(const float4*)(A + (size_t)arow * lda + k0 + lk);
        As[lk + 0][lr] = av.x; As[lk + 1][lr] = av.y; As[lk + 2][lr] = av.z; As[lk + 3][lr] = av.w;
        *(float4*)&Bs[bk][bn] = *(const float4*)(B + (size_t)(k0 + bk) * ldb + col0 + bn);
        if (MODE >= 2) *(float4*)&Bs2[bk][bn] = *(const float4*)(B2 + (size_t)(k0 + bk) * ldb + col0 + bn);
        __syncthreads();
#pragma unroll
        for (int k = 0; k < 16; ++k) {
            const float4 a = *(const float4*)&As[k][ty * 4];
            const float4 b = *(const float4*)&Bs[k][tx * 4];
            const float aa[4] = {a.x, a.y, a.z, a.w}, bb[4] = {b.x, b.y, b.z, b.w};
#pragma unroll
            for (int i = 0; i < 4; ++i)
#pragma unroll
                for (int j = 0; j < 4; ++j) acc[i][j] += aa[i] * bb[j];
            if (MODE >= 2) {
                const float4 b2 = *(const float4*)&Bs2[k][tx * 4]; const float cc[4] = {b2.x, b2.y, b2.z, b2.w};
#pragma unroll
                for (int i = 0; i < 4; ++i)
#pragma unroll
                    for (int j = 0; j < 4; ++j) acc2[i][j] += aa[i] * cc[j];
            }
        }
        __syncthreads();
    }
#pragma unroll
    for (int i = 0; i < 4; ++i) {
        const int r = row0 + ty * 4 + i;
        if (r >= M) continue;
        float o[4];
#pragma unroll
        for (int j = 0; j < 4; ++j) {
            float v = acc[i][j];
            if (MODE == 2) v = (v * sigmoidf_(v)) * acc2[i][j];
            if (MODE == 3) v = v * sigmoidf_(acc2[i][j]);
            o[j] = v;
        }
        const size_t ci = (size_t)(coff + r) * ldc + col0 + tx * 4;
        if (MODE == 1) { const float4 rr = *(const float4*)(resid + ci); o[0] += rr.x; o[1] += rr.y; o[2] += rr.z; o[3] += rr.w; }
        *(float4*)(C + ci) = make_float4(o[0], o[1], o[2], o[3]);
    }
}

__global__ __launch_bounds__(256) void k_conv(const float* xc, const float* cg, float* bg_z, const float* cw, const float* cb) {
    const size_t i = (size_t)blockIdx.x * 256 + threadIdx.x;
    const int t = (int)(i / D), c = (int)(i % D);
    float y = cb[c] + cw[2 * D + c] * (cg[i] * xc[i]);
    if (t >= 1) y += cw[1 * D + c] * (cg[i - D] * xc[i - D]);
    if (t >= 2) y += cw[0 * D + c] * (cg[i - 2 * D] * xc[i - 2 * D]);
    bg_z[i] = bg_z[i] * y;
}

struct cplx { float re, im; };
__device__ __forceinline__ cplx cmul(cplx a, cplx b) { return {a.re * b.re - a.im * b.im, a.re * b.im + a.im * b.re}; }

__device__ __forceinline__ void ssm_consts(const float* a_re, const float* a_im, const float* log_dt, int g, int n, cplx& abar, cplx& coef, cplx& a256) {
    const double lr = a_re[g * NS + n], li = a_im[g * NS + n], dt = exp((double)log_dt[g]);
    const double er = exp(lr * dt), cr = er * cos(li * dt), ci = er * sin(li * dt);
    abar = {(float)cr, (float)ci};
    const double nr = cr - 1.0, ni = ci, den = lr * lr + li * li;
    coef = {(float)((nr * lr + ni * li) / den), (float)((ni * lr - nr * li) / den)};
    const double e2 = exp(lr * dt * 256.0);
    a256 = {(float)(e2 * cos(li * dt * 256.0)), (float)(e2 * sin(li * dt * 256.0))};
}

template <int PASS>
__global__ __launch_bounds__(64) void k_ssm(const float* u, const float* a_re, const float* a_im, const float* log_dt, const float* b_re, const float* b_im,
                                            const float* c_re, const float* c_im, const float* dsk, float* E, const float* Cin, float* ys) {
    __shared__ float part[16][65];
    const int g = blockIdx.x, r = blockIdx.y, n = threadIdx.x;
    cplx abar, coef, a256; ssm_consts(a_re, a_im, log_dt, g, n, abar, coef, a256);
    cplx bb[16]; float cre[16], cim[16];
#pragma unroll
    for (int h = 0; h < 16; ++h) {
        bb[h] = cmul(coef, cplx{b_re[(g * NS + n) * NH + h], b_im[(g * NS + n) * NH + h]});
        cre[h] = c_re[(g * NH + h) * NS + n]; cim[h] = c_im[(g * NH + h) * NS + n];
    }
    cplx s = {0.f, 0.f};
    if (PASS == 2) s = {Cin[((size_t)(r * NG + g) * NS + n) * 2], Cin[((size_t)(r * NG + g) * NS + n) * 2 + 1]};
    for (int t = r * 256; t < r * 256 + 256; ++t) {
        const float* ut = u + (size_t)t * SW + g * NH;
        cplx bu = {0.f, 0.f};
#pragma unroll
        for (int h = 0; h < 16; ++h) { const float uv = ut[h]; bu.re += bb[h].re * uv; bu.im += bb[h].im * uv; }
        s = cmul(abar, s); s.re += bu.re; s.im += bu.im;
        if (PASS == 2) {
#pragma unroll
            for (int h = 0; h < 16; ++h) part[h][n] = cre[h] * s.re - cim[h] * s.im;
            __syncthreads();
            const int h = n & 15, q = n >> 4; float y = 0.f;
#pragma unroll
            for (int j = 0; j < 16; ++j) y += part[h][q * 16 + j];
            y += __shfl_xor(y, 16); y += __shfl_xor(y, 32);
            if (q == 0) { const float v = y + dsk[g * NH + h] * ut[h]; ys[(size_t)t * SW + g * NH + h] = gelu_tanh(v); }
            __syncthreads();
        }
    }
    if (PASS == 1) { E[((size_t)(r * NG + g) * NS + n) * 2] = s.re; E[((size_t)(r * NG + g) * NS + n) * 2 + 1] = s.im; }
}
__global__ __launch_bounds__(64) void k_ssm_carry(const float* a_re, const float* a_im, const float* log_dt, const float* E, float* Cin) {
    const int g = blockIdx.x, n = threadIdx.x;
    cplx abar, coef, a256; ssm_consts(a_re, a_im, log_dt, g, n, abar, coef, a256);
    cplx run = {0.f, 0.f};
    for (int r = 0; r < T / 256; ++r) {
        const size_t i = ((size_t)(r * NG + g) * NS + n) * 2;
        Cin[i] = run.re; Cin[i + 1] = run.im;
        run = cmul(a256, run); run.re += E[i]; run.im += E[i + 1];
    }
}

template <int ADD>
__global__ __launch_bounds__(256) void k_mix(const float* gl, const float* bias, const float* y, float* m) {
    const size_t i = (size_t)blockIdx.x * 256 + threadIdx.x; const int c = (int)(i % D);
    const float v = sigmoidf_(gl[i] + bias[c]) * y[i];
    m[i] = ADD ? m[i] + v : v;
}

__global__ __launch_bounds__(256) void k_route(const float* h2, const float* wrg, const float* brg, const float* wre, const float* bre,
                                               int* cnt, int* list, int* tok_e, int* tok_pos, float* tok_w) {
    const int t = blockIdx.x * 4 + (threadIdx.x >> 6), lane = threadIdx.x & 63;
    float acc[36];
#pragma unroll
    for (int j = 0; j < 36; ++j) acc[j] = 0.f;
    for (int k = lane; k < D; k += 64) {
        const float hv = h2[(size_t)t * D + k];
#pragma unroll
        for (int j = 0; j < 4; ++j) acc[j] += hv * wrg[k * 4 + j];
#pragma unroll
        for (int j = 0; j < 32; ++j) acc[4 + j] += hv * wre[k * 32 + j];
    }
#pragma unroll
    for (int j = 0; j < 36; ++j) acc[j] = wave_sum(acc[j]);
    if (lane == 0) {
        float lg[4]; int gi = 0; float lmax;
#pragma unroll
        for (int j = 0; j < 4; ++j) { lg[j] = acc[j] + brg[j]; }
        lmax = lg[0];
#pragma unroll
        for (int j = 1; j < 4; ++j) if (lg[j] > lmax) { lmax = lg[j]; gi = j; }
        float se = 0.f;
#pragma unroll
        for (int j = 0; j < 4; ++j) se += __expf(lg[j] - lmax);
        const float pg = 1.f / se;
        float v1 = -3.0e38f, v2 = -3.0e38f; int i1 = 0, i2 = 0;
#pragma unroll
        for (int j = 0; j < 8; ++j) { float v = 0.f;
#pragma unroll
            for (int q = 0; q < 4; ++q) if (q == gi) v = acc[4 + q * 8 + j] + bre[q * 8 + j];
            if (v > v1) { v2 = v1; i2 = i1; v1 = v; i1 = j; } else if (v > v2) { v2 = v; i2 = j; } }
        const float w1 = 1.f / (1.f + __expf(v2 - v1)), w2 = 1.f - w1;
        const int e1 = gi * 8 + i1, e2 = gi * 8 + i2;
        const int p1 = atomicAdd(&cnt[e1], 1), p2 = atomicAdd(&cnt[e2], 1);
        list[e1 * T + p1] = t; list[e2 * T + p2] = t;
        tok_e[t * 2] = e1; tok_e[t * 2 + 1] = e2; tok_pos[t * 2] = p1; tok_pos[t * 2 + 1] = p2;
        tok_w[t * 2] = pg * w1; tok_w[t * 2 + 1] = pg * w2;
    }
}
__global__ void k_offsets(const int* cnt, int* off) { if (threadIdx.x == 0) { int s = 0; for (int e = 0; e < NE; ++e) { off[e] = s; s += cnt[e]; } } }

__global__ __launch_bounds__(256) void k_final(float* out, const float* Y, const int* off, const int* tok_e, const int* tok_pos, const float* tok_w, const float* g) {
    const int t = blockIdx.x * 4 + (threadIdx.x >> 6), lane = threadIdx.x & 63;
    const int s1 = off[tok_e[t * 2]] + tok_pos[t * 2], s2 = off[tok_e[t * 2 + 1]] + tok_pos[t * 2 + 1];
    const float w1 = tok_w[t * 2], w2 = tok_w[t * 2 + 1];
    float4* xr = (float4*)(out + (size_t)t * D);
    const float4* y1 = (const float4*)(Y + (size_t)s1 * D); const float4* y2 = (const float4*)(Y + (size_t)s2 * D);
    float4 v[4]; float s = 0.f;
#pragma unroll
    for (int j = 0; j < 4; ++j) { const float4 a = xr[lane + 64 * j], b = y1[lane + 64 * j], c = y2[lane + 64 * j];
        v[j] = make_float4(a.x + w1 * b.x + w2 * c.x, a.y + w1 * b.y + w2 * c.y, a.z + w1 * b.z + w2 * c.z, a.w + w1 * b.w + w2 * c.w);
        s += v[j].x * v[j].x + v[j].y * v[j].y + v[j].z * v[j].z + v[j].w * v[j].w; }
    const float r = rsqrtf(wave_sum(s) * (1.f / D) + EPS);
#pragma unroll
    for (int j = 0; j < 4; ++j) { const float4 gg = ((const float4*)g)[lane + 64 * j]; xr[lane + 64 * j] = make_float4(v[j].x * r * gg.x, v[j].y * r * gg.y, v[j].z * r * gg.z, v[j].w * r * gg.w); }
}
}

#define LAS __attribute__((address_space(3)))
typedef unsigned short bf16_t;
typedef short bf16x8 __attribute__((ext_vector_type(8)));
typedef float f32x4 __attribute__((ext_vector_type(4)));
typedef float f32x16 __attribute__((ext_vector_type(16)));
typedef unsigned u32x4 __attribute__((ext_vector_type(4)));
typedef unsigned u32x2 __attribute__((ext_vector_type(2)));

constexpr int T = 16384, D = 1024, SW = 512, NG = 32, NS = 64, NH = 16, INC = 5632, NE = 32, EFF = 512;
constexpr float EPS = 1e-6f;

__device__ __forceinline__ unsigned cvt_pk_bf16(float lo, float hi) { unsigned r; asm volatile("v_cvt_pk_bf16_f32 %0, %1, %2" : "=v"(r) : "v"(lo), "v"(hi)); return r; }
__device__ __forceinline__ unsigned cvt4_fp8(float a, float b, float c, float d) { int w = __builtin_amdgcn_cvt_pk_fp8_f32(a, b, 0, false); w = __builtin_amdgcn_cvt_pk_fp8_f32(c, d, w, true); return (unsigned)w; }
__device__ __forceinline__ float bf_lo(unsigned w) { return __uint_as_float(w << 16); }
__device__ __forceinline__ float bf_hi(unsigned w) { return __uint_as_float(w & 0xffff0000u); }
__device__ __forceinline__ float fsigmoid(float x) { return __builtin_amdgcn_rcpf(1.f + __builtin_amdgcn_exp2f(-1.4426950408889634f * x)); }
__device__ __forceinline__ float fsilu(float x) { return x * fsigmoid(x); }
__device__ __forceinline__ float fgelu_tanh(float x) { const float u = 0.7978845608028654f * (x + 0.044715f * x * x * x); return x * fsigmoid(2.f * u); }
__device__ __forceinline__ float wave_sum64(float v) {
#pragma unroll
    for (int o = 1; o < 64; o <<= 1) v += __shfl_xor(v, o);
    return v;
}

namespace pg8 {
constexpr int BM = 256, BK = 64, HALF = 128, HTB = HALF * BK * 2, STAGE_BYTES = 8 * HTB, NXCD = 8, WGM = 8;
__host__ __device__ __forceinline__ int lds_byte(int r, int c) { const int st = (r >> 4) * 2 + (c >> 5), rr = r & 15, cc = c & 31, ob = rr * 64 + cc * 2; return st * 1024 + (ob ^ (((ob >> 9) & 1) << 5)); }
__host__ __device__ __forceinline__ void stage_rc(int b, int& R, int& C) { const int st = b / 1024, sb = b % 1024, swz = sb ^ (((sb >> 9) & 1) << 5); R = (st >> 1) * 16 + swz / 64; C = (st & 1) * 32 + (swz % 64) / 2; }
__host__ __device__ __forceinline__ int perm32(int rho) { const int n = rho >> 4, i = rho & 15; return 8 * (i >> 2) + 4 * n + (i & 3); }

struct Unit { int pm, pn, e, nrow, srow; };

__device__ __forceinline__ void tile_map(int L, int nM, int nN, int& pm, int& pn) {
    const int nwg = nM * nN; int wgid = L;
    { const int q = nwg / NXCD, r = nwg % NXCD, xcd = wgid % NXCD, off = wgid / NXCD; wgid = (xcd < r ? xcd * (q + 1) : r * (q + 1) + (xcd - r) * q) + off; }
    const int nig = WGM * nN, gid = wgid / nig, fm = gid * WGM, gsz = (nM - fm) < WGM ? (nM - fm) : WGM;
    pm = fm + ((wgid % nig) % gsz); pn = (wgid % nig) / gsz;
}
struct DenseOrder {
    const char* A; const char* Bt; int K, nM, nNt, sub, G, c;
    __device__ __forceinline__ bool next(int i, Unit& u) const {
        const int L = (i / sub) * G + c; if (L >= nM * nNt) return false;
        int pm, pn; tile_map(L, nM, nNt, pm, pn); u.pm = pm; u.pn = pn * sub + (i % sub); u.e = 0; u.nrow = 256; u.srow = 0; return true;
    }
    __device__ __forceinline__ const char* a_base(const Unit& u) const { return A + (size_t)u.pm * (size_t)(BM * 2) * K; }
    __device__ __forceinline__ const char* b_base(const Unit& u) const { return Bt + (size_t)u.pn * (size_t)(BM * 2) * K; }
    __device__ __forceinline__ unsigned a_row(const Unit&, int r) const { return (unsigned)r; }
};
struct MoEOrder {
    const LAS int* tb; const LAS int* lc; const int* list; const char* A; const char* Bt; int K; size_t bstride; int G, c; bool gather; const char* Bt2; int esplit;
    __device__ __forceinline__ bool next(int i, Unit& u) const {
        const int L = i * G + c; const int ntile = tb[32]; if (L >= ntile * 4) return false;
        const int tt = L >> 2; int e = 0;
#pragma unroll 1
        for (int q = 1; q < 32; ++q) if (tb[q] <= tt) e = q;
        e = __builtin_amdgcn_readfirstlane(e);
        u.e = e; u.pm = tt - tb[e]; u.pn = L & 3; const int rem = lc[e] - 256 * u.pm; u.nrow = rem < 256 ? rem : 256; u.srow = 256 * tt; return true;
    }
    __device__ __forceinline__ const char* a_base(const Unit& u) const { return gather ? A : A + (size_t)u.srow * 2 * K; }
    __device__ __forceinline__ const char* b_base(const Unit& u) const { return (u.e < esplit ? Bt + (size_t)u.e * bstride : Bt2 + (size_t)(u.e - esplit) * bstride) + (size_t)u.pn * (size_t)(BM * 2) * K; }
    __device__ __forceinline__ unsigned a_row(const Unit& u, int r) const { return r < u.nrow ? (unsigned)list[u.e * T + 256 * u.pm + r] : 0u; }
};

typedef int v8i_t __attribute__((ext_vector_type(8)));
typedef int v4i_t __attribute__((ext_vector_type(4)));
__device__ __forceinline__ v8i_t cat8(const bf16x8 lo, const bf16x8 hi) { const v4i_t a = __builtin_bit_cast(v4i_t, lo), b = __builtin_bit_cast(v4i_t, hi); return __builtin_shufflevector(a, b, 0, 1, 2, 3, 4, 5, 6, 7); }
template <class Epi, class Sched, bool GATHER, bool ALIGN_EPI, bool FP8 = false>
__device__ __forceinline__ void gemm_phase(LAS unsigned char* lds, const int K, const Sched& S, const Epi& E) {
    const int tid = threadIdx.x, wid = __builtin_amdgcn_readfirstlane(tid >> 6), lane = tid & 63, wr = wid >> 2, wc = wid & 3, fr = lane & 15, fq = lane >> 4;
    const int nt = K / BK;
    unsigned voffB[2], vA[2][2], nvA[2][2]; int Rr[2], Cc[2];
#pragma unroll
    for (int i = 0; i < 2; ++i) { int R, C; stage_rc(tid * 16 + i * 8192, R, C); const int Rb = Epi::PERM ? ((R & ~31) + perm32(R & 31)) : R;
        Rr[i] = R; Cc[i] = C; voffB[i] = (unsigned)(Rb * K + C) * 2u; }
    const size_t kstep = (size_t)(BK * 2);
    const size_t hstep = (size_t)HALF * K * 2;
    const unsigned ldsw = (unsigned)wid * 1024u;
    const int aoff = lds_byte(wr * 64 + fr, fq * 8), boff = lds_byte(wc * 32 + fr, fq * 8);
#define PG8_SA(b, h) (((b) * 2 + (h)) * HTB)
#define PG8_SB(b, h) ((4 + (b) * 2 + (h)) * HTB)
#define PG8_STAGE(bufoff, gbase, voff) do { _Pragma("unroll") for (int _i = 0; _i < 2; ++_i) \
        __builtin_amdgcn_global_load_lds((const unsigned*)((const char*)(gbase) + (voff)[_i]), (LAS unsigned*)(lds + (bufoff) + ldsw + _i * 8192), 16, 0, 0); } while (0)
#define PG8_LDA(dst, b, h) do { if constexpr (FP8) { _Pragma("unroll") for (int m = 0; m < 4; ++m) dst##8[m] = cat8(*(const LAS bf16x8*)(lds + PG8_SA(b, h) + aoff + m * 2048), *(const LAS bf16x8*)(lds + PG8_SA(b, h) + aoff + m * 2048 + 1024)); } \
    else { _Pragma("unroll") for (int m = 0; m < 4; ++m) _Pragma("unroll") for (int k = 0; k < 2; ++k) dst[m][k] = *(const LAS bf16x8*)(lds + PG8_SA(b, h) + aoff + m * 2048 + k * 1024); } } while (0)
#define PG8_LDB(dst, b, h) do { if constexpr (FP8) { _Pragma("unroll") for (int n = 0; n < 2; ++n) dst##8[n] = cat8(*(const LAS bf16x8*)(lds + PG8_SB(b, h) + boff + n * 2048), *(const LAS bf16x8*)(lds + PG8_SB(b, h) + boff + n * 2048 + 1024)); } \
    else { _Pragma("unroll") for (int n = 0; n < 2; ++n) _Pragma("unroll") for (int k = 0; k < 2; ++k) dst[n][k] = *(const LAS bf16x8*)(lds + PG8_SB(b, h) + boff + n * 2048 + k * 1024); } } while (0)
#define PG8_MMA(ai, bj, At, Bt) do { __builtin_amdgcn_s_setprio(1); if constexpr (FP8) { _Pragma("unroll") for (int m = 0; m < 4; ++m) _Pragma("unroll") for (int n = 0; n < 2; ++n) \
        asm volatile("v_mfma_scale_f32_16x16x128_f8f6f4 %0, %1, %2, %0, %3, %3 op_sel_hi:[0,0,0]" : "+v"(acc[ai][bj][m][n]) : "v"(Bt##8[n]), "v"(At##8[m]), "v"(sc8)); } \
    else { _Pragma("unroll") for (int m = 0; m < 4; ++m) _Pragma("unroll") for (int n = 0; n < 2; ++n) _Pragma("unroll") for (int k = 0; k < 2; ++k) \
        acc[ai][bj][m][n] = __builtin_amdgcn_mfma_f32_16x16x32_bf16(Bt[n][k], At[m][k], acc[ai][bj][m][n], 0, 0, 0); } __builtin_amdgcn_s_setprio(0); } while (0)
#define PG8_WAIT_V(n) asm volatile("s_waitcnt vmcnt(" #n ")" ::: "memory")
#define PG8_WAIT_L(n) asm volatile("s_waitcnt lgkmcnt(" #n ")" ::: "memory")
#define PG8_BAR __builtin_amdgcn_s_barrier()
#define PG8_SCHED __builtin_amdgcn_sched_barrier(0)
    Unit cur, nxt; int ui = 0;
    if (!S.next(0, cur)) return;
#pragma unroll
    for (int h = 0; h < 2; ++h)
#pragma unroll
        for (int i = 0; i < 2; ++i) vA[h][i] = (unsigned)((GATHER ? S.a_row(cur, h * HALF + Rr[i]) : (unsigned)(h * HALF + Rr[i])) * (unsigned)K + (unsigned)Cc[i]) * 2u;
    f32x4 acc[2][2][4][2];
    if constexpr (Epi::HAS_INIT) E.init(acc, cur, wr, wc, fr, fq);
    else {
#pragma unroll
    for (int a = 0; a < 2; ++a)
#pragma unroll
        for (int b = 0; b < 2; ++b)
#pragma unroll
            for (int m = 0; m < 4; ++m)
#pragma unroll
                for (int n = 0; n < 2; ++n) acc[a][b][m][n] = (f32x4){0.f, 0.f, 0.f, 0.f};
    }
    const int sc8 = 0x7f7f7f7f;
    bf16x8 At[4][2], B0[2][2], B1[2][2]; v8i_t At8[4], B08[2], B18[2];
    const char* cA = S.a_base(cur); const char* cB = S.b_base(cur);
    PG8_STAGE(PG8_SB(0, 0), cB, voffB); PG8_STAGE(PG8_SB(0, 1), cB + hstep, voffB); PG8_STAGE(PG8_SA(0, 0), cA, vA[0]); PG8_STAGE(PG8_SA(0, 1), cA, vA[1]);
    if (wr == 1) PG8_BAR;
    PG8_WAIT_V(2); PG8_BAR;
    PG8_STAGE(PG8_SB(1, 0), cB + kstep, voffB); PG8_STAGE(PG8_SA(1, 0), cA + kstep, vA[0]); PG8_STAGE(PG8_SB(1, 1), cB + hstep + kstep, voffB);
    PG8_WAIT_V(6); PG8_BAR;
    for (;;) {
        const bool has_next = S.next(ui + 1, nxt);
        const char* nA = has_next ? S.a_base(nxt) : cA; const char* nB = has_next ? S.b_base(nxt) : cB;
        if constexpr (GATHER) {
#pragma unroll
            for (int h = 0; h < 2; ++h)
#pragma unroll
                for (int i = 0; i < 2; ++i) nvA[h][i] = has_next ? (unsigned)(S.a_row(nxt, h * HALF + Rr[i]) * (unsigned)K + (unsigned)Cc[i]) * 2u : vA[h][i];
        }
        for (int t = 0; t < nt; t += 2) {
            const bool last = (t == nt - 2);
            const char* a1 = cA + (size_t)(t + 1) * kstep;
            const char* a2 = last ? nA : cA + (size_t)(t + 2) * kstep; const char* b2 = last ? nB : cB + (size_t)(t + 2) * kstep;
            const char* a3 = a2 + kstep; const char* b3 = b2 + kstep;
            unsigned x0[2], x1[2];
            if constexpr (GATHER) { x0[0] = last ? nvA[0][0] : vA[0][0]; x0[1] = last ? nvA[0][1] : vA[0][1]; x1[0] = last ? nvA[1][0] : vA[1][0]; x1[1] = last ? nvA[1][1] : vA[1][1]; }
            else { x0[0] = vA[0][0]; x0[1] = vA[0][1]; x1[0] = vA[1][0]; x1[1] = vA[1][1]; }
            PG8_LDB(B0, 0, 0); PG8_LDB(B1, 0, 1); PG8_SCHED; PG8_LDA(At, 0, 0); PG8_STAGE(PG8_SA(1, 1), a1, vA[1]);
            PG8_WAIT_V(8); PG8_WAIT_L(0); PG8_BAR; PG8_MMA(0, 0, At, B0); PG8_MMA(0, 1, At, B1); PG8_BAR; PG8_SCHED;
            PG8_LDA(At, 0, 1); PG8_STAGE(PG8_SB(0, 0), b2, voffB); PG8_STAGE(PG8_SB(0, 1), b2 + hstep, voffB); PG8_STAGE(PG8_SA(0, 0), a2, x0);
            PG8_WAIT_V(8); PG8_WAIT_L(0); PG8_BAR; PG8_MMA(1, 0, At, B0); PG8_MMA(1, 1, At, B1); PG8_BAR; PG8_SCHED;
            PG8_LDB(B0, 1, 0); PG8_LDB(B1, 1, 1); PG8_SCHED; PG8_LDA(At, 1, 0); PG8_STAGE(PG8_SA(0, 1), a2, x1);
            PG8_WAIT_V(8); PG8_WAIT_L(0); PG8_BAR; PG8_MMA(0, 0, At, B0); PG8_MMA(0, 1, At, B1); PG8_BAR; PG8_SCHED;
            PG8_LDA(At, 1, 1); PG8_STAGE(PG8_SB(1, 0), b3, voffB); PG8_STAGE(PG8_SB(1, 1), b3 + hstep, voffB); PG8_STAGE(PG8_SA(1, 0), a3, x0);
            PG8_WAIT_V(8); PG8_WAIT_L(0); PG8_BAR; PG8_MMA(1, 0, At, B0); PG8_MMA(1, 1, At, B1); PG8_BAR; PG8_SCHED;
        }
        if constexpr (ALIGN_EPI) { if (wr == 0) PG8_BAR; }
        if constexpr (FP8) asm volatile("s_nop 15\n\ts_nop 15" ::: "memory");
        E(acc, cur, wr, wc, fr, fq);
        if (!has_next) break;
        if constexpr (Epi::HAS_INIT) E.init(acc, nxt, wr, wc, fr, fq);
        else {
#pragma unroll
        for (int a = 0; a < 2; ++a)
#pragma unroll
            for (int b = 0; b < 2; ++b)
#pragma unroll
                for (int m = 0; m < 4; ++m)
#pragma unroll
                    for (int n = 0; n < 2; ++n) acc[a][b][m][n] = (f32x4){0.f, 0.f, 0.f, 0.f};
        }
        cur = nxt; cA = nA; cB = nB; ++ui;
        if constexpr (GATHER) { vA[0][0] = nvA[0][0]; vA[0][1] = nvA[0][1]; vA[1][0] = nvA[1][0]; vA[1][1] = nvA[1][1]; }
        if constexpr (ALIGN_EPI) { if (wr == 1) PG8_BAR; }
    }
    PG8_WAIT_V(0);
    if constexpr (!ALIGN_EPI) { if (wr == 0) PG8_BAR; }
    PG8_BAR;
#undef PG8_SA
#undef PG8_SB
#undef PG8_STAGE
#undef PG8_LDA
#undef PG8_LDB
#undef PG8_MMA
#undef PG8_WAIT_V
#undef PG8_WAIT_L
#undef PG8_BAR
#undef PG8_SCHED
}
}

#define EPI_ROWS(ai, m) (u.pm * 256 + (ai) * 128 + wr * 64 + (m) * 16 + fr)
__device__ __forceinline__ u32x4 pack8(const f32x4 a, const f32x4 b) { u32x4 w; w.x = cvt_pk_bf16(a[0], a[1]); w.y = cvt_pk_bf16(a[2], a[3]); w.z = cvt_pk_bf16(b[0], b[1]); w.w = cvt_pk_bf16(b[2], b[3]); return w; }
__device__ __forceinline__ void unpack8(const u32x4 w, f32x4& a, f32x4& b) { a = (f32x4){bf_lo(w.x), bf_hi(w.x), bf_lo(w.y), bf_hi(w.y)}; b = (f32x4){bf_lo(w.z), bf_hi(w.z), bf_lo(w.w), bf_hi(w.w)}; }

struct EpiWin {
    static constexpr bool PERM = true, HAS_INIT = false;
    const float* rstd; bf16_t* v; bf16_t* bg; bf16_t* ub; bf16_t* gates; const float* gate_bias;
    __device__ __forceinline__ void operator()(const f32x4 (&acc)[2][2][4][2], const pg8::Unit& u, int wr, int wc, int fr, int fq) const {
        if (u.pn < 8) {
#pragma unroll
            for (int ai = 0; ai < 2; ++ai)
#pragma unroll
                for (int m = 0; m < 4; ++m) { const int row = EPI_ROWS(ai, m); const float rs = rstd[row], rs2 = rs * rs;
                    const f32x4 a0 = acc[ai][0][m][0] * acc[ai][1][m][0] * rs2, a1 = acc[ai][0][m][1] * acc[ai][1][m][1] * rs2;
                    *(u32x4*)(v + (size_t)row * D + 128 * u.pn + 32 * wc + 8 * fq) = pack8(a0, a1); }
        } else if (u.pn < 14) {
            bf16_t* base; int ld, c0;
            if (u.pn < 12) { base = bg; ld = D; c0 = 256 * (u.pn - 8); } else { base = ub; ld = SW; c0 = 256 * (u.pn - 12); }
#pragma unroll
            for (int ai = 0; ai < 2; ++ai)
#pragma unroll
                for (int m = 0; m < 4; ++m) { const int row = EPI_ROWS(ai, m); const float rs = rstd[row];
#pragma unroll
                    for (int bj = 0; bj < 2; ++bj) *(u32x4*)(base + (size_t)row * ld + c0 + 128 * bj + 32 * wc + 8 * fq) = pack8(acc[ai][bj][m][0] * rs, acc[ai][bj][m][1] * rs); }
        } else {
            const int c0 = 256 * (u.pn - 14) + 32 * wc + 8 * fq;
            f32x4 bv[2][2];
#pragma unroll
            for (int bj = 0; bj < 2; ++bj)
#pragma unroll
                for (int n = 0; n < 2; ++n) bv[bj][n] = *(const f32x4*)(gate_bias + c0 + 128 * bj + 4 * n);
#pragma unroll
            for (int ai = 0; ai < 2; ++ai)
#pragma unroll
                for (int m = 0; m < 4; ++m) { const int row = EPI_ROWS(ai, m); const float rs = rstd[row];
#pragma unroll
                    for (int bj = 0; bj < 2; ++bj) { f32x4 g0 = acc[ai][bj][m][0] * rs + bv[bj][0], g1 = acc[ai][bj][m][1] * rs + bv[bj][1];
#pragma unroll
                        for (int j = 0; j < 4; ++j) { g0[j] = fsigmoid(g0[j]); g1[j] = fsigmoid(g1[j]); }
                        *(u32x4*)(gates + (size_t)row * 2048 + c0 + 128 * bj) = pack8(g0, g1); } }
        }
    }
};
struct EpiGlu {
    static constexpr bool PERM = true, HAS_INIT = false;
    const bf16_t* gates; bf16_t* mb;
    __device__ __forceinline__ void operator()(const f32x4 (&acc)[2][2][4][2], const pg8::Unit& u, int wr, int wc, int fr, int fq) const {
        const int col = 128 * u.pn + 32 * wc + 8 * fq;
#pragma unroll
        for (int ai = 0; ai < 2; ++ai)
#pragma unroll
            for (int m = 0; m < 4; ++m) { const int row = EPI_ROWS(ai, m);
                f32x4 g0, g1; unpack8(*(const u32x4*)(gates + (size_t)row * 2048 + 1024 + col), g0, g1);
                f32x4 y0 = acc[ai][0][m][0], y1 = acc[ai][0][m][1]; const f32x4 b0 = acc[ai][1][m][0], b1 = acc[ai][1][m][1];
#pragma unroll
                for (int j = 0; j < 4; ++j) { y0[j] = y0[j] * fsigmoid(b0[j]) * g0[j]; y1[j] = y1[j] * fsigmoid(b1[j]) * g1[j]; }
                *(u32x4*)(mb + (size_t)row * D + col) = pack8(y0, y1); }
    }
};
struct EpiMix {
    static constexpr bool PERM = true, HAS_INIT = false;
    const bf16_t* gates; const bf16_t* mb; bf16_t* mixed;
    __device__ __forceinline__ void operator()(const f32x4 (&acc)[2][2][4][2], const pg8::Unit& u, int wr, int wc, int fr, int fq) const {
#pragma unroll
        for (int ai = 0; ai < 2; ++ai)
#pragma unroll
            for (int m = 0; m < 4; ++m) { const int row = EPI_ROWS(ai, m);
#pragma unroll
                for (int bj = 0; bj < 2; ++bj) { const int col = 256 * u.pn + 128 * bj + 32 * wc + 8 * fq;
                    f32x4 g0, g1, m0, m1; unpack8(*(const u32x4*)(gates + (size_t)row * 2048 + col), g0, g1); unpack8(*(const u32x4*)(mb + (size_t)row * D + col), m0, m1);
                    *(u32x4*)(mixed + (size_t)row * D + col) = pack8(g0 * acc[ai][bj][m][0] + m0, g1 * acc[ai][bj][m][1] + m1); } }
    }
};
struct EpiX1 {
    static constexpr bool PERM = true, HAS_INIT = true;
    const float* __restrict__ x; float* __restrict__ x1; bf16_t* __restrict__ x1b; unsigned char* __restrict__ x1q;
    __device__ __forceinline__ void init(f32x4 (&acc)[2][2][4][2], const pg8::Unit& u, int wr, int wc, int fr, int fq) const {
#pragma unroll
        for (int ai = 0; ai < 2; ++ai)
#pragma unroll
            for (int m = 0; m < 4; ++m)
#pragma unroll
                for (int bj = 0; bj < 2; ++bj)
#pragma unroll
                    for (int n = 0; n < 2; ++n) acc[ai][bj][m][n] = *(const f32x4*)(x + (size_t)EPI_ROWS(ai, m) * D + 256 * u.pn + 128 * bj + 32 * wc + 8 * fq + 4 * n);
    }
    __device__ __forceinline__ void operator()(const f32x4 (&acc)[2][2][4][2], const pg8::Unit& u, int wr, int wc, int fr, int fq) const {
#pragma unroll
        for (int ai = 0; ai < 2; ++ai)
#pragma unroll
            for (int m = 0; m < 4; ++m) { const int row = EPI_ROWS(ai, m);
#pragma unroll
                for (int bj = 0; bj < 2; ++bj) { const size_t o = (size_t)row * D + 256 * u.pn + 128 * bj + 32 * wc + 8 * fq;
                    const f32x4 r0 = acc[ai][bj][m][0], r1 = acc[ai][bj][m][1];
                    *(f32x4*)(x1 + o) = r0; *(f32x4*)(x1 + o + 4) = r1; *(u32x4*)(x1b + o) = pack8(r0, r1);
                    u32x2 q8; q8.x = cvt4_fp8(r0[0], r0[1], r0[2], r0[3]); q8.y = cvt4_fp8(r1[0], r1[1], r1[2], r1[3]); *(u32x2*)(x1q + o) = q8; }
                asm volatile("s_waitcnt vmcnt(24)" ::: "memory"); }
    }
};
struct EpiUp {
    static constexpr bool PERM = true, HAS_INIT = false;
    const int* list; const float* rstd2; unsigned char* hmid;
    __device__ __forceinline__ void operator()(const f32x4 (&acc)[2][2][4][2], const pg8::Unit& u, int wr, int wc, int fr, int fq) const {
        const int col = 128 * u.pn + 32 * wc + 8 * fq;
#pragma unroll
        for (int ai = 0; ai < 2; ++ai)
#pragma unroll
            for (int m = 0; m < 4; ++m) { const int r = ai * 128 + wr * 64 + m * 16 + fr; const bool ok = r < u.nrow;
                const int tok = ok ? list[u.e * T + 256 * u.pm + r] : 0; const float rs = ok ? rstd2[tok] * (1.f / 32.f) : 0.f;
                f32x4 g0 = acc[ai][0][m][0] * rs, g1 = acc[ai][0][m][1] * rs; const f32x4 u0 = acc[ai][1][m][0] * rs, u1 = acc[ai][1][m][1] * rs;
#pragma unroll
                for (int j = 0; j < 4; ++j) { g0[j] = fsilu(g0[j]) * u0[j]; g1[j] = fsilu(g1[j]) * u1[j]; }
                u32x2 q8; q8.x = cvt4_fp8(g0[0], g0[1], g0[2], g0[3]); q8.y = cvt4_fp8(g1[0], g1[1], g1[2], g1[3]); *(u32x2*)(hmid + (size_t)(u.srow + r) * EFF + col) = q8; }
    }
};
struct EpiDown {
    static constexpr bool PERM = true, HAS_INIT = false;
    bf16_t* Y;
    __device__ __forceinline__ void operator()(const f32x4 (&acc)[2][2][4][2], const pg8::Unit& u, int wr, int wc, int fr, int fq) const {
#pragma unroll
        for (int ai = 0; ai < 2; ++ai)
#pragma unroll
            for (int m = 0; m < 4; ++m) { const int r = ai * 128 + wr * 64 + m * 16 + fr;
#pragma unroll
                for (int bj = 0; bj < 2; ++bj) *(u32x4*)(Y + (size_t)(u.srow + r) * D + 256 * u.pn + 128 * bj + 32 * wc + 8 * fq) = pack8(acc[ai][bj][m][0] * (1.f / 16.f), acc[ai][bj][m][1] * (1.f / 16.f)); }
    }
};

constexpr size_t MiB = 1u << 20;
constexpr size_t WS_CTL = 0, CTL_BYTES = 64 * 1024;
constexpr size_t WS_WIN = 1 * MiB, WS_WC = 12 * MiB, WS_WGLU = 14 * MiB, WS_WO = 16 * MiB;
constexpr size_t WS_RSTD1 = 18 * MiB, WS_RSTD2 = WS_RSTD1 + 64 * 1024, WS_TABA = WS_RSTD2 + 64 * 1024, WS_TABA256 = WS_TABA + 32 * 1024, WS_BBT = WS_TABA256 + 32 * 1024,
                 WS_CT = WS_BBT + 128 * 1024, WS_WRT = WS_CT + 128 * 1024, WS_E = 19 * MiB;
constexpr size_t WS_XB = 20 * MiB, WS_Z = 20 * MiB;
constexpr size_t WS_V = 52 * MiB, WS_MB = 52 * MiB, WS_X1B = 52 * MiB;
constexpr size_t WS_BG = 84 * MiB, WS_MIXED = 84 * MiB, WS_HMID = 84 * MiB;
constexpr size_t WS_UB = 116 * MiB, WS_YS = 116 * MiB;
constexpr size_t WS_GATES = 132 * MiB;
constexpr size_t WS_Y = 124 * MiB;
constexpr size_t WS_WGU = 196 * MiB, WS_X1Q = 228 * MiB;
constexpr size_t WS_WD = 260 * MiB, WS_WD2 = 2 * MiB;
constexpr int WD_SPLIT = 64;
#ifndef CV_EARLY_ITEMS
#define CV_EARLY_ITEMS 5120
#endif
constexpr int CV_EARLY = CV_EARLY_ITEMS;
constexpr size_t WS_TOK = 4 * MiB, WS_LIST = 6 * MiB, WS_END = 290 * MiB;
constexpr int CW_CNT = 64;
constexpr int CW_BAR = 4096;
constexpr int RING_BYTES = 131072, MISC_OFF = RING_BYTES, LDS_BYTES = 147456;

#define XB_TMO      128
#define XB_XCNT(j)  (256  + 64 * (j))
#define XB_XSUB(j)  (1280 + 64 * (j))
#define XB_XGEN(j)  (2304 + 64 * (j))
#define XB_TOP      3328
#define XB_TOPGEN   3392
#define XCD_BAR_WORDS 3456
#define XB_SPIN_CAP (1u << 18)
__device__ __forceinline__ unsigned xb_ld(unsigned* p)              { return __hip_atomic_load(p, __ATOMIC_RELAXED, __HIP_MEMORY_SCOPE_AGENT); }
__device__ __forceinline__ unsigned xb_add(unsigned* p, unsigned v) { return __hip_atomic_fetch_add(p, v, __ATOMIC_RELAXED, __HIP_MEMORY_SCOPE_AGENT); }
__device__ __forceinline__ unsigned xb_xcc_id() { return (unsigned)__builtin_amdgcn_s_getreg((3 << 11) | 20) & 0xFu; }
#define XB_SPIN(cond, bar) do { unsigned _sp = 0; while (cond) { __builtin_amdgcn_s_sleep(1); \
    if ((++_sp & 255u) == 0u) { if (xb_ld(&(bar)[XB_TMO])) break; if (_sp > XB_SPIN_CAP) { atomicAdd(&(bar)[XB_TMO], 1u); break; } } } } while (0)
struct XcdBarrier { unsigned* bar; unsigned x; volatile LAS unsigned* st; };
__device__ __forceinline__ XcdBarrier xcd_barrier_post(unsigned* bar, volatile LAS unsigned* st) {
    XcdBarrier b; b.bar = bar; b.x = xb_xcc_id(); b.st = st;
    if (threadIdx.x == 0) (void)xb_add(&bar[XB_XCNT(b.x)], 1u);
    return b;
}
__device__ __forceinline__ void xcd_barrier_complete(unsigned* bar, unsigned x, unsigned& nloc, unsigned& nx) {
    const unsigned G = gridDim.x * gridDim.y * gridDim.z;
    unsigned sum, cnt, mine, sp = 0u;
    for (;;) {
        sum = 0u; cnt = 0u; mine = 0u;
#pragma unroll
        for (unsigned j = 0; j < 16; ++j) { const unsigned c = xb_ld(&bar[XB_XCNT(j)]); sum += c; cnt += (c > 0u) ? 1u : 0u; mine = (j == x) ? c : mine; }
        if (sum == G) break;
        __builtin_amdgcn_s_sleep(1);
        if ((++sp & 255u) == 0u) { if (xb_ld(&bar[XB_TMO])) break; if (sp > XB_SPIN_CAP) { atomicAdd(&bar[XB_TMO], 1u); break; } }
    }
    nloc = mine > 0u ? mine : 1u; nx = cnt > 0u ? cnt : 1u;
}
__device__ __forceinline__ void xcd_barrier(const XcdBarrier& b) {
    asm volatile("s_waitcnt vmcnt(0)" ::: "memory");
    __syncthreads();
    if (threadIdx.x == 0) {
        unsigned* bar = b.bar;
        __builtin_amdgcn_s_waitcnt(0);
        unsigned nloc = b.st[0], nx = b.st[1];
        if (nloc == 0u) { xcd_barrier_complete(bar, b.x, nloc, nx); b.st[0] = nloc; b.st[1] = nx; }
        const unsigned old = xb_add(&bar[XB_XSUB(b.x)], 1u);
        const unsigned gen = old / nloc;
        if (old + 1u == (gen + 1u) * nloc) {
            __builtin_amdgcn_fence(__ATOMIC_RELEASE, "agent");
            asm volatile("s_waitcnt vmcnt(0)" ::: "memory");
            const unsigned og = xb_add(&bar[XB_TOP], 1u);
            const unsigned tg = og / nx;
            if (og + 1u == (tg + 1u) * nx) xb_add(&bar[XB_TOPGEN], 1u);
            else XB_SPIN(xb_ld(&bar[XB_TOPGEN]) == tg, bar);
            __builtin_amdgcn_fence(__ATOMIC_ACQUIRE, "agent");
            xb_add(&bar[XB_XGEN(b.x)], 1u);
            asm volatile("s_waitcnt vmcnt(0)" ::: "memory");
        } else {
            XB_SPIN(xb_ld(&bar[XB_XGEN(b.x)]) == gen, bar);
            __builtin_amdgcn_fence(__ATOMIC_ACQUIRE, "agent");
            asm volatile("s_waitcnt vmcnt(0)" ::: "memory");
        }
    }
    __syncthreads();
}

struct Args { const float* in[27]; float* out; unsigned char* ws; int ph_lo, ph_hi, use_bar, pad; };
struct Frame {
    LAS unsigned char* lds; volatile LAS unsigned* MISC; unsigned* ctl; unsigned char* ws;
    int tid, lane, wave, G;
};

__device__ __forceinline__ void tr64(const float* __restrict__ src, int ld, int col0, int k0, const float* __restrict__ scale, bf16_t* __restrict__ dst, size_t drow0, int Kdst, LAS unsigned char* scr, int lane) {
    const float* s = src + (size_t)k0 * ld + col0 + lane;
#pragma unroll
    for (int hh = 0; hh < 2; ++hh) {
        float v[32];
#pragma unroll
        for (int kk = 0; kk < 32; ++kk) v[kk] = s[(size_t)(32 * hh + kk) * ld];
        if (scale) {
#pragma unroll
            for (int kk = 0; kk < 32; ++kk) v[kk] *= scale[k0 + 32 * hh + kk];
        }
#pragma unroll
        for (int c = 0; c < 4; ++c) { u32x4 o; o.x = cvt_pk_bf16(v[8 * c + 0], v[8 * c + 1]); o.y = cvt_pk_bf16(v[8 * c + 2], v[8 * c + 3]); o.z = cvt_pk_bf16(v[8 * c + 4], v[8 * c + 5]); o.w = cvt_pk_bf16(v[8 * c + 6], v[8 * c + 7]);
            *(LAS u32x4*)(scr + lane * 144 + 16 * (4 * hh + c)) = o; }
        asm volatile("s_waitcnt vmcnt(0)" ::: "memory");
    }
    asm volatile("s_waitcnt lgkmcnt(0)" ::: "memory");
#pragma unroll
    for (int j = 0; j < 8; ++j) { const int row = 8 * j + (lane >> 3); const u32x4 o = *(const LAS u32x4*)(scr + row * 144 + 16 * (lane & 7));
        *(u32x4*)(dst + (drow0 + row) * (size_t)Kdst + k0 + 8 * (lane & 7)) = o; }
    asm volatile("s_waitcnt lgkmcnt(0)" ::: "memory");
}

__device__ __forceinline__ void p0_prologue(const Frame& F, const Args& a) {
    LAS unsigned char* scr = F.lds + F.wave * 16384;
    const int gw = blockIdx.x * 8 + F.wave, NGW = F.G * 8;
    bf16_t* Win_t = (bf16_t*)(F.ws + WS_WIN); bf16_t* Wc_t = (bf16_t*)(F.ws + WS_WC); bf16_t* Wglu_t = (bf16_t*)(F.ws + WS_WGLU); bf16_t* Wo_t = (bf16_t*)(F.ws + WS_WO);
    constexpr int I_WIN = 16 * 88, I_WC = 16 * 16, I_WO = 16 * 16, I_GLU = 8 * 32;
    for (int it = gw; it < I_WIN + I_WC + I_WO + I_GLU; it += NGW) {
        int r = it;
        if (r < I_WIN) { const int kb = r / 88, nb = r % 88, j0 = 64 * nb; int col0;
            if (j0 < 2048) { const int pn = j0 >> 8, i = j0 & 255; col0 = (i < 128) ? (128 * pn + i) : (2048 + 128 * pn + (i - 128)); } else if (j0 < 3072) col0 = j0 - 1024; else col0 = j0;
            tr64(a.in[2], INC, col0, 64 * kb, a.in[1], Win_t, (size_t)j0, D, scr, F.lane); continue; }
        r -= I_WIN;
        if (r < I_WC) { tr64(a.in[5], D, 64 * (r % 16), 64 * (r / 16), nullptr, Wc_t, (size_t)(64 * (r % 16)), D, scr, F.lane); continue; }
        r -= I_WC;
        if (r < I_WO) { tr64(a.in[17], D, 64 * (r % 16), 64 * (r / 16), nullptr, Wo_t, (size_t)(64 * (r % 16)), D, scr, F.lane); continue; }
        r -= I_WO;
        { const int kb = r / 32, nb = r % 32, j0 = 64 * nb, pn = j0 >> 8, i = j0 & 255;
          tr64(i < 128 ? a.in[14] : a.in[15], D, 128 * pn + (i & 127), 64 * kb, nullptr, Wglu_t, (size_t)j0, SW, scr, F.lane); }
    }
    { const float* x = a.in[0]; bf16_t* xb = (bf16_t*)(F.ws + WS_XB); float* rstd1 = (float*)(F.ws + WS_RSTD1);
      for (int m = gw; m < T; m += NGW) {
          const f32x4* xr = (const f32x4*)(x + (size_t)m * D) + F.lane; f32x4 v[4]; float s = 0.f;
#pragma unroll
          for (int j = 0; j < 4; ++j) { v[j] = xr[64 * j]; s += (v[j][0] * v[j][0] + v[j][1] * v[j][1]) + (v[j][2] * v[j][2] + v[j][3] * v[j][3]); }
          const float rs = rsqrtf(wave_sum64(s) * (1.f / D) + EPS);
          u32x2* o = (u32x2*)(xb + (size_t)m * D) + F.lane;
#pragma unroll
          for (int j = 0; j < 4; ++j) { u32x2 w; w.x = cvt_pk_bf16(v[j][0], v[j][1]); w.y = cvt_pk_bf16(v[j][2], v[j][3]); o[64 * j] = w; }
          if (F.lane == 0) rstd1[m] = rs; } }
    { bf16_t* wrt = (bf16_t*)(F.ws + WS_WRT); const float* g2 = a.in[18];
      for (int i = blockIdx.x * 512 + F.tid; i < 48 * D; i += F.G * 512) { const int j = i / D, k = i % D; float w = 0.f;
          if (j < 4) w = a.in[19][k * 4 + j]; else if (j < 36) w = a.in[21][k * 32 + (j - 4)];
          wrt[i] = (bf16_t)(cvt_pk_bf16(w * g2[k], 0.f) & 0xffffu); } }
    { float* tab_a = (float*)(F.ws + WS_TABA); float* tab_a256 = (float*)(F.ws + WS_TABA256); bf16_t* BbT = (bf16_t*)(F.ws + WS_BBT); bf16_t* Ct = (bf16_t*)(F.ws + WS_CT);
      for (int i = blockIdx.x * 512 + F.tid; i < NG * NS; i += F.G * 512) { const int g = i / NS, n = i % NS;
          f32x4 br[4], bi[4]; float cre[16], cim[16];
#pragma unroll
          for (int q = 0; q < 4; ++q) { br[q] = *(const f32x4*)(a.in[9] + (size_t)i * NH + 4 * q); bi[q] = *(const f32x4*)(a.in[10] + (size_t)i * NH + 4 * q); }
#pragma unroll
          for (int h = 0; h < NH; ++h) { cre[h] = a.in[11][(g * NH + h) * NS + n]; cim[h] = a.in[12][(g * NH + h) * NS + n]; }
          const float lr = a.in[6][i], li = a.in[7][i], dt = expf(a.in[8][g]);
          float sn, cs; sincosf(li * dt, &sn, &cs); const float er = expf(lr * dt); const float cr = er * cs, ci = er * sn;
          float pr = cr, pi = ci;
#pragma unroll
          for (int q = 0; q < 4; ++q) { const float tr_ = pr * pr - pi * pi, ti_ = 2.f * pr * pi; pr = tr_; pi = ti_; }
          *(f32x4*)(tab_a + (size_t)i * 4) = (f32x4){cr, ci, pr, pi};
#pragma unroll
          for (int q = 0; q < 4; ++q) { const float tr_ = pr * pr - pi * pi, ti_ = 2.f * pr * pi; pr = tr_; pi = ti_; }
          *(float2*)(tab_a256 + (size_t)i * 2) = make_float2(pr, pi);
          const float nr = cr - 1.f, ni = ci, den = lr * lr + li * li; const float kr = (nr * lr + ni * li) / den, ki = (ni * lr - nr * li) / den;
          unsigned wre[8], wim[8];
#pragma unroll
          for (int q = 0; q < 4; ++q) {
              wre[2 * q]     = cvt_pk_bf16(kr * br[q][0] - ki * bi[q][0], kr * br[q][1] - ki * bi[q][1]);
              wre[2 * q + 1] = cvt_pk_bf16(kr * br[q][2] - ki * bi[q][2], kr * br[q][3] - ki * bi[q][3]);
              wim[2 * q]     = cvt_pk_bf16(kr * bi[q][0] + ki * br[q][0], kr * bi[q][1] + ki * br[q][1]);
              wim[2 * q + 1] = cvt_pk_bf16(kr * bi[q][2] + ki * br[q][2], kr * bi[q][3] + ki * br[q][3]); }
          u32x4* dre = (u32x4*)(BbT + ((size_t)(g * 4 + 0 + (n >> 5)) * 32 + (n & 31)) * 16); u32x4* dim_ = (u32x4*)(BbT + ((size_t)(g * 4 + 2 + (n >> 5)) * 32 + (n & 31)) * 16);
          dre[0] = (u32x4){wre[0], wre[1], wre[2], wre[3]}; dre[1] = (u32x4){wre[4], wre[5], wre[6], wre[7]};
          dim_[0] = (u32x4){wim[0], wim[1], wim[2], wim[3]}; dim_[1] = (u32x4){wim[4], wim[5], wim[6], wim[7]};
#pragma unroll
          for (int h = 0; h < NH; ++h) *(unsigned*)(Ct + (size_t)(g * NH + h) * 128 + 2 * n) = cvt_pk_bf16(cre[h], -cim[h]); } }
}

__device__ __forceinline__ void p2_conv(const Frame& F, const Args& a) {
    const bf16_t* v = (const bf16_t*)(F.ws + WS_V); const bf16_t* bg = (const bf16_t*)(F.ws + WS_BG); bf16_t* z = (bf16_t*)(F.ws + WS_Z);
    const float* cw = a.in[3]; const float* cb = a.in[4];
    const int gw = blockIdx.x * 8 + F.wave, NGW = F.G * 8;
    for (int it = gw; it < (T / 8) * 2; it += NGW) {
        const int t0 = (it >> 1) * 8, ch = (it & 1) * 512 + F.lane * 8;
        f32x4 w0a = *(const f32x4*)(cw + ch), w0b = *(const f32x4*)(cw + ch + 4), w1a = *(const f32x4*)(cw + D + ch), w1b = *(const f32x4*)(cw + D + ch + 4);
        f32x4 w2a = *(const f32x4*)(cw + 2 * D + ch), w2b = *(const f32x4*)(cw + 2 * D + ch + 4), ba = *(const f32x4*)(cb + ch), bb = *(const f32x4*)(cb + ch + 4);
        f32x4 p2a = {0.f, 0.f, 0.f, 0.f}, p2b = p2a, p1a = p2a, p1b = p2a;
        if (t0 >= 2) { unpack8(*(const u32x4*)(v + (size_t)(t0 - 2) * D + ch), p2a, p2b); unpack8(*(const u32x4*)(v + (size_t)(t0 - 1) * D + ch), p1a, p1b); }
#pragma unroll
        for (int i = 0; i < 8; ++i) { f32x4 ca, cbv, ga, gb; unpack8(*(const u32x4*)(v + (size_t)(t0 + i) * D + ch), ca, cbv); unpack8(*(const u32x4*)(bg + (size_t)(t0 + i) * D + ch), ga, gb);
            const f32x4 ya = ga * (w0a * p2a + w1a * p1a + w2a * ca + ba), yb = gb * (w0b * p2b + w1b * p1b + w2b * cbv + bb);
            *(u32x4*)(z + (size_t)(t0 + i) * D + ch) = pack8(ya, yb);
            p2a = p1a; p2b = p1b; p1a = ca; p1b = cbv; }
    }
}

struct ConvD { const float* src; const float* scale; bf16_t* dst; int ld, Kdst; };
__device__ __forceinline__ ConvD conv_desc(int H, const Args& a, unsigned char* ws) {
    ConvD d; const int it = H >> 1, hh = H & 1;
    if (it < NE * 256) { const int e = it >> 8, r = it & 255, kb = r >> 4, nb = r & 15, j0 = 64 * nb, pn = j0 >> 8, i = j0 & 255, k0 = 64 * kb + 32 * hh;
        d.src = (i < 128 ? a.in[23] : a.in[24]) + (size_t)e * D * EFF + (size_t)k0 * EFF + 128 * pn + (i & 127); d.ld = EFF; d.scale = a.in[18] + k0;
        d.dst = (bf16_t*)(ws + WS_WGU) + ((size_t)e * 1024 + j0) * D + k0; d.Kdst = D; }
    else { const int q = it - NE * 256, e = q >> 7, r = q & 127, kb = r >> 4, nb = r & 15, k0 = 64 * kb + 32 * hh;
        d.src = a.in[25] + (size_t)e * EFF * D + (size_t)k0 * D + 64 * nb; d.ld = D; d.scale = nullptr;
        d.dst = (bf16_t*)(e < WD_SPLIT ? ws + WS_WD + (size_t)e * MiB : ws + WS_WD2 + (size_t)(e - WD_SPLIT) * MiB) + (size_t)(64 * nb) * EFF + k0; d.Kdst = EFF; }
    return d;
}
__device__ __forceinline__ void conv_finish(float (&cv)[32], const ConvD& d, const float sc, LAS unsigned char* scr, int lane) {
    if (d.scale) {
#pragma unroll
        for (int kk = 0; kk < 32; ++kk) cv[kk] *= __uint_as_float((unsigned)__builtin_amdgcn_readlane((int)__float_as_uint(sc), kk));
    }
#pragma unroll
    for (int c = 0; c < 4; ++c) { u32x4 o; o.x = cvt_pk_bf16(cv[8 * c + 0], cv[8 * c + 1]); o.y = cvt_pk_bf16(cv[8 * c + 2], cv[8 * c + 3]); o.z = cvt_pk_bf16(cv[8 * c + 4], cv[8 * c + 5]); o.w = cvt_pk_bf16(cv[8 * c + 6], cv[8 * c + 7]);
        *(LAS u32x4*)(scr + lane * 80 + 16 * c) = o; }
    asm volatile("s_waitcnt lgkmcnt(0)" ::: "memory");
#pragma unroll
    for (int j = 0; j < 4; ++j) { const int row = 16 * j + (lane >> 2); const u32x4 o = *(const LAS u32x4*)(scr + row * 80 + 16 * (lane & 3));
        *(u32x4*)(d.dst + (size_t)row * d.Kdst + 8 * (lane & 3)) = o; }
    asm volatile("s_waitcnt lgkmcnt(0)" ::: "memory");
}

__device__ __forceinline__ int tokmap(int r) { return 16 * ((r >> 2) & 1) + 4 * (r >> 3) + (r & 3); }
template <int PASS>
__device__ __forceinline__ void scan_tile(f32x16& re, f32x16& im, const f32x4 c, float& Rr, float& Ri, int hf) {
    const float ar = c[0], ai = c[1];
    float sr = hf ? 0.f : Rr, si = hf ? 0.f : Ri;
#pragma unroll
    for (int q = 0; q < 16; ++q) { const float nr = ar * sr - ai * si + re[q], ni = ar * si + ai * sr + im[q]; sr = nr; si = ni; re[q] = sr; im[q] = si; }
    const float orr = __shfl_xor(sr, 32), oii = __shfl_xor(si, 32);
    Rr = c[2] * sr - c[3] * si + orr; Ri = c[2] * si + c[3] * sr + oii;
    if (PASS == 2) {
        float cr = hf ? orr : 0.f, ci = hf ? oii : 0.f;
#pragma unroll
        for (int q = 0; q < 16; ++q) { const float nr = ar * cr - ai * ci, ni = ar * ci + ai * cr; cr = nr; ci = ni; re[q] += cr; im[q] += ci; }
    }
}
template <int PASS>
__device__ __forceinline__ void ssm_pass(const Frame& F, const Args& a) {
    const int lane = F.lane, hf = lane >> 5, col = lane & 31;
    const f32x4* tab_a = (const f32x4*)(F.ws + WS_TABA); const float2* tab_a256 = (const float2*)(F.ws + WS_TABA256);
    const bf16_t* BbT = (const bf16_t*)(F.ws + WS_BBT); const bf16_t* Ct = (const bf16_t*)(F.ws + WS_CT);
    const bf16_t* ub = (const bf16_t*)(F.ws + WS_UB); bf16_t* ys = (bf16_t*)(F.ws + WS_YS); float* E = (float*)(F.ws + WS_E);
    LAS unsigned char* sl = F.lds + F.wave * 16384; LAS unsigned char* cscr = sl + 8704;
    for (int id = blockIdx.x * 8 + F.wave; id < NG * (T / 256); id += F.G * 8) {
        const int g = id & 31, r = id >> 5;
        const f32x4 c0 = tab_a[g * NS + col], c1 = tab_a[g * NS + 32 + col];
        bf16x8 Bf[4];
#pragma unroll
        for (int q = 0; q < 4; ++q) Bf[q] = *(const bf16x8*)(BbT + ((size_t)(g * 4 + q) * 32 + col) * 16 + 8 * hf);
        float R0r = 0.f, R0i = 0.f, R1r = 0.f, R1i = 0.f;
        bf16x8 Cf[4], Df;
        if (PASS == 2) {
            const float2 p0 = tab_a256[g * NS + col], p1 = tab_a256[g * NS + 32 + col];
            for (int j0 = 0; j0 < r; j0 += 8) {
                float2 e0[8], e1[8];
#pragma unroll
                for (int q = 0; q < 8; ++q) { const int j = (j0 + q < r) ? j0 + q : r - 1;
                    e0[q] = *(const float2*)(E + ((size_t)(j * NG + g) * NS + col) * 2); e1[q] = *(const float2*)(E + ((size_t)(j * NG + g) * NS + 32 + col) * 2); }
#pragma unroll
                for (int q = 0; q < 8; ++q) if (j0 + q < r) {
                    const float t0r = p0.x * R0r - p0.y * R0i + e0[q].x, t0i = p0.x * R0i + p0.y * R0r + e0[q].y; R0r = t0r; R0i = t0i;
                    const float t1r = p1.x * R1r - p1.y * R1i + e1[q].x, t1i = p1.x * R1i + p1.y * R1r + e1[q].y; R1r = t1r; R1i = t1i; } }
#pragma unroll
            for (int kb = 0; kb < 4; ++kb) Cf[kb] = *(const bf16x8*)(Ct + (size_t)(g * NH + (lane & 15)) * 128 + kb * 32 + 8 * (lane >> 4));
            const unsigned dbits = cvt_pk_bf16(a.in[13][g * NH + (lane & 15)], 0.f) & 0xffffu;
#pragma unroll
            for (int jj = 0; jj < 8; ++jj) Df[jj] = (short)((lane < 32 && (8 * (lane >> 4) + jj) == (lane & 15)) ? dbits : 0u);
        }
        bf16x8 Un = *(const bf16x8*)(ub + (size_t)(r * 256 + tokmap(col)) * SW + g * NH + 8 * hf);
        bf16x8 A2n[2] = {{0, 0, 0, 0, 0, 0, 0, 0}, {0, 0, 0, 0, 0, 0, 0, 0}};
        if (PASS == 2) {
#pragma unroll
            for (int mt = 0; mt < 2; ++mt) A2n[mt] = *(const bf16x8*)(ub + (size_t)(r * 256 + 16 * mt + (lane & 15)) * SW + g * NH + 8 * ((lane >> 4) & 1)); }
        for (int c = 0; c < 8; ++c) {
            const int t0 = r * 256 + c * 32;
            const bf16x8 Ua = Un; bf16x8 A2[2] = {A2n[0], A2n[1]};
            if (lane >= 32) { A2[0] = (bf16x8){0, 0, 0, 0, 0, 0, 0, 0}; A2[1] = (bf16x8){0, 0, 0, 0, 0, 0, 0, 0}; }
            { const int tn = t0 + (c < 7 ? 32 : 0);
                Un = *(const bf16x8*)(ub + (size_t)(tn + tokmap(col)) * SW + g * NH + 8 * hf);
                if (PASS == 2) {
#pragma unroll
                    for (int mt = 0; mt < 2; ++mt) A2n[mt] = *(const bf16x8*)(ub + (size_t)(tn + 16 * mt + (lane & 15)) * SW + g * NH + 8 * ((lane >> 4) & 1)); } }
            constexpr bool has_cv = false; ConvD cd; float cv[32]; float csc = 1.f;
            if (has_cv) { const int jstep = (PASS == 2 ? 4 + c : c); cd = conv_desc(2 * ((jstep >> 1) * 2048 + id) + (jstep & 1), a, F.ws);
#pragma unroll
                for (int kk = 0; kk < 32; ++kk) cv[kk] = cd.src[(size_t)kk * cd.ld + lane];
                if (cd.scale) csc = cd.scale[lane & 31]; }
            const f32x16 zz = {0.f, 0.f, 0.f, 0.f, 0.f, 0.f, 0.f, 0.f, 0.f, 0.f, 0.f, 0.f, 0.f, 0.f, 0.f, 0.f};
            f32x16 bu0 = __builtin_amdgcn_mfma_f32_32x32x16_bf16(Ua, Bf[0], zz, 0, 0, 0);
            f32x16 bu1 = __builtin_amdgcn_mfma_f32_32x32x16_bf16(Ua, Bf[1], zz, 0, 0, 0);
            f32x16 bu2 = __builtin_amdgcn_mfma_f32_32x32x16_bf16(Ua, Bf[2], zz, 0, 0, 0);
            f32x16 bu3 = __builtin_amdgcn_mfma_f32_32x32x16_bf16(Ua, Bf[3], zz, 0, 0, 0);
            scan_tile<PASS>(bu0, bu2, c0, R0r, R0i, hf);
            scan_tile<PASS>(bu1, bu3, c1, R1r, R1i, hf);
            if (PASS == 2) {
                LAS unsigned* sw = (LAS unsigned*)sl;
#pragma unroll
                for (int q = 0; q < 16; ++q) { sw[(16 * hf + q) * 68 + col] = cvt_pk_bf16(bu0[q], bu2[q]); sw[(16 * hf + q) * 68 + 32 + col] = cvt_pk_bf16(bu1[q], bu3[q]); }
                asm volatile("s_waitcnt lgkmcnt(0)" ::: "memory");
#pragma unroll
                for (int mt = 0; mt < 2; ++mt) {
                    f32x4 y = {0.f, 0.f, 0.f, 0.f};
#pragma unroll
                    for (int kb = 0; kb < 4; ++kb) { const bf16x8 Af = *(const LAS bf16x8*)(sl + ((16 * mt + (lane & 15)) * 68 + kb * 16 + 4 * (lane >> 4)) * 4);
                        y = __builtin_amdgcn_mfma_f32_16x16x32_bf16(Af, Cf[kb], y, 0, 0, 0); }
                    y = __builtin_amdgcn_mfma_f32_16x16x32_bf16(A2[mt], Df, y, 0, 0, 0);
#pragma unroll
                    for (int j = 0; j < 4; ++j) ys[(size_t)(t0 + 16 * mt + 4 * (lane >> 4) + j) * SW + g * NH + (lane & 15)] = (bf16_t)(cvt_pk_bf16(fgelu_tanh(y[j]), 0.f) & 0xffffu);
                }
                asm volatile("s_waitcnt lgkmcnt(0)" ::: "memory");
            }
            if (has_cv) conv_finish(cv, cd, csc, cscr, lane);
        }
        if (PASS == 1 && hf == 0) {
            *(float2*)(E + ((size_t)(r * NG + g) * NS + col) * 2) = make_float2(R0r, R0i);
            *(float2*)(E + ((size_t)(r * NG + g) * NS + 32 + col) * 2) = make_float2(R1r, R1i);
        }
    }
}

__device__ __forceinline__ void p6_route(const Frame& F, const Args& a) {
    const bf16_t* x1b = (const bf16_t*)(F.ws + WS_X1B); const bf16_t* wrt = (const bf16_t*)(F.ws + WS_WRT); float* rstd2 = (float*)(F.ws + WS_RSTD2);
    int* cnt = (int*)(F.ctl + CW_CNT); int* list = (int*)(F.ws + WS_LIST);
    int* tok_e = (int*)(F.ws + WS_TOK); int* tok_pos = tok_e + 2 * T; float* tok_w = (float*)(tok_pos + 2 * T);
    volatile LAS int* lcnt = (volatile LAS int*)(F.MISC + 96); volatile LAS int* lbase = (volatile LAS int*)(F.MISC + 128);
    constexpr int WP = 2064;
    LAS unsigned char* wl = F.lds;
    LAS float* lg = (LAS float*)(F.lds + 102400 + (F.wave & 3) * 4096);
    const int lane = F.lane; const bool active = F.wave < 4;
    { u32x4 t[12];
#pragma unroll
      for (int q = 0; q < 12; ++q) { const int p = F.tid + 512 * q; t[q] = *(const u32x4*)(wrt + (size_t)(p >> 7) * D + (p & 127) * 8); }
#pragma unroll
      for (int q = 0; q < 12; ++q) { const int p = F.tid + 512 * q; *(LAS u32x4*)(wl + (p >> 7) * WP + (p & 127) * 16) = t[q]; } }
    for (int blk = blockIdx.x; blk < T / 64; blk += F.G) {
        if (F.tid < 32) lcnt[F.tid] = 0;
        __syncthreads();
        const int tok0 = blk * 64 + (F.wave & 3) * 16;
        int e1 = 0, e2 = 0, rk1 = 0, rk2 = 0; float wt1 = 0.f, wt2 = 0.f;
        if (active) {
            f32x4 acc[3]; float ssq = 0.f;
#pragma unroll
            for (int n = 0; n < 3; ++n) acc[n] = (f32x4){0.f, 0.f, 0.f, 0.f};
            const bf16_t* arow = x1b + (size_t)(tok0 + (lane & 15)) * D + 8 * (lane >> 4);
            const LAS unsigned char* brow = wl + (lane & 15) * WP + 16 * (lane >> 4);
#pragma unroll 8
            for (int kb = 0; kb < 32; ++kb) {
                const u32x4 aw = *(const u32x4*)(arow + kb * 32);
                f32x4 p, q; unpack8(aw, p, q); ssq += (p[0] * p[0] + p[1] * p[1]) + (p[2] * p[2] + p[3] * p[3]) + (q[0] * q[0] + q[1] * q[1]) + (q[2] * q[2] + q[3] * q[3]);
                const bf16x8 Af = __builtin_bit_cast(bf16x8, aw);
#pragma unroll
                for (int n = 0; n < 3; ++n) { const bf16x8 Bfr = *(const LAS bf16x8*)(brow + n * 16 * WP + kb * 64);
                    acc[n] = __builtin_amdgcn_mfma_f32_16x16x32_bf16(Af, Bfr, acc[n], 0, 0, 0); }
            }
            ssq += __shfl_xor(ssq, 16); ssq += __shfl_xor(ssq, 32);
            const float rs = rsqrtf(ssq * (1.f / D) + EPS);
#pragma unroll
            for (int n = 0; n < 3; ++n)
#pragma unroll
                for (int j = 0; j < 4; ++j) lg[(4 * (lane >> 4) + j) * 52 + n * 16 + (lane & 15)] = acc[n][j];
            asm volatile("s_waitcnt lgkmcnt(0)" ::: "memory");
            if (lane < 16) {
                const LAS float* my = lg + lane * 52;
                float l0 = my[0] * rs + a.in[20][0], l1 = my[1] * rs + a.in[20][1], l2 = my[2] * rs + a.in[20][2], l3 = my[3] * rs + a.in[20][3];
                int gi = 0; float lmax = l0;
                if (l1 > lmax) { lmax = l1; gi = 1; } if (l2 > lmax) { lmax = l2; gi = 2; } if (l3 > lmax) { lmax = l3; gi = 3; }
                const float se = __expf(l0 - lmax) + __expf(l1 - lmax) + __expf(l2 - lmax) + __expf(l3 - lmax);
                const float pg = 1.f / se;
                float v1 = -3.0e38f, v2 = -3.0e38f; int i1 = 0, i2 = 0;
#pragma unroll
                for (int j = 0; j < 8; ++j) { const float vv = my[4 + gi * 8 + j] * rs + a.in[22][gi * 8 + j];
                    if (vv > v1) { v2 = v1; i2 = i1; v1 = vv; i1 = j; } else if (vv > v2) { v2 = vv; i2 = j; } }
                const float w1 = 1.f / (1.f + __expf(v2 - v1));
                e1 = gi * 8 + i1; e2 = gi * 8 + i2; wt1 = pg * w1; wt2 = pg * (1.f - w1);
                rk1 = __hip_atomic_fetch_add((LAS int*)&lcnt[e1], 1, __ATOMIC_RELAXED, __HIP_MEMORY_SCOPE_WORKGROUP);
                rk2 = __hip_atomic_fetch_add((LAS int*)&lcnt[e2], 1, __ATOMIC_RELAXED, __HIP_MEMORY_SCOPE_WORKGROUP);
                rstd2[tok0 + lane] = rs;
            }
        }
        __syncthreads();
        if (F.tid < 32) { const int c = lcnt[F.tid]; lbase[F.tid] = c ? __hip_atomic_fetch_add(&cnt[F.tid], c, __ATOMIC_RELAXED, __HIP_MEMORY_SCOPE_AGENT) : 0; }
        __syncthreads();
        if (active && lane < 16) { const int t = tok0 + lane; const int p1 = lbase[e1] + rk1, p2 = lbase[e2] + rk2;
            list[e1 * T + p1] = t; list[e2 * T + p2] = t;
            tok_e[2 * t] = e1; tok_e[2 * t + 1] = e2; tok_pos[2 * t] = p1; tok_pos[2 * t + 1] = p2; tok_w[2 * t] = wt1; tok_w[2 * t + 1] = wt2; }
        __syncthreads();
    }
}
__device__ __forceinline__ void tr64q(const float* __restrict__ src, int ld, int col0, int k0, const float* __restrict__ scale, float mul, unsigned char* __restrict__ dst, size_t drow0, int Kdst, LAS unsigned char* scr, int lane) {
    const float* s = src + (size_t)k0 * ld + col0 + lane;
#pragma unroll
    for (int hh = 0; hh < 2; ++hh) {
        float v[32];
#pragma unroll
        for (int kk = 0; kk < 32; ++kk) v[kk] = s[(size_t)(32 * hh + kk) * ld];
        if (scale) {
#pragma unroll
            for (int kk = 0; kk < 32; ++kk) v[kk] *= scale[k0 + 32 * hh + kk];
        }
#pragma unroll
        for (int c = 0; c < 2; ++c) { u32x4 o;
            o.x = cvt4_fp8(v[16 * c + 0] * mul, v[16 * c + 1] * mul, v[16 * c + 2] * mul, v[16 * c + 3] * mul); o.y = cvt4_fp8(v[16 * c + 4] * mul, v[16 * c + 5] * mul, v[16 * c + 6] * mul, v[16 * c + 7] * mul);
            o.z = cvt4_fp8(v[16 * c + 8] * mul, v[16 * c + 9] * mul, v[16 * c + 10] * mul, v[16 * c + 11] * mul); o.w = cvt4_fp8(v[16 * c + 12] * mul, v[16 * c + 13] * mul, v[16 * c + 14] * mul, v[16 * c + 15] * mul);
            *(LAS u32x4*)(scr + lane * 80 + 16 * (2 * hh + c)) = o; }
        asm volatile("s_waitcnt vmcnt(0)" ::: "memory");
    }
    asm volatile("s_waitcnt lgkmcnt(0)" ::: "memory");
#pragma unroll
    for (int j = 0; j < 4; ++j) { const int row = 16 * j + (lane >> 2); const u32x4 o = *(const LAS u32x4*)(scr + row * 80 + 16 * (lane & 3));
        *(u32x4*)(dst + (drow0 + row) * (size_t)Kdst + k0 + 16 * (lane & 3)) = o; }
    asm volatile("s_waitcnt lgkmcnt(0)" ::: "memory");
}
__device__ __forceinline__ void p6_convert(const Frame& F, const Args& a, int lo, int hi, int widx, int nwork) {
    LAS unsigned char* scr = F.lds + F.wave * 16384;
    unsigned char* Wgu_q = F.ws + WS_WGU; unsigned char* Wd_q = F.ws + WS_WD;
    constexpr int I_GU = NE * 16 * 16;
    for (int it = lo + widx; it < hi; it += nwork) {
        if (it < I_GU) { const int e = it / 256, r = it % 256, kb = r / 16, nb = r % 16, j0 = 64 * nb, pn = j0 >> 8, i = j0 & 255;
            tr64q((i < 128 ? a.in[23] : a.in[24]) + (size_t)e * D * EFF, EFF, 128 * pn + (i & 127), 64 * kb, a.in[18], 32.f, Wgu_q, (size_t)e * 1024 + j0, D, scr, F.lane); }
        else { const int q = it - I_GU, e = q / 128, r = q % 128, kb = r / 16, nb = r % 16;
            tr64q(a.in[25] + (size_t)e * EFF * D, D, 64 * nb, 64 * kb, nullptr, 16.f, Wd_q, (size_t)e * 1024 + 64 * nb, EFF, scr, F.lane); }
    }
}
__device__ __forceinline__ void load_tb(const Frame& F) {
    volatile LAS int* tb = (volatile LAS int*)(F.MISC + 16); volatile LAS int* lc = (volatile LAS int*)(F.MISC + 64);
    if (F.tid < 32) lc[F.tid] = (int)__hip_atomic_load(F.ctl + CW_CNT + F.tid, __ATOMIC_RELAXED, __HIP_MEMORY_SCOPE_AGENT);
    __syncthreads();
    if (F.tid == 0) { int s = 0; for (int e = 0; e < 32; ++e) { tb[e] = s; s += (lc[e] + 255) >> 8; } tb[32] = s; }
    __syncthreads();
}
__device__ __forceinline__ void p9_final(const Frame& F, const Args& a) {
    const LAS int* tb = (const LAS int*)(F.MISC + 16);
    const int* tok_e = (const int*)(F.ws + WS_TOK); const int* tok_pos = tok_e + 2 * T; const float* tok_w = (const float*)(tok_pos + 2 * T);
    const bf16_t* Y = (const bf16_t*)(F.ws + WS_Y); const float* gf = a.in[26]; float* out = a.out;
    const int gw = blockIdx.x * 8 + F.wave, NGW = F.G * 8;
    for (int t = gw; t < T; t += NGW) {
        const int s1 = 256 * tb[tok_e[2 * t]] + tok_pos[2 * t], s2 = 256 * tb[tok_e[2 * t + 1]] + tok_pos[2 * t + 1];
        const float w1 = tok_w[2 * t], w2 = tok_w[2 * t + 1];
        f32x4 va[2], vb[2]; float s = 0.f;
#pragma unroll
        for (int j = 0; j < 2; ++j) { const int c = 8 * F.lane + 512 * j; f32x4 ya, yb, za, zb;
            unpack8(*(const u32x4*)(Y + (size_t)s1 * D + c), ya, yb); unpack8(*(const u32x4*)(Y + (size_t)s2 * D + c), za, zb);
            va[j] = *(const f32x4*)(out + (size_t)t * D + c) + w1 * ya + w2 * za; vb[j] = *(const f32x4*)(out + (size_t)t * D + c + 4) + w1 * yb + w2 * zb;
            s += (va[j][0] * va[j][0] + va[j][1] * va[j][1]) + (va[j][2] * va[j][2] + va[j][3] * va[j][3]) + (vb[j][0] * vb[j][0] + vb[j][1] * vb[j][1]) + (vb[j][2] * vb[j][2] + vb[j][3] * vb[j][3]); }
        const float rs = rsqrtf(wave_sum64(s) * (1.f / D) + EPS);
#pragma unroll
        for (int j = 0; j < 2; ++j) { const int c = 8 * F.lane + 512 * j;
            *(f32x4*)(out + (size_t)t * D + c) = va[j] * rs * *(const f32x4*)(gf + c); *(f32x4*)(out + (size_t)t * D + c + 4) = vb[j] * rs * *(const f32x4*)(gf + c + 4); }
    }
}

__global__ void __launch_bounds__(512, 2) mega_fwd(Args args) {
    extern __shared__ __attribute__((aligned(16))) unsigned char lds_raw[];
    Frame F;
    F.lds = (LAS unsigned char*)lds_raw; F.MISC = (volatile LAS unsigned*)(F.lds + MISC_OFF);
    F.tid = threadIdx.x; F.lane = F.tid & 63; F.wave = __builtin_amdgcn_readfirstlane(F.tid >> 6); F.G = gridDim.x;
    F.ws = args.ws; F.ctl = (unsigned*)(args.ws + WS_CTL);
    for (int u = F.tid; u < (LDS_BYTES - MISC_OFF) / 4; u += 512) ((LAS unsigned*)(F.lds + MISC_OFF))[u] = 0u;
    __syncthreads();
    XcdBarrier bar; bar.bar = F.ctl + CW_BAR; bar.x = 0; bar.st = nullptr;
    if (args.use_bar) bar = xcd_barrier_post(F.ctl + CW_BAR, F.MISC + 0);
    const int lo = args.ph_lo, hi = args.ph_hi;
#define IN(k) (lo <= (k) && (k) < hi)
#define SEAM(k) do { if (IN(k) && IN((k) + 1)) xcd_barrier(bar); } while (0)
    unsigned char* ws = args.ws;
    const int c = (int)blockIdx.x;

    if (IN(0)) { p0_prologue(F, args); }
    SEAM(0);
    if (IN(1)) {
        pg8::DenseOrder S{(const char*)(ws + WS_XB), (const char*)(ws + WS_WIN), D, T / 256, INC / 256, 1, F.G, c};
        EpiWin E{(const float*)(ws + WS_RSTD1), (bf16_t*)(ws + WS_V), (bf16_t*)(ws + WS_BG), (bf16_t*)(ws + WS_UB), (bf16_t*)(ws + WS_GATES), args.in[16]};
        pg8::gemm_phase<EpiWin, pg8::DenseOrder, false, true>(F.lds, D, S, E);
        { const int nu = (T / 256) * (INC / 256), rem = nu % F.G; if (rem != 0 && c >= rem) p6_convert(F, args, 0, CV_EARLY, (c - rem) * 8 + F.wave, (F.G - rem) * 8); }
    }
    SEAM(1);
    if (IN(2)) { p2_conv(F, args); ssm_pass<1>(F, args); }
    SEAM(2);
    if (IN(3)) { ssm_pass<2>(F, args); }
    SEAM(3);
    if (IN(4)) {
        { pg8::DenseOrder S{(const char*)(ws + WS_YS), (const char*)(ws + WS_WGLU), SW, T / 256, 4, 2, F.G, c};
          EpiGlu E{(const bf16_t*)(ws + WS_GATES), (bf16_t*)(ws + WS_MB)};
          pg8::gemm_phase<EpiGlu, pg8::DenseOrder, false, true>(F.lds, SW, S, E); }
        asm volatile("s_waitcnt vmcnt(0)" ::: "memory"); __syncthreads();
        { pg8::DenseOrder S{(const char*)(ws + WS_Z), (const char*)(ws + WS_WC), D, T / 256, 4, 1, F.G, c};
          EpiMix E{(const bf16_t*)(ws + WS_GATES), (const bf16_t*)(ws + WS_MB), (bf16_t*)(ws + WS_MIXED)};
          pg8::gemm_phase<EpiMix, pg8::DenseOrder, false, true>(F.lds, D, S, E); }
    }
    SEAM(4);
    if (IN(5)) {
        pg8::DenseOrder S{(const char*)(ws + WS_MIXED), (const char*)(ws + WS_WO), D, T / 256, 4, 1, F.G, c};
        EpiX1 E{args.in[0], args.out, (bf16_t*)(ws + WS_X1B), ws + WS_X1Q};
        pg8::gemm_phase<EpiX1, pg8::DenseOrder, false, true>(F.lds, D, S, E);
    }
    SEAM(5);
    if (IN(6)) { p6_route(F, args); { const int nu = (T / 256) * (INC / 256), rem = nu % F.G; p6_convert(F, args, rem != 0 ? CV_EARLY : 0, NE * 256 + NE * 128, blockIdx.x * 8 + F.wave, F.G * 8); } }
    SEAM(6);
    if (IN(7)) {
        load_tb(F);
        pg8::MoEOrder S{(const LAS int*)(F.MISC + 16), (const LAS int*)(F.MISC + 64), (const int*)(ws + WS_LIST), (const char*)(ws + WS_X1Q), (const char*)(ws + WS_WGU), D / 2, (size_t)1024 * D, F.G, c, true, (const char*)(ws + WS_WGU), 64};
        EpiUp E{(const int*)(ws + WS_LIST), (const float*)(ws + WS_RSTD2), ws + WS_HMID};
        pg8::gemm_phase<EpiUp, pg8::MoEOrder, true, true, true>(F.lds, D / 2, S, E);
    }
    SEAM(7);
    if (IN(8)) {
        load_tb(F);
        pg8::MoEOrder S{(const LAS int*)(F.MISC + 16), (const LAS int*)(F.MISC + 64), (const int*)(ws + WS_LIST), (const char*)(ws + WS_HMID), (const char*)(ws + WS_WD), EFF / 2, (size_t)1024 * EFF, F.G, c, false, (const char*)(ws + WS_WD2), WD_SPLIT};
        EpiDown E{(bf16_t*)(ws + WS_Y)};
        pg8::gemm_phase<EpiDown, pg8::MoEOrder, false, true, true>(F.lds, EFF / 2, S, E);
    }
    SEAM(8);
    if (IN(9)) { load_tb(F); p9_final(F, args); }
#undef IN
#undef SEAM
}

#ifndef MK_MODE
#define MK_MODE 2
#endif
extern "C" void kernel_launch(void* const* d_in, const int* in_sizes, int n_in, void* d_out, int out_size, void* d_ws, size_t ws_size, hipStream_t stream) {
    static int grid = 0;
    if (grid == 0) {
        if (ws_size < WS_END) { fprintf(stderr, "kernel_launch: workspace too small (%zu < %zu)\n", ws_size, (size_t)WS_END); grid = -1; return; }
        int dev = 0, cus = 0, per_cu = 0;
        (void)hipGetDevice(&dev); (void)hipDeviceGetAttribute(&cus, hipDeviceAttributeMultiprocessorCount, dev);
        (void)hipFuncSetAttribute((const void*)mega_fwd, hipFuncAttributeMaxDynamicSharedMemorySize, LDS_BYTES);
        (void)hipOccupancyMaxActiveBlocksPerMultiprocessor(&per_cu, (const void*)mega_fwd, 512, LDS_BYTES);
        (void)hipGetLastError();
        grid = cus * (per_cu < 1 ? 1 : 1);
    }
    if (grid < 0) return;
    (void)hipMemsetAsync((char*)d_ws + WS_CTL, 0, CTL_BYTES, stream);
    Args a{};
    for (int i = 0; i < 27; ++i) a.in[i] = (const float*)d_in[i];
    a.out = (float*)d_out; a.ws = (unsigned char*)d_ws;
#if MK_MODE == 2
    a.ph_lo = 0; a.ph_hi = 10; a.use_bar = 1;
    hipLaunchKernelGGL(mega_fwd, dim3(grid), dim3(512), LDS_BYTES, stream, a);
#else
    const int nfast = (MK_MODE == 1) ? 6 : 10;
    for (int p = 0; p < nfast; ++p) { a.ph_lo = p; a.ph_hi = p + 1; a.use_bar = 0; hipLaunchKernelGGL(mega_fwd, dim3(grid), dim3(512), LDS_BYTES, stream, a); }
#if MK_MODE == 1
    {
        using namespace nv;
        float* out = (float*)d_out; char* ws = (char*)d_ws; const size_t MiB_ = 1u << 20;
        float* hbuf = (float*)(ws); float* B1 = (float*)(ws + 64 * MiB_); float* B2 = (float*)(ws + 128 * MiB_);
        char* misc = ws + 256 * MiB_;
        int* cnt = (int*)(misc + 2 * MiB_); int* off = cnt + 64; int* list = (int*)(misc + 2 * MiB_ + 4096);
        int* tok_e = (int*)(misc + 5 * MiB_); int* tok_pos = tok_e + 2 * nv::T; float* tok_w = (float*)(tok_pos + 2 * nv::T);
        const dim3 b256(256);
        const float* norm_ffn = (const float*)d_in[18]; const float* wrg = (const float*)d_in[19]; const float* brg = (const float*)d_in[20]; const float* wre = (const float*)d_in[21]; const float* bre = (const float*)d_in[22];
        const float* w_gate = (const float*)d_in[23]; const float* w_up = (const float*)d_in[24]; const float* w_down = (const float*)d_in[25]; const float* norm_final = (const float*)d_in[26];
        hipLaunchKernelGGL(k_rmsnorm, dim3(nv::T / 4), b256, 0, stream, out, norm_ffn, hbuf, nv::T);
        (void)hipMemsetAsync(cnt, 0, 512, stream);
        hipLaunchKernelGGL(k_route, dim3(nv::T / 4), b256, 0, stream, hbuf, wrg, brg, wre, bre, cnt, list, tok_e, tok_pos, tok_w);
        hipLaunchKernelGGL(k_offsets, dim3(1), dim3(64), 0, stream, cnt, off);
        float* Hm = B1; float* Yd = B2;
        for (int e = 0; e < nv::NE; ++e)
            hipLaunchKernelGGL(k_gemm<2>, dim3(nv::EFF / 64, nv::T / 64), b256, 0, stream, hbuf, nv::D, list + e * nv::T, nullptr, w_gate + (size_t)e * nv::D * nv::EFF, w_up + (size_t)e * nv::D * nv::EFF, nv::EFF,
                               Hm, nv::EFF, off + e, nullptr, 0, cnt + e, nv::EFF, nv::D);
        for (int e = 0; e < nv::NE; ++e)
            hipLaunchKernelGGL(k_gemm<0>, dim3(nv::D / 64, nv::T / 64), b256, 0, stream, Hm, nv::EFF, nullptr, off + e, w_down + (size_t)e * nv::EFF * nv::D, nullptr, nv::D,
                               Yd, nv::D, off + e, nullptr, 0, cnt + e, nv::D, nv::EFF);
        hipLaunchKernelGGL(k_final, dim3(nv::T / 4), b256, 0, stream, out, Yd, off, tok_e, tok_pos, tok_w, norm_final);
    }
#endif
#endif
}
```

```cpp
#define CV_EARLY_ITEMS 0
#include <hip/hip_runtime.h>
#include <stdint.h>
#include <cstdio>

namespace nv {
constexpr int T = 16384, D = 1024, SW = 512, NG = 32, NS = 64, NH = 16, INC = 5632, NE = 32, EFF = 512;
constexpr float EPS = 1e-6f;

__device__ __forceinline__ float wave_sum(float v) {
#pragma unroll
    for (int o = 1; o < 64; o <<= 1) v += __shfl_xor(v, o);
    return v;
}
__device__ __forceinline__ float sigmoidf_(float x) { return 1.f / (1.f + __expf(-x)); }
__device__ __forceinline__ float gelu_tanh(float x) { const float u = 0.7978845608028654f * (x + 0.044715f * x * x * x); return 0.5f * x * (1.f + tanhf(u)); }

__global__ __launch_bounds__(256) void k_rmsnorm(const float* x, const float* g, float* y, int rows) {
    const int row = blockIdx.x * 4 + (threadIdx.x >> 6), lane = threadIdx.x & 63;
    if (row >= rows) return;
    const float4* xr = (const float4*)(x + (size_t)row * D);
    float4 v[4]; float s = 0.f;
#pragma unroll
    for (int j = 0; j < 4; ++j) { v[j] = xr[lane + 64 * j]; s += v[j].x * v[j].x + v[j].y * v[j].y + v[j].z * v[j].z + v[j].w * v[j].w; }
    const float r = rsqrtf(wave_sum(s) * (1.f / D) + EPS);
    float4* yr = (float4*)(y + (size_t)row * D);
#pragma unroll
    for (int j = 0; j < 4; ++j) { const float4 gg = ((const float4*)g)[lane + 64 * j]; yr[lane + 64 * j] = make_float4(v[j].x * r * gg.x, v[j].y * r * gg.y, v[j].z * r * gg.z, v[j].w * r * gg.w); }
}

template <int MODE>
__global__ __launch_bounds__(256) void k_gemm(const float* A, int lda, const int* gather, const int* aoff_dev, const float* B, const float* B2, int ldb,
                                              float* C, int ldc, const int* coff_dev, const float* resid, int M, const int* Mdev, int N, int K) {
    __shared__ float As[16][68];
    __shared__ float Bs[16][64];
    __shared__ float Bs2[16][64];
    if (Mdev) M = *Mdev;
    const int row0 = blockIdx.y * 64, col0 = blockIdx.x * 64;
    if (row0 >= M) return;
    const int aoff = aoff_dev ? *aoff_dev : 0, coff = coff_dev ? *coff_dev : 0;
    const int tid = threadIdx.x, ty = tid >> 4, tx = tid & 15;
    const int lr = tid >> 2, lk = (tid & 3) * 4;
    const int bk = tid >> 4, bn = (tid & 15) * 4;
    int arow = -1;
    if (row0 + lr < M) arow = gather ? gather[row0 + lr] : (aoff + row0 + lr);
    float acc[4][4] = {}, acc2[4][4] = {};
    for (int k0 = 0; k0 < K; k0 += 16) {
        float4 av = make_float4(0.f, 0.f, 0.f, 0.f);
        if (arow >= 0) av = *(const float4*)(A + (size_t)arow * lda + k0 + lk);
        As[lk + 0][lr] = av.x; As[lk + 1][lr] = av.y; As[lk + 2][lr] = av.z; As[lk + 3][lr] = av.w;
        *(float4*)&Bs[bk][bn] = *(const float4*)(B + (size_t)(k0 + bk) * ldb + col0 + bn);
        if (MODE >= 2) *(float4*)&Bs2[bk][bn] = *(const float4*)(B2 + (size_t)(k0 + bk) * ldb + col0 + bn);
        __syncthreads();
#pragma unroll
        for (int k = 0; k < 16; ++k) {
            const float4 a = *(const float4*)&As[k][ty * 4];
            const float4 b = *(const float4*)&Bs[k][tx * 4];
            const float aa[4] = {a.x, a.y, a.z, a.w}, bb[4] = {b.x, b.y, b.z, b.w};
#pragma unroll
            for (int i = 0; i < 4; ++i)
#pragma unroll
                for (int j = 0; j < 4; ++j) acc[i][j] += aa[i] * bb[j];
            if (MODE >= 2) {
                const float4 b2 = *(const float4*)&Bs2[k][tx * 4]; const float cc[4] = {b2.x, b2.y, b2.z, b2.w};
#pragma unroll
                for (int i = 0; i < 4; ++i)
#pragma unroll
                    for (int j = 0; j < 4; ++j) acc2[i][j] += aa[i] * cc[j];
            }
        }
        __syncthreads();
    }
#pragma unroll
    for (int i = 0; i < 4; ++i) {
        const int r = row0 + ty * 4 + i;
        if (r >= M) continue;
        float o[4];
#pragma unroll
        for (int j = 0; j < 4; ++j) {
            float v = acc[i][j];
            if (MODE == 2) v = (v * sigmoidf_(v)) * acc2[i][j];
            if (MODE == 3) v = v * sigmoidf_(acc2[i][j]);
            o[j] = v;
        }
        const size_t ci = (size_t)(coff + r) * ldc + col0 + tx * 4;
        if (MODE == 1) { const float4 rr = *(const float4*)(resid + ci); o[0] += rr.x; o[1] += rr.y; o[2] += rr.z; o[3] += rr.w; }
        *(float4*)(C + ci) = make_float4(o[0], o[1], o[2], o[3]);
    }
}

__global__ __launch_bounds__(256) void k_conv(const float* xc, const float* cg, float* bg_z, const float* cw, const float* cb) {
    const size_t i = (size_t)blockIdx.x * 256 + threadIdx.x;
    const int t = (int)(i / D), c = (int)(i % D);
    float y = cb[c] + cw[2 * D + c] * (cg[i] * xc[i]);
    if (t >= 1) y += cw[1 * D + c] * (cg[i - D] * xc[i - D]);
    if (t >= 2) y += cw[0 * D + c] * (cg[i - 2 * D] * xc[i - 2 * D]);
    bg_z[i] = bg_z[i] * y;
}

struct cplx { float re, im; };
__device__ __forceinline__ cplx cmul(cplx a, cplx b) { return {a.re * b.re - a.im * b.im, a.re * b.im + a.im * b.re}; }

__device__ __forceinline__ void ssm_consts(const float* a_re, const float* a_im, const float* log_dt, int g, int n, cplx& abar, cplx& coef, cplx& a256) {
    const double lr = a_re[g * NS + n], li = a_im[g * NS + n], dt = exp((double)log_dt[g]);
    const double er = exp(lr * dt), cr = er * cos(li * dt), ci = er * sin(li * dt);
    abar = {(float)cr, (float)ci};
    const double nr = cr - 1.0, ni = ci, den = lr * lr + li * li;
    coef = {(float)((nr * lr + ni * li) / den), (float)((ni * lr - nr * li) / den)};
    const double e2 = exp(lr * dt * 256.0);
    a256 = {(float)(e2 * cos(li * dt * 256.0)), (float)(e2 * sin(li * dt * 256.0))};
}

template <int PASS>
__global__ __launch_bounds__(64) void k_ssm(const float* u, const float* a_re, const float* a_im, const float* log_dt, const float* b_re, const float* b_im,
                                            const float* c_re, const float* c_im, const float* dsk, float* E, const float* Cin, float* ys) {
    __shared__ float part[16][65];
    const int g = blockIdx.x, r = blockIdx.y, n = threadIdx.x;
    cplx abar, coef, a256; ssm_consts(a_re, a_im, log_dt, g, n, abar, coef, a256);
    cplx bb[16]; float cre[16], cim[16];
#pragma unroll
    for (int h = 0; h < 16; ++h) {
        bb[h] = cmul(coef, cplx{b_re[(g * NS + n) * NH + h], b_im[(g * NS + n) * NH + h]});
        cre[h] = c_re[(g * NH + h) * NS + n]; cim[h] = c_im[(g * NH + h) * NS + n];
    }
    cplx s = {0.f, 0.f};
    if (PASS == 2) s = {Cin[((size_t)(r * NG + g) * NS + n) * 2], Cin[((size_t)(r * NG + g) * NS + n) * 2 + 1]};
    for (int t = r * 256; t < r * 256 + 256; ++t) {
        const float* ut = u + (size_t)t * SW + g * NH;
        cplx bu = {0.f, 0.f};
#pragma unroll
        for (int h = 0; h < 16; ++h) { const float uv = ut[h]; bu.re += bb[h].re * uv; bu.im += bb[h].im * uv; }
        s = cmul(abar, s); s.re += bu.re; s.im += bu.im;
        if (PASS == 2) {
#pragma unroll
            for (int h = 0; h < 16; ++h) part[h][n] = cre[h] * s.re - cim[h] * s.im;
            __syncthreads();
            const int h = n & 15, q = n >> 4; float y = 0.f;
#pragma unroll
            for (int j = 0; j < 16; ++j) y += part[h][q * 16 + j];
            y += __shfl_xor(y, 16); y += __shfl_xor(y, 32);
            if (q == 0) { const float v = y + dsk[g * NH + h] * ut[h]; ys[(size_t)t * SW + g * NH + h] = gelu_tanh(v); }
            __syncthreads();
        }
    }
    if (PASS == 1) { E[((size_t)(r * NG + g) * NS + n) * 2] = s.re; E[((size_t)(r * NG + g) * NS + n) * 2 + 1] = s.im; }
}
__global__ __launch_bounds__(64) void k_ssm_carry(const float* a_re, const float* a_im, const float* log_dt, const float* E, float* Cin) {
    const int g = blockIdx.x, n = threadIdx.x;
    cplx abar, coef, a256; ssm_consts(a_re, a_im, log_dt, g, n, abar, coef, a256);
    cplx run = {0.f, 0.f};
    for (int r = 0; r < T / 256; ++r) {
        const size_t i = ((size_t)(r * NG + g) * NS + n) * 2;
        Cin[i] = run.re; Cin[i + 1] = run.im;
        run = cmul(a256, run); run.re += E[i]; run.im += E[i + 1];
    }
}

template <int ADD>
__global__ __launch_bounds__(256) void k_mix(const float* gl, const float* bias, const float* y, float* m) {
    const size_t i = (size_t)blockIdx.x * 256 + threadIdx.x; const int c = (int)(i % D);
    const float v = sigmoidf_(gl[i] + bias[c]) * y[i];
    m[i] = ADD ? m[i] + v : v;
}

__global__ __launch_bounds__(256) void k_route(const float* h2, const float* wrg, const float* brg, const float* wre, const float* bre,
                                               int* cnt, int* list, int* tok_e, int* tok_pos, float* tok_w) {
    const int t = blockIdx.x * 4 + (threadIdx.x >> 6), lane = threadIdx.x & 63;
    float acc[36];
#pragma unroll
    for (int j = 0; j < 36; ++j) acc[j] = 0.f;
    for (int k = lane; k < D; k += 64) {
        const float hv = h2[(size_t)t * D + k];
#pragma unroll
        for (int j = 0; j < 4; ++j) acc[j] += hv * wrg[k * 4 + j];
#pragma unroll
        for (int j = 0; j < 32; ++j) acc[4 + j] += hv * wre[k * 32 + j];
    }
#pragma unroll
    for (int j = 0; j < 36; ++j) acc[j] = wave_sum(acc[j]);
    if (lane == 0) {
        float lg[4]; int gi = 0; float lmax;
#pragma unroll
        for (int j = 0; j < 4; ++j) { lg[j] = acc[j] + brg[j]; }
        lmax = lg[0];
#pragma unroll
        for (int j = 1; j < 4; ++j) if (lg[j] > lmax) { lmax = lg[j]; gi = j; }
        float se = 0.f;
#pragma unroll
        for (int j = 0; j < 4; ++j) se += __expf(lg[j] - lmax);
        const float pg = 1.f / se;
        float v1 = -3.0e38f, v2 = -3.0e38f; int i1 = 0, i2 = 0;
#pragma unroll
        for (int j = 0; j < 8; ++j) { float v = 0.f;
#pragma unroll
            for (int q = 0; q < 4; ++q) if (q == gi) v = acc[4 + q * 8 + j] + bre[q * 8 + j];
            if (v > v1) { v2 = v1; i2 = i1; v1 = v; i1 = j; } else if (v > v2) { v2 = v; i2 = j; } }
        const float w1 = 1.f / (1.f + __expf(v2 - v1)), w2 = 1.f - w1;
        const int e1 = gi * 8 + i1, e2 = gi * 8 + i2;
        const int p1 = atomicAdd(&cnt[e1], 1), p2 = atomicAdd(&cnt[e2], 1);
        list[e1 * T + p1] = t; list[e2 * T + p2] = t;
        tok_e[t * 2] = e1; tok_e[t * 2 + 1] = e2; tok_pos[t * 2] = p1; tok_pos[t * 2 + 1] = p2;
        tok_w[t * 2] = pg * w1; tok_w[t * 2 + 1] = pg * w2;
    }
}
__global__ void k_offsets(const int* cnt, int* off) { if (threadIdx.x == 0) { int s = 0; for (int e = 0; e < NE; ++e) { off[e] = s; s += cnt[e]; } } }

__global__ __launch_bounds__(256) void k_final(float* out, const float* Y, const int* off, const int* tok_e, const int* tok_pos, const float* tok_w, const float* g) {
    const int t = blockIdx.x * 4 + (threadIdx.x >> 6), lane = threadIdx.x & 63;
    const int s1 = off[tok_e[t * 2]] + tok_pos[t * 2], s2 = off[tok_e[t * 2 + 1]] + tok_pos[t * 2 + 1];
    const float w1 = tok_w[t * 2], w2 = tok_w[t * 2 + 1];
    float4* xr = (float4*)(out + (size_t)t * D);
    const float4* y1 = (const float4*)(Y + (size_t)s1 * D); const float4* y2 = (const float4*)(Y + (size_t)s2 * D);
    float4 v[4]; float s = 0.f;
#pragma unroll
    for (int j = 0; j < 4; ++j) { const float4 a = xr[lane + 64 * j], b = y1[lane + 64 * j], c = y2[lane + 64 * j];
        v[j] = make_float4(a.x + w1 * b.x + w2 * c.x, a.y + w1 * b.y + w2 * c.y, a.z + w1 * b.z + w2 * c.z, a.w + w1 * b.w + w2 * c.w);
        s += v[j].x * v[j].x + v[j].y * v[j].y + v[j].z * v[j].z + v[j].w * v[j].w; }
    const float r = rsqrtf(wave_sum(s) * (1.f / D) + EPS);
#pragma unroll
    for (int j = 0; j < 4; ++j) { const float4 gg = ((const float4*)g)[lane + 64 * j]; xr[lane + 64 * j] = make_float4(v[j].x * r * gg.x, v[j].y * r * gg.y, v[j].z * r * gg.z, v[j].w * r * gg.w); }
}
}

#define LAS __attribute__((address_space(3)))
typedef unsigned short bf16_t;
typedef short bf16x8 __attribute__((ext_vector_type(8)));
typedef float f32x4 __attribute__((ext_vector_type(4)));
typedef float f32x16 __attribute__((ext_vector_type(16)));
typedef unsigned u32x4 __attribute__((ext_vector_type(4)));
typedef unsigned u32x2 __attribute__((ext_vector_type(2)));

constexpr int T = 16384, D = 1024, SW = 512, NG = 32, NS = 64, NH = 16, INC = 5632, NE = 32, EFF = 512;
constexpr float EPS = 1e-6f;

typedef __bf16 bf16x2_t __attribute__((ext_vector_type(2)));
typedef float f32x2c_t __attribute__((ext_vector_type(2)));
__device__ __forceinline__ unsigned cvt_pk_bf16(float lo, float hi) { const f32x2c_t v = {lo, hi}; return __builtin_bit_cast(unsigned, __builtin_convertvector(v, bf16x2_t)); }
__device__ __forceinline__ unsigned cvt4_fp8(float a, float b, float c, float d) { int w = __builtin_amdgcn_cvt_pk_fp8_f32(a, b, 0, false); w = __builtin_amdgcn_cvt_pk_fp8_f32(c, d, w, true); return (unsigned)w; }
__device__ __forceinline__ float bf_lo(unsigned w) { return __uint_as_float(w << 16); }
__device__ __forceinline__ float bf_hi(unsigned w) { return __uint_as_float(w & 0xffff0000u); }
__device__ __forceinline__ float fsigmoid(float x) { return __builtin_amdgcn_rcpf(1.f + __builtin_amdgcn_exp2f(-1.4426950408889634f * x)); }
__device__ __forceinline__ float fsilu(float x) { return x * fsigmoid(x); }
__device__ __forceinline__ float fgelu_tanh(float x) { const float u = 0.7978845608028654f * (x + 0.044715f * x * x * x); return x * fsigmoid(2.f * u); }
__device__ __forceinline__ float wave_sum64(float v) {
#pragma unroll
    for (int o = 1; o < 64; o <<= 1) v += __shfl_xor(v, o);
    return v;
}

namespace pg8 {
constexpr int BM = 256, BK = 64, HALF = 128, HTB = HALF * BK * 2, STAGE_BYTES = 8 * HTB, NXCD = 8, WGM = 8;
__host__ __device__ __forceinline__ int lds_byte(int r, int c) { const int st = (r >> 4) * 2 + (c >> 5), rr = r & 15, cc = c & 31, ob = rr * 64 + cc * 2; return st * 1024 + (ob ^ (((ob >> 9) & 1) << 5)); }
__host__ __device__ __forceinline__ void stage_rc(int b, int& R, int& C) { const int st = b / 1024, sb = b % 1024, swz = sb ^ (((sb >> 9) & 1) << 5); R = (st >> 1) * 16 + swz / 64; C = (st & 1) * 32 + (swz % 64) / 2; }
__host__ __device__ __forceinline__ int perm32(int rho) { const int n = rho >> 4, i = rho & 15; return 8 * (i >> 2) + 4 * n + (i & 3); }

struct Unit { int pm, pn, e, nrow, srow; };

__device__ __forceinline__ void tile_map(int L, int nM, int nN, int& pm, int& pn) {
    const int nwg = nM * nN; int wgid = L;
    { const int q = nwg / NXCD, r = nwg % NXCD, xcd = wgid % NXCD, off = wgid / NXCD; wgid = (xcd < r ? xcd * (q + 1) : r * (q + 1) + (xcd - r) * q) + off; }
    const int nig = WGM * nN, gid = wgid / nig, fm = gid * WGM, gsz = (nM - fm) < WGM ? (nM - fm) : WGM;
    pm = fm + ((wgid % nig) % gsz); pn = (wgid % nig) / gsz;
}
struct DenseOrder {
    const char* A; const char* Bt; int K, nM, nNt, sub, G, c;
    __device__ __forceinline__ bool next(int i, Unit& u) const {
        const int L = (i / sub) * G + c; if (L >= nM * nNt) return false;
        int pm, pn; tile_map(L, nM, nNt, pm, pn); u.pm = pm; u.pn = pn * sub + (i % sub); u.e = 0; u.nrow = 256; u.srow = 0; return true;
    }
    __device__ __forceinline__ const char* a_base(const Unit& u) const { return A + (size_t)u.pm * (size_t)(BM * 2) * K; }
    __device__ __forceinline__ const char* b_base(const Unit& u) const { return Bt + (size_t)u.pn * (size_t)(BM * 2) * K; }
    __device__ __forceinline__ unsigned a_row(const Unit&, int r) const { return (unsigned)r; }
};
struct MoEOrder {
    const LAS int* tb; const LAS int* lc; const int* list; const char* A; const char* Bt; int K; size_t bstride; int G, c; bool gather; const char* Bt2; int esplit;
    __device__ __forceinline__ bool next(int i, Unit& u) const {
        const int L = i * G + c; const int ntile = tb[32]; if (L >= ntile * 4) return false;
        const int tt = L >> 2; int e = 0;
#pragma unroll 1
        for (int q = 1; q < 32; ++q) if (tb[q] <= tt) e = q;
        e = __builtin_amdgcn_readfirstlane(e);
        u.e = e; u.pm = tt - tb[e]; u.pn = L & 3; const int rem = lc[e] - 256 * u.pm; u.nrow = rem < 256 ? rem : 256; u.srow = 256 * tt; return true;
    }
    __device__ __forceinline__ const char* a_base(const Unit& u) const { return gather ? A : A + (size_t)u.srow * 2 * K; }
    __device__ __forceinline__ const char* b_base(const Unit& u) const { return (u.e < esplit ? Bt + (size_t)u.e * bstride : Bt2 + (size_t)(u.e - esplit) * bstride) + (size_t)u.pn * (size_t)(BM * 2) * K; }
    __device__ __forceinline__ unsigned a_row(const Unit& u, int r) const { return r < u.nrow ? (unsigned)list[u.e * T + 256 * u.pm + r] : 0u; }
};

typedef int v8i_t __attribute__((ext_vector_type(8)));
typedef int v4i_t __attribute__((ext_vector_type(4)));
__device__ __forceinline__ v8i_t cat8(const bf16x8 lo, const bf16x8 hi) { const v4i_t a = __builtin_bit_cast(v4i_t, lo), b = __builtin_bit_cast(v4i_t, hi); return __builtin_shufflevector(a, b, 0, 1, 2, 3, 4, 5, 6, 7); }
template <class Epi, class Sched, bool GATHER, bool ALIGN_EPI, bool FP8 = false>
__device__ __forceinline__ void gemm_phase(LAS unsigned char* lds, const int K, const Sched& S, const Epi& E) {
    const int tid = threadIdx.x, wid = __builtin_amdgcn_readfirstlane(tid >> 6), lane = tid & 63, wr = wid >> 2, wc = wid & 3, fr = lane & 15, fq = lane >> 4;
    const int nt = K / BK;
    unsigned voffB[2], vA[2][2], nvA[2][2]; int Rr[2], Cc[2];
#pragma unroll
    for (int i = 0; i < 2; ++i) { int R, C; stage_rc(tid * 16 + i * 8192, R, C); const int Rb = Epi::PERM ? ((R & ~31) + perm32(R & 31)) : R;
        Rr[i] = R; Cc[i] = C; voffB[i] = (unsigned)(Rb * K + C) * 2u; }
    const size_t kstep = (size_t)(BK * 2);
    const size_t hstep = (size_t)HALF * K * 2;
    const unsigned ldsw = (unsigned)wid * 1024u;
    const int aoff = lds_byte(wr * 64 + fr, fq * 8), boff = lds_byte(wc * 32 + fr, fq * 8);
#define PG8_SA(b, h) (((b) * 2 + (h)) * HTB)
#define PG8_SB(b, h) ((4 + (b) * 2 + (h)) * HTB)
#define PG8_STAGE(bufoff, gbase, voff) do { _Pragma("unroll") for (int _i = 0; _i < 2; ++_i) \
        __builtin_amdgcn_global_load_lds((const unsigned*)((const char*)(gbase) + (voff)[_i]), (LAS unsigned*)(lds + (bufoff) + ldsw + _i * 8192), 16, 0, 0); } while (0)
#define PG8_LDA(dst, b, h) do { if constexpr (FP8) { _Pragma("unroll") for (int m = 0; m < 4; ++m) dst##8[m] = cat8(*(const LAS bf16x8*)(lds + PG8_SA(b, h) + aoff + m * 2048), *(const LAS bf16x8*)(lds + PG8_SA(b, h) + aoff + m * 2048 + 1024)); } \
    else { _Pragma("unroll") for (int m = 0; m < 4; ++m) _Pragma("unroll") for (int k = 0; k < 2; ++k) dst[m][k] = *(const LAS bf16x8*)(lds + PG8_SA(b, h) + aoff + m * 2048 + k * 1024); } } while (0)
#define PG8_LDB(dst, b, h) do { if constexpr (FP8) { _Pragma("unroll") for (int n = 0; n < 2; ++n) dst##8[n] = cat8(*(const LAS bf16x8*)(lds + PG8_SB(b, h) + boff + n * 2048), *(const LAS bf16x8*)(lds + PG8_SB(b, h) + boff + n * 2048 + 1024)); } \
    else { _Pragma("unroll") for (int n = 0; n < 2; ++n) _Pragma("unroll") for (int k = 0; k < 2; ++k) dst[n][k] = *(const LAS bf16x8*)(lds + PG8_SB(b, h) + boff + n * 2048 + k * 1024); } } while (0)
#define PG8_MMA(ai, bj, At, Bt) do { __builtin_amdgcn_s_setprio(1); if constexpr (FP8) { _Pragma("unroll") for (int m = 0; m < 4; ++m) _Pragma("unroll") for (int n = 0; n < 2; ++n) \
        asm volatile("v_mfma_scale_f32_16x16x128_f8f6f4 %0, %1, %2, %0, %3, %3 op_sel_hi:[0,0,0]" : "+v"(acc[ai][bj][m][n]) : "v"(Bt##8[n]), "v"(At##8[m]), "v"(sc8)); } \
    else { _Pragma("unroll") for (int m = 0; m < 4; ++m) _Pragma("unroll") for (int n = 0; n < 2; ++n) _Pragma("unroll") for (int k = 0; k < 2; ++k) \
        acc[ai][bj][m][n] = __builtin_amdgcn_mfma_f32_16x16x32_bf16(Bt[n][k], At[m][k], acc[ai][bj][m][n], 0, 0, 0); } __builtin_amdgcn_s_setprio(0); } while (0)
#define PG8_WAIT_V(n) asm volatile("s_waitcnt vmcnt(" #n ")" ::: "memory")
#define PG8_WAIT_L(n) asm volatile("s_waitcnt lgkmcnt(" #n ")" ::: "memory")
#define PG8_BAR __builtin_amdgcn_s_barrier()
#define PG8_SCHED __builtin_amdgcn_sched_barrier(0)
    Unit cur, nxt; int ui = 0;
    if (!S.next(0, cur)) return;
#pragma unroll
    for (int h = 0; h < 2; ++h)
#pragma unroll
        for (int i = 0; i < 2; ++i) vA[h][i] = (unsigned)((GATHER ? S.a_row(cur, h * HALF + Rr[i]) : (unsigned)(h * HALF + Rr[i])) * (unsigned)K + (unsigned)Cc[i]) * 2u;
    f32x4 acc[2][2][4][2];
    if constexpr (Epi::HAS_INIT) E.init(acc, cur, wr, wc, fr, fq);
    else {
#pragma unroll
    for (int a = 0; a < 2; ++a)
#pragma unroll
        for (int b = 0; b < 2; ++b)
#pragma unroll
            for (int m = 0; m < 4; ++m)
#pragma unroll
                for (int n = 0; n < 2; ++n) acc[a][b][m][n] = (f32x4){0.f, 0.f, 0.f, 0.f};
    }
    const int sc8 = 0x7f7f7f7f;
    bf16x8 At[4][2], B0[2][2], B1[2][2]; v8i_t At8[4], B08[2], B18[2];
    const char* cA = S.a_base(cur); const char* cB = S.b_base(cur);
    PG8_STAGE(PG8_SB(0, 0), cB, voffB); PG8_STAGE(PG8_SB(0, 1), cB + hstep, voffB); PG8_STAGE(PG8_SA(0, 0), cA, vA[0]); PG8_STAGE(PG8_SA(0, 1), cA, vA[1]);
    if (wr == 1) PG8_BAR;
    PG8_WAIT_V(2); PG8_BAR;
    PG8_STAGE(PG8_SB(1, 0), cB + kstep, voffB); PG8_STAGE(PG8_SA(1, 0), cA + kstep, vA[0]); PG8_STAGE(PG8_SB(1, 1), cB + hstep + kstep, voffB);
    PG8_WAIT_V(6); PG8_BAR;
    for (;;) {
        const bool has_next = S.next(ui + 1, nxt);
        const char* nA = has_next ? S.a_base(nxt) : cA; const char* nB = has_next ? S.b_base(nxt) : cB;
        if constexpr (GATHER) {
#pragma unroll
            for (int h = 0; h < 2; ++h)
#pragma unroll
                for (int i = 0; i < 2; ++i) nvA[h][i] = has_next ? (unsigned)(S.a_row(nxt, h * HALF + Rr[i]) * (unsigned)K + (unsigned)Cc[i]) * 2u : vA[h][i];
        }
        for (int t = 0; t < nt; t += 2) {
            const bool last = (t == nt - 2);
            const char* a1 = cA + (size_t)(t + 1) * kstep;
            const char* a2 = last ? nA : cA + (size_t)(t + 2) * kstep; const char* b2 = last ? nB : cB + (size_t)(t + 2) * kstep;
            const char* a3 = a2 + kstep; const char* b3 = b2 + kstep;
            unsigned x0[2], x1[2];
            if constexpr (GATHER) { x0[0] = last ? nvA[0][0] : vA[0][0]; x0[1] = last ? nvA[0][1] : vA[0][1]; x1[0] = last ? nvA[1][0] : vA[1][0]; x1[1] = last ? nvA[1][1] : vA[1][1]; }
            else { x0[0] = vA[0][0]; x0[1] = vA[0][1]; x1[0] = vA[1][0]; x1[1] = vA[1][1]; }
            PG8_LDB(B0, 0, 0); PG8_LDB(B1, 0, 1); PG8_SCHED; PG8_LDA(At, 0, 0); PG8_STAGE(PG8_SA(1, 1), a1, vA[1]);
            PG8_WAIT_V(8); PG8_WAIT_L(0); PG8_BAR; PG8_MMA(0, 0, At, B0); PG8_MMA(0, 1, At, B1); PG8_BAR; PG8_SCHED;
            PG8_LDA(At, 0, 1); PG8_STAGE(PG8_SB(0, 0), b2, voffB); PG8_STAGE(PG8_SB(0, 1), b2 + hstep, voffB); PG8_STAGE(PG8_SA(0, 0), a2, x0);
            PG8_WAIT_V(8); PG8_WAIT_L(0); PG8_BAR; PG8_MMA(1, 0, At, B0); PG8_MMA(1, 1, At, B1); PG8_BAR; PG8_SCHED;
            PG8_LDB(B0, 1, 0); PG8_LDB(B1, 1, 1); PG8_SCHED; PG8_LDA(At, 1, 0); PG8_STAGE(PG8_SA(0, 1), a2, x1);
            PG8_WAIT_V(8); PG8_WAIT_L(0); PG8_BAR; PG8_MMA(0, 0, At, B0); PG8_MMA(0, 1, At, B1); PG8_BAR; PG8_SCHED;
            PG8_LDA(At, 1, 1); PG8_STAGE(PG8_SB(1, 0), b3, voffB); PG8_STAGE(PG8_SB(1, 1), b3 + hstep, voffB); PG8_STAGE(PG8_SA(1, 0), a3, x0);
            PG8_WAIT_V(8); PG8_WAIT_L(0); PG8_BAR; PG8_MMA(1, 0, At, B0); PG8_MMA(1, 1, At, B1); PG8_BAR; PG8_SCHED;
        }
        if constexpr (ALIGN_EPI) { if (wr == 0) PG8_BAR; }
        if constexpr (FP8) asm volatile("s_nop 15\n\ts_nop 15" ::: "memory");
        E(acc, cur, wr, wc, fr, fq);
        if (!has_next) break;
        if constexpr (Epi::HAS_INIT) E.init(acc, nxt, wr, wc, fr, fq);
        else {
#pragma unroll
        for (int a = 0; a < 2; ++a)
#pragma unroll
            for (int b = 0; b < 2; ++b)
#pragma unroll
                for (int m = 0; m < 4; ++m)
#pragma unroll
                    for (int n = 0; n < 2; ++n) acc[a][b][m][n] = (f32x4){0.f, 0.f, 0.f, 0.f};
        }
        cur = nxt; cA = nA; cB = nB; ++ui;
        if constexpr (GATHER) { vA[0][0] = nvA[0][0]; vA[0][1] = nvA[0][1]; vA[1][0] = nvA[1][0]; vA[1][1] = nvA[1][1]; }
        if constexpr (ALIGN_EPI) { if (wr == 1) PG8_BAR; }
    }
    PG8_WAIT_V(0);
    if constexpr (!ALIGN_EPI) { if (wr == 0) PG8_BAR; }
    PG8_BAR;
#undef PG8_SA
#undef PG8_SB
#undef PG8_STAGE
#undef PG8_LDA
#undef PG8_LDB
#undef PG8_MMA
#undef PG8_WAIT_V
#undef PG8_WAIT_L
#undef PG8_BAR
#undef PG8_SCHED
}
}

#define EPI_ROWS(ai, m) (u.pm * 256 + (ai) * 128 + wr * 64 + (m) * 16 + fr)
__device__ __forceinline__ u32x4 pack8(const f32x4 a, const f32x4 b) { u32x4 w; w.x = cvt_pk_bf16(a[0], a[1]); w.y = cvt_pk_bf16(a[2], a[3]); w.z = cvt_pk_bf16(b[0], b[1]); w.w = cvt_pk_bf16(b[2], b[3]); return w; }
__device__ __forceinline__ void unpack8(const u32x4 w, f32x4& a, f32x4& b) { a = (f32x4){bf_lo(w.x), bf_hi(w.x), bf_lo(w.y), bf_hi(w.y)}; b = (f32x4){bf_lo(w.z), bf_hi(w.z), bf_lo(w.w), bf_hi(w.w)}; }

struct EpiWin {
    static constexpr bool PERM = true, HAS_INIT = false;
    const float* rstd; bf16_t* v; bf16_t* bg; bf16_t* ub; bf16_t* gates; const float* gate_bias;
    __device__ __forceinline__ void operator()(const f32x4 (&acc)[2][2][4][2], const pg8::Unit& u, int wr, int wc, int fr, int fq) const {
        if (u.pn < 8) {
#pragma unroll
            for (int ai = 0; ai < 2; ++ai)
#pragma unroll
                for (int m = 0; m < 4; ++m) { const int row = EPI_ROWS(ai, m); const float rs = rstd[row], rs2 = rs * rs;
                    const f32x4 a0 = acc[ai][0][m][0] * acc[ai][1][m][0] * rs2, a1 = acc[ai][0][m][1] * acc[ai][1][m][1] * rs2;
                    *(u32x4*)(v + (size_t)row * D + 128 * u.pn + 32 * wc + 8 * fq) = pack8(a0, a1); }
        } else if (u.pn < 14) {
            bf16_t* base; int ld, c0;
            if (u.pn < 12) { base = bg; ld = D; c0 = 256 * (u.pn - 8); } else { base = ub; ld = SW; c0 = 256 * (u.pn - 12); }
#pragma unroll
            for (int ai = 0; ai < 2; ++ai)
#pragma unroll
                for (int m = 0; m < 4; ++m) { const int row = EPI_ROWS(ai, m); const float rs = rstd[row];
#pragma unroll
                    for (int bj = 0; bj < 2; ++bj) *(u32x4*)(base + (size_t)row * ld + c0 + 128 * bj + 32 * wc + 8 * fq) = pack8(acc[ai][bj][m][0] * rs, acc[ai][bj][m][1] * rs); }
        } else {
            const int c0 = 256 * (u.pn - 14) + 32 * wc + 8 * fq;
            f32x4 bv[2][2];
#pragma unroll
            for (int bj = 0; bj < 2; ++bj)
#pragma unroll
                for (int n = 0; n < 2; ++n) bv[bj][n] = *(const f32x4*)(gate_bias + c0 + 128 * bj + 4 * n);
#pragma unroll
            for (int ai = 0; ai < 2; ++ai)
#pragma unroll
                for (int m = 0; m < 4; ++m) { const int row = EPI_ROWS(ai, m); const float rs = rstd[row];
#pragma unroll
                    for (int bj = 0; bj < 2; ++bj) { f32x4 g0 = acc[ai][bj][m][0] * rs + bv[bj][0], g1 = acc[ai][bj][m][1] * rs + bv[bj][1];
#pragma unroll
                        for (int j = 0; j < 4; ++j) { g0[j] = fsigmoid(g0[j]); g1[j] = fsigmoid(g1[j]); }
                        *(u32x4*)(gates + (size_t)row * 2048 + c0 + 128 * bj) = pack8(g0, g1); } }
        }
    }
};
struct EpiGlu {
    static constexpr bool PERM = true, HAS_INIT = false;
    const bf16_t* gates; bf16_t* mb;
    __device__ __forceinline__ void operator()(const f32x4 (&acc)[2][2][4][2], const pg8::Unit& u, int wr, int wc, int fr, int fq) const {
        const int col = 128 * u.pn + 32 * wc + 8 * fq;
#pragma unroll
        for (int ai = 0; ai < 2; ++ai)
#pragma unroll
            for (int m = 0; m < 4; ++m) { const int row = EPI_ROWS(ai, m);
                f32x4 g0, g1; unpack8(*(const u32x4*)(gates + (size_t)row * 2048 + 1024 + col), g0, g1);
                f32x4 y0 = acc[ai][0][m][0], y1 = acc[ai][0][m][1]; const f32x4 b0 = acc[ai][1][m][0], b1 = acc[ai][1][m][1];
#pragma unroll
                for (int j = 0; j < 4; ++j) { y0[j] = y0[j] * fsigmoid(b0[j]) * g0[j]; y1[j] = y1[j] * fsigmoid(b1[j]) * g1[j]; }
                *(u32x4*)(mb + (size_t)row * D + col) = pack8(y0, y1); }
    }
};
struct EpiMix {
    static constexpr bool PERM = true, HAS_INIT = false;
    const bf16_t* gates; const bf16_t* mb; bf16_t* mixed;
    __device__ __forceinline__ void operator()(const f32x4 (&acc)[2][2][4][2], const pg8::Unit& u, int wr, int wc, int fr, int fq) const {
#pragma unroll
        for (int ai = 0; ai < 2; ++ai)
#pragma unroll
            for (int m = 0; m < 4; ++m) { const int row = EPI_ROWS(ai, m);
#pragma unroll
                for (int bj = 0; bj < 2; ++bj) { const int col = 256 * u.pn + 128 * bj + 32 * wc + 8 * fq;
                    f32x4 g0, g1, m0, m1; unpack8(*(const u32x4*)(gates + (size_t)row * 2048 + col), g0, g1); unpack8(*(const u32x4*)(mb + (size_t)row * D + col), m0, m1);
                    *(u32x4*)(mixed + (size_t)row * D + col) = pack8(g0 * acc[ai][bj][m][0] + m0, g1 * acc[ai][bj][m][1] + m1); } }
    }
};
struct EpiX1 {
    static constexpr bool PERM = true, HAS_INIT = true;
    const float* __restrict__ x; float* __restrict__ x1; bf16_t* __restrict__ x1b; unsigned char* __restrict__ x1q;
    __device__ __forceinline__ void init(f32x4 (&acc)[2][2][4][2], const pg8::Unit& u, int wr, int wc, int fr, int fq) const {
#pragma unroll
        for (int ai = 0; ai < 2; ++ai)
#pragma unroll
            for (int m = 0; m < 4; ++m)
#pragma unroll
                for (int bj = 0; bj < 2; ++bj)
#pragma unroll
                    for (int n = 0; n < 2; ++n) acc[ai][bj][m][n] = *(const f32x4*)(x + (size_t)EPI_ROWS(ai, m) * D + 256 * u.pn + 128 * bj + 32 * wc + 8 * fq + 4 * n);
    }
    __device__ __forceinline__ void operator()(const f32x4 (&acc)[2][2][4][2], const pg8::Unit& u, int wr, int wc, int fr, int fq) const {
#pragma unroll
        for (int ai = 0; ai < 2; ++ai)
#pragma unroll
            for (int m = 0; m < 4; ++m) { const int row = EPI_ROWS(ai, m);
#pragma unroll
                for (int bj = 0; bj < 2; ++bj) { const size_t o = (size_t)row * D + 256 * u.pn + 128 * bj + 32 * wc + 8 * fq;
                    const f32x4 r0 = acc[ai][bj][m][0], r1 = acc[ai][bj][m][1];
                    *(u32x4*)(x1b + o) = pack8(r0, r1);
                    u32x2 q8; q8.x = cvt4_fp8(r0[0], r0[1], r0[2], r0[3]); q8.y = cvt4_fp8(r1[0], r1[1], r1[2], r1[3]); *(u32x2*)(x1q + o) = q8; }
                }
    }
};
struct EpiUp {
    static constexpr bool PERM = true, HAS_INIT = false;
    const int* list; const float* rstd2; unsigned char* hmid;
    __device__ __forceinline__ void operator()(const f32x4 (&acc)[2][2][4][2], const pg8::Unit& u, int wr, int wc, int fr, int fq) const {
        const int col = 128 * u.pn + 32 * wc + 8 * fq;
#pragma unroll
        for (int ai = 0; ai < 2; ++ai)
#pragma unroll
            for (int m = 0; m < 4; ++m) { const int r = ai * 128 + wr * 64 + m * 16 + fr; const bool ok = r < u.nrow;
                const int tok = ok ? list[u.e * T + 256 * u.pm + r] : 0; const float rs = ok ? rstd2[tok] * (1.f / 32.f) : 0.f;
                f32x4 g0 = acc[ai][0][m][0] * rs, g1 = acc[ai][0][m][1] * rs; const f32x4 u0 = acc[ai][1][m][0] * rs, u1 = acc[ai][1][m][1] * rs;
#pragma unroll
                for (int j = 0; j < 4; ++j) { g0[j] = fsilu(g0[j]) * u0[j]; g1[j] = fsilu(g1[j]) * u1[j]; }
                u32x2 q8; q8.x = cvt4_fp8(g0[0], g0[1], g0[2], g0[3]); q8.y = cvt4_fp8(g1[0], g1[1], g1[2], g1[3]); *(u32x2*)(hmid + (size_t)(u.srow + r) * EFF + col) = q8; }
    }
};
struct EpiDown {
    static constexpr bool PERM = true, HAS_INIT = false;
    bf16_t* Y;
    __device__ __forceinline__ void operator()(const f32x4 (&acc)[2][2][4][2], const pg8::Unit& u, int wr, int wc, int fr, int fq) const {
#pragma unroll
        for (int ai = 0; ai < 2; ++ai)
#pragma unroll
            for (int m = 0; m < 4; ++m) { const int r = ai * 128 + wr * 64 + m * 16 + fr;
#pragma unroll
                for (int bj = 0; bj < 2; ++bj) *(u32x4*)(Y + (size_t)(u.srow + r) * D + 256 * u.pn + 128 * bj + 32 * wc + 8 * fq) = pack8(acc[ai][bj][m][0] * (1.f / 16.f), acc[ai][bj][m][1] * (1.f / 16.f)); }
    }
};

constexpr size_t MiB = 1u << 20;
constexpr size_t WS_CTL = 0, CTL_BYTES = 64 * 1024;
constexpr size_t WS_WIN = 1 * MiB, WS_WC = 12 * MiB, WS_WGLU = 14 * MiB, WS_WO = 16 * MiB;
constexpr size_t WS_RSTD1 = 18 * MiB, WS_RSTD2 = WS_RSTD1 + 64 * 1024, WS_TABA = WS_RSTD2 + 64 * 1024, WS_TABA256 = WS_TABA + 32 * 1024, WS_BBT = WS_TABA256 + 32 * 1024,
                 WS_CT = WS_BBT + 128 * 1024, WS_WRT = WS_CT + 128 * 1024, WS_E = 19 * MiB;
constexpr size_t WS_XB = 20 * MiB, WS_Z = 20 * MiB;
constexpr size_t WS_V = 52 * MiB, WS_MB = 52 * MiB, WS_X1B = 52 * MiB;
constexpr size_t WS_BG = 84 * MiB, WS_MIXED = 84 * MiB, WS_HMID = 84 * MiB;
constexpr size_t WS_UB = 116 * MiB, WS_YS = 116 * MiB;
constexpr size_t WS_GATES = 132 * MiB;
constexpr size_t WS_Y = 124 * MiB;
constexpr size_t WS_WGU = 196 * MiB, WS_X1Q = 228 * MiB;
constexpr size_t WS_WD = 260 * MiB, WS_WD2 = 2 * MiB;
constexpr int WD_SPLIT = 64;
#ifndef CV_EARLY_ITEMS
#define CV_EARLY_ITEMS 5120
#endif
constexpr int CV_EARLY = CV_EARLY_ITEMS;
constexpr size_t WS_TOK = 4 * MiB, WS_LIST = 6 * MiB, WS_END = 290 * MiB;
constexpr int CW_CNT = 64;
constexpr int CW_BAR = 4096;
constexpr int RING_BYTES = 131072, MISC_OFF = RING_BYTES, LDS_BYTES = 147456;

#define XB_TMO      128
#define XB_XCNT(j)  (256  + 64 * (j))
#define XB_XSUB(j)  (1280 + 64 * (j))
#define XB_XGEN(j)  (2304 + 64 * (j))
#define XB_TOP      3328
#define XB_TOPGEN   3392
#define XCD_BAR_WORDS 3456
#define XB_SPIN_CAP (1u << 18)
__device__ __forceinline__ unsigned xb_ld(unsigned* p)              { return __hip_atomic_load(p, __ATOMIC_RELAXED, __HIP_MEMORY_SCOPE_AGENT); }
__device__ __forceinline__ unsigned xb_add(unsigned* p, unsigned v) { return __hip_atomic_fetch_add(p, v, __ATOMIC_RELAXED, __HIP_MEMORY_SCOPE_AGENT); }
__device__ __forceinline__ unsigned xb_xcc_id() { return (unsigned)__builtin_amdgcn_s_getreg((3 << 11) | 20) & 0xFu; }
#define XB_SPIN(cond, bar) do { unsigned _sp = 0; while (cond) { __builtin_amdgcn_s_sleep(1); \
    if ((++_sp & 255u) == 0u) { if (xb_ld(&(bar)[XB_TMO])) break; if (_sp > XB_SPIN_CAP) { atomicAdd(&(bar)[XB_TMO], 1u); break; } } } } while (0)
struct XcdBarrier { unsigned* bar; unsigned x; volatile LAS unsigned* st; };
__device__ __forceinline__ XcdBarrier xcd_barrier_post(unsigned* bar, volatile LAS unsigned* st) {
    XcdBarrier b; b.bar = bar; b.x = xb_xcc_id(); b.st = st;
    if (threadIdx.x == 0) (void)xb_add(&bar[XB_XCNT(b.x)], 1u);
    return b;
}
__device__ __forceinline__ void xcd_barrier_complete(unsigned* bar, unsigned x, unsigned& nloc, unsigned& nx) {
    const unsigned G = gridDim.x * gridDim.y * gridDim.z;
    unsigned sum, cnt, mine, sp = 0u;
    for (;;) {
        sum = 0u; cnt = 0u; mine = 0u;
#pragma unroll
        for (unsigned j = 0; j < 16; ++j) { const unsigned c = xb_ld(&bar[XB_XCNT(j)]); sum += c; cnt += (c > 0u) ? 1u : 0u; mine = (j == x) ? c : mine; }
        if (sum == G) break;
        __builtin_amdgcn_s_sleep(1);
        if ((++sp & 255u) == 0u) { if (xb_ld(&bar[XB_TMO])) break; if (sp > XB_SPIN_CAP) { atomicAdd(&bar[XB_TMO], 1u); break; } }
    }
    nloc = mine > 0u ? mine : 1u; nx = cnt > 0u ? cnt : 1u;
}
__device__ __forceinline__ void xcd_barrier(const XcdBarrier& b) {
    asm volatile("s_waitcnt vmcnt(0)" ::: "memory");
    __syncthreads();
    if (threadIdx.x == 0) {
        unsigned* bar = b.bar;
        __builtin_amdgcn_s_waitcnt(0);
        unsigned nloc = b.st[0], nx = b.st[1];
        if (nloc == 0u) { xcd_barrier_complete(bar, b.x, nloc, nx); b.st[0] = nloc; b.st[1] = nx; }
        const unsigned old = xb_add(&bar[XB_XSUB(b.x)], 1u);
        const unsigned gen = old / nloc;
        if (old + 1u == (gen + 1u) * nloc) {
            __builtin_amdgcn_fence(__ATOMIC_RELEASE, "agent");
            asm volatile("s_waitcnt vmcnt(0)" ::: "memory");
            const unsigned og = xb_add(&bar[XB_TOP], 1u);
            const unsigned tg = og / nx;
            if (og + 1u == (tg + 1u) * nx) xb_add(&bar[XB_TOPGEN], 1u);
            else XB_SPIN(xb_ld(&bar[XB_TOPGEN]) == tg, bar);
            __builtin_amdgcn_fence(__ATOMIC_ACQUIRE, "agent");
            xb_add(&bar[XB_XGEN(b.x)], 1u);
            asm volatile("s_waitcnt vmcnt(0)" ::: "memory");
        } else {
            XB_SPIN(xb_ld(&bar[XB_XGEN(b.x)]) == gen, bar);
            __builtin_amdgcn_fence(__ATOMIC_ACQUIRE, "agent");
            asm volatile("s_waitcnt vmcnt(0)" ::: "memory");
        }
    }
    __syncthreads();
}

struct Args { const float* in[27]; float* out; unsigned char* ws; int ph_lo, ph_hi, use_bar, pad; };
struct Frame {
    LAS unsigned char* lds; volatile LAS unsigned* MISC; unsigned* ctl; unsigned char* ws;
    int tid, lane, wave, G;
};

__device__ __forceinline__ void tr64(const float* __restrict__ src, int ld, int col0, int k0, const float* __restrict__ scale, bf16_t* __restrict__ dst, size_t drow0, int Kdst, LAS unsigned char* scr, int lane) {
    const float* s = src + (size_t)k0 * ld + col0 + lane;
#pragma unroll
    for (int hh = 0; hh < 2; ++hh) {
        float v[32];
#pragma unroll
        for (int kk = 0; kk < 32; ++kk) v[kk] = s[(size_t)(32 * hh + kk) * ld];
        if (scale) {
#pragma unroll
            for (int kk = 0; kk < 32; ++kk) v[kk] *= scale[k0 + 32 * hh + kk];
        }
#pragma unroll
        for (int c = 0; c < 4; ++c) { u32x4 o; o.x = cvt_pk_bf16(v[8 * c + 0], v[8 * c + 1]); o.y = cvt_pk_bf16(v[8 * c + 2], v[8 * c + 3]); o.z = cvt_pk_bf16(v[8 * c + 4], v[8 * c + 5]); o.w = cvt_pk_bf16(v[8 * c + 6], v[8 * c + 7]);
            *(LAS u32x4*)(scr + lane * 144 + 16 * (4 * hh + c)) = o; }
        asm volatile("s_waitcnt vmcnt(0)" ::: "memory");
    }
    asm volatile("s_waitcnt lgkmcnt(0)" ::: "memory");
#pragma unroll
    for (int j = 0; j < 8; ++j) { const int row = 8 * j + (lane >> 3); const u32x4 o = *(const LAS u32x4*)(scr + row * 144 + 16 * (lane & 7));
        *(u32x4*)(dst + (drow0 + row) * (size_t)Kdst + k0 + 8 * (lane & 7)) = o; }
    asm volatile("s_waitcnt lgkmcnt(0)" ::: "memory");
}

__device__ __forceinline__ void p0_prologue(const Frame& F, const Args& a) {
    LAS unsigned char* scr = F.lds + F.wave * 16384;
    const int gw = blockIdx.x * 8 + F.wave, NGW = F.G * 8;
    bf16_t* Win_t = (bf16_t*)(F.ws + WS_WIN); bf16_t* Wc_t = (bf16_t*)(F.ws + WS_WC); bf16_t* Wglu_t = (bf16_t*)(F.ws + WS_WGLU); bf16_t* Wo_t = (bf16_t*)(F.ws + WS_WO);
    constexpr int I_WIN = 16 * 88, I_WC = 16 * 16, I_WO = 16 * 16, I_GLU = 8 * 32;
    for (int it = gw; it < I_WIN + I_WC + I_WO + I_GLU; it += NGW) {
        int r = it;
        if (r < I_WIN) { const int kb = r / 88, nb = r % 88, j0 = 64 * nb; int col0;
            if (j0 < 2048) { const int pn = j0 >> 8, i = j0 & 255; col0 = (i < 128) ? (128 * pn + i) : (2048 + 128 * pn + (i - 128)); } else if (j0 < 3072) col0 = j0 - 1024; else col0 = j0;
            tr64(a.in[2], INC, col0, 64 * kb, a.in[1], Win_t, (size_t)j0, D, scr, F.lane); continue; }
        r -= I_WIN;
        if (r < I_WC) { tr64(a.in[5], D, 64 * (r % 16), 64 * (r / 16), nullptr, Wc_t, (size_t)(64 * (r % 16)), D, scr, F.lane); continue; }
        r -= I_WC;
        if (r < I_WO) { tr64(a.in[17], D, 64 * (r % 16), 64 * (r / 16), nullptr, Wo_t, (size_t)(64 * (r % 16)), D, scr, F.lane); continue; }
        r -= I_WO;
        { const int kb = r / 32, nb = r % 32, j0 = 64 * nb, pn = j0 >> 8, i = j0 & 255;
          tr64(i < 128 ? a.in[14] : a.in[15], D, 128 * pn + (i & 127), 64 * kb, nullptr, Wglu_t, (size_t)j0, SW, scr, F.lane); }
    }
    { const float* __restrict__ x = a.in[0]; bf16_t* __restrict__ xb = (bf16_t*)(F.ws + WS_XB); float* __restrict__ rstd1 = (float*)(F.ws + WS_RSTD1);
      for (int m = 4 * gw; m < T; m += 4 * NGW) {
          f32x4 v[4][4]; float sq[4];
#pragma unroll
          for (int q = 0; q < 4; ++q) { const f32x4* xr = (const f32x4*)(x + (size_t)(m + q) * D) + F.lane;
#pragma unroll
              for (int j = 0; j < 4; ++j) v[q][j] = xr[64 * j]; }
#pragma unroll
          for (int q = 0; q < 4; ++q) { sq[q] = 0.f;
#pragma unroll
              for (int j = 0; j < 4; ++j) sq[q] += (v[q][j][0] * v[q][j][0] + v[q][j][1] * v[q][j][1]) + (v[q][j][2] * v[q][j][2] + v[q][j][3] * v[q][j][3]);
              u32x2* o = (u32x2*)(xb + (size_t)(m + q) * D) + F.lane;
#pragma unroll
              for (int j = 0; j < 4; ++j) { u32x2 w; w.x = cvt_pk_bf16(v[q][j][0], v[q][j][1]); w.y = cvt_pk_bf16(v[q][j][2], v[q][j][3]); o[64 * j] = w; } }
#pragma unroll
          for (int o = 1; o < 64; o <<= 1) {
#pragma unroll
              for (int q = 0; q < 4; ++q) sq[q] += __shfl_xor(sq[q], o); }
          if (F.lane < 4) { const float sv = F.lane == 0 ? sq[0] : F.lane == 1 ? sq[1] : F.lane == 2 ? sq[2] : sq[3]; rstd1[m + F.lane] = rsqrtf(sv * (1.f / D) + EPS); }
          asm volatile("s_waitcnt vmcnt(8)" ::: "memory"); } }
    { bf16_t* wrt = (bf16_t*)(F.ws + WS_WRT); const float* g2 = a.in[18];
      for (int i = blockIdx.x * 512 + F.tid; i < 48 * D; i += F.G * 512) { const int j = i / D, k = i % D; float w = 0.f;
          if (j < 4) w = a.in[19][k * 4 + j]; else if (j < 36) w = a.in[21][k * 32 + (j - 4)];
          wrt[i] = (bf16_t)(cvt_pk_bf16(w * g2[k], 0.f) & 0xffffu); } }
    { float* tab_a = (float*)(F.ws + WS_TABA); float* tab_a256 = (float*)(F.ws + WS_TABA256); bf16_t* BbT = (bf16_t*)(F.ws + WS_BBT); bf16_t* Ct = (bf16_t*)(F.ws + WS_CT);
      for (int i = blockIdx.x * 512 + F.tid; i < NG * NS; i += F.G * 512) { const int g = i / NS, n = i % NS;
          f32x4 br[4], bi[4]; float cre[16], cim[16];
#pragma unroll
          for (int q = 0; q < 4; ++q) { br[q] = *(const f32x4*)(a.in[9] + (size_t)i * NH + 4 * q); bi[q] = *(const f32x4*)(a.in[10] + (size_t)i * NH + 4 * q); }
#pragma unroll
          for (int h = 0; h < NH; ++h) { cre[h] = a.in[11][(g * NH + h) * NS + n]; cim[h] = a.in[12][(g * NH + h) * NS + n]; }
          const float lr = a.in[6][i], li = a.in[7][i], dt = expf(a.in[8][g]);
          float sn, cs; sincosf(li * dt, &sn, &cs); const float er = expf(lr * dt); const float cr = er * cs, ci = er * sn;
          float pr = cr, pi = ci;
#pragma unroll
          for (int q = 0; q < 4; ++q) { const float tr_ = pr * pr - pi * pi, ti_ = 2.f * pr * pi; pr = tr_; pi = ti_; }
          *(f32x4*)(tab_a + (size_t)i * 4) = (f32x4){cr, ci, pr, pi};
#pragma unroll
          for (int q = 0; q < 4; ++q) { const float tr_ = pr * pr - pi * pi, ti_ = 2.f * pr * pi; pr = tr_; pi = ti_; }
          *(float2*)(tab_a256 + (size_t)i * 2) = make_float2(pr, pi);
          const float nr = cr - 1.f, ni = ci, den = lr * lr + li * li; const float kr = (nr * lr + ni * li) / den, ki = (ni * lr - nr * li) / den;
          unsigned wre[8], wim[8];
#pragma unroll
          for (int q = 0; q < 4; ++q) {
              wre[2 * q]     = cvt_pk_bf16(kr * br[q][0] - ki * bi[q][0], kr * br[q][1] - ki * bi[q][1]);
              wre[2 * q + 1] = cvt_pk_bf16(kr * br[q][2] - ki * bi[q][2], kr * br[q][3] - ki * bi[q][3]);
              wim[2 * q]     = cvt_pk_bf16(kr * bi[q][0] + ki * br[q][0], kr * bi[q][1] + ki * br[q][1]);
              wim[2 * q + 1] = cvt_pk_bf16(kr * bi[q][2] + ki * br[q][2], kr * bi[q][3] + ki * br[q][3]); }
          u32x4* dre = (u32x4*)(BbT + ((size_t)(g * 4 + 0 + (n >> 5)) * 32 + (n & 31)) * 16); u32x4* dim_ = (u32x4*)(BbT + ((size_t)(g * 4 + 2 + (n >> 5)) * 32 + (n & 31)) * 16);
          dre[0] = (u32x4){wre[0], wre[1], wre[2], wre[3]}; dre[1] = (u32x4){wre[4], wre[5], wre[6], wre[7]};
          dim_[0] = (u32x4){wim[0], wim[1], wim[2], wim[3]}; dim_[1] = (u32x4){wim[4], wim[5], wim[6], wim[7]};
#pragma unroll
          for (int h = 0; h < NH; ++h) *(unsigned*)(Ct + (size_t)(g * NH + h) * 128 + 2 * n) = cvt_pk_bf16(cre[h], -cim[h]); } }
}

__device__ __forceinline__ void p2_conv(const Frame& F, const Args& a) {
    const bf16_t* v = (const bf16_t*)(F.ws + WS_V); const bf16_t* bg = (const bf16_t*)(F.ws + WS_BG); bf16_t* z = (bf16_t*)(F.ws + WS_Z);
    const float* cw = a.in[3]; const float* cb = a.in[4];
    const int gw = blockIdx.x * 8 + F.wave, NGW = F.G * 8;
    for (int it = gw; it < (T / 8) * 2; it += NGW) {
        const int t0 = (it >> 1) * 8, ch = (it & 1) * 512 + F.lane * 8;
        f32x4 w0a = *(const f32x4*)(cw + ch), w0b = *(const f32x4*)(cw + ch + 4), w1a = *(const f32x4*)(cw + D + ch), w1b = *(const f32x4*)(cw + D + ch + 4);
        f32x4 w2a = *(const f32x4*)(cw + 2 * D + ch), w2b = *(const f32x4*)(cw + 2 * D + ch + 4), ba = *(const f32x4*)(cb + ch), bb = *(const f32x4*)(cb + ch + 4);
        f32x4 p2a = {0.f, 0.f, 0.f, 0.f}, p2b = p2a, p1a = p2a, p1b = p2a;
        if (t0 >= 2) { unpack8(*(const u32x4*)(v + (size_t)(t0 - 2) * D + ch), p2a, p2b); unpack8(*(const u32x4*)(v + (size_t)(t0 - 1) * D + ch), p1a, p1b); }
#pragma unroll
        for (int i = 0; i < 8; ++i) { f32x4 ca, cbv, ga, gb; unpack8(*(const u32x4*)(v + (size_t)(t0 + i) * D + ch), ca, cbv); unpack8(*(const u32x4*)(bg + (size_t)(t0 + i) * D + ch), ga, gb);
            const f32x4 ya = ga * (w0a * p2a + w1a * p1a + w2a * ca + ba), yb = gb * (w0b * p2b + w1b * p1b + w2b * cbv + bb);
            *(u32x4*)(z + (size_t)(t0 + i) * D + ch) = pack8(ya, yb);
            p2a = p1a; p2b = p1b; p1a = ca; p1b = cbv; }
    }
}

struct ConvD { const float* src; const float* scale; bf16_t* dst; int ld, Kdst; };
__device__ __forceinline__ ConvD conv_desc(int H, const Args& a, unsigned char* ws) {
    ConvD d; const int it = H >> 1, hh = H & 1;
    if (it < NE * 256) { const int e = it >> 8, r = it & 255, kb = r >> 4, nb = r & 15, j0 = 64 * nb, pn = j0 >> 8, i = j0 & 255, k0 = 64 * kb + 32 * hh;
        d.src = (i < 128 ? a.in[23] : a.in[24]) + (size_t)e * D * EFF + (size_t)k0 * EFF + 128 * pn + (i & 127); d.ld = EFF; d.scale = a.in[18] + k0;
        d.dst = (bf16_t*)(ws + WS_WGU) + ((size_t)e * 1024 + j0) * D + k0; d.Kdst = D; }
    else { const int q = it - NE * 256, e = q >> 7, r = q & 127, kb = r >> 4, nb = r & 15, k0 = 64 * kb + 32 * hh;
        d.src = a.in[25] + (size_t)e * EFF * D + (size_t)k0 * D + 64 * nb; d.ld = D; d.scale = nullptr;
        d.dst = (bf16_t*)(e < WD_SPLIT ? ws + WS_WD + (size_t)e * MiB : ws + WS_WD2 + (size_t)(e - WD_SPLIT) * MiB) + (size_t)(64 * nb) * EFF + k0; d.Kdst = EFF; }
    return d;
}
__device__ __forceinline__ void conv_finish(float (&cv)[32], const ConvD& d, const float sc, LAS unsigned char* scr, int lane) {
    if (d.scale) {
#pragma unroll
        for (int kk = 0; kk < 32; ++kk) cv[kk] *= __uint_as_float((unsigned)__builtin_amdgcn_readlane((int)__float_as_uint(sc), kk));
    }
#pragma unroll
    for (int c = 0; c < 4; ++c) { u32x4 o; o.x = cvt_pk_bf16(cv[8 * c + 0], cv[8 * c + 1]); o.y = cvt_pk_bf16(cv[8 * c + 2], cv[8 * c + 3]); o.z = cvt_pk_bf16(cv[8 * c + 4], cv[8 * c + 5]); o.w = cvt_pk_bf16(cv[8 * c + 6], cv[8 * c + 7]);
        *(LAS u32x4*)(scr + lane * 80 + 16 * c) = o; }
    asm volatile("s_waitcnt lgkmcnt(0)" ::: "memory");
#pragma unroll
    for (int j = 0; j < 4; ++j) { const int row = 16 * j + (lane >> 2); const u32x4 o = *(const LAS u32x4*)(scr + row * 80 + 16 * (lane & 3));
        *(u32x4*)(d.dst + (size_t)row * d.Kdst + 8 * (lane & 3)) = o; }
    asm volatile("s_waitcnt lgkmcnt(0)" ::: "memory");
}

__device__ __forceinline__ int tokmap(int r) { return 16 * ((r >> 2) & 1) + 4 * (r >> 3) + (r & 3); }
template <int PASS>
__device__ __forceinline__ void scan_tile(f32x16& re, f32x16& im, const f32x4 c, float& Rr, float& Ri, int hf) {
    const float ar = c[0], ai = c[1];
    float sr = hf ? 0.f : Rr, si = hf ? 0.f : Ri;
#pragma unroll
    for (int q = 0; q < 16; ++q) { const float nr = ar * sr - ai * si + re[q], ni = ar * si + ai * sr + im[q]; sr = nr; si = ni; re[q] = sr; im[q] = si; }
    const float orr = __shfl_xor(sr, 32), oii = __shfl_xor(si, 32);
    Rr = c[2] * sr - c[3] * si + orr; Ri = c[2] * si + c[3] * sr + oii;
    if (PASS == 2) {
        float cr = hf ? orr : 0.f, ci = hf ? oii : 0.f;
#pragma unroll
        for (int q = 0; q < 16; ++q) { const float nr = ar * cr - ai * ci, ni = ar * ci + ai * cr; cr = nr; ci = ni; re[q] += cr; im[q] += ci; }
    }
}
template <int PASS>
__device__ __forceinline__ void ssm_pass(const Frame& F, const Args& a) {
    const int lane = F.lane, hf = lane >> 5, col = lane & 31;
    const f32x4* tab_a = (const f32x4*)(F.ws + WS_TABA); const float2* tab_a256 = (const float2*)(F.ws + WS_TABA256);
    const bf16_t* BbT = (const bf16_t*)(F.ws + WS_BBT); const bf16_t* Ct = (const bf16_t*)(F.ws + WS_CT);
    const bf16_t* ub = (const bf16_t*)(F.ws + WS_UB); bf16_t* ys = (bf16_t*)(F.ws + WS_YS); float* E = (float*)(F.ws + WS_E);
    LAS unsigned char* sl = F.lds + F.wave * 16384; LAS unsigned char* cscr = sl + 8704;
    for (int id = blockIdx.x * 8 + F.wave; id < NG * (T / 256); id += F.G * 8) {
        const int g = id & 31, r = id >> 5;
        const f32x4 c0 = tab_a[g * NS + col], c1 = tab_a[g * NS + 32 + col];
        bf16x8 Bf[4];
#pragma unroll
        for (int q = 0; q < 4; ++q) Bf[q] = *(const bf16x8*)(BbT + ((size_t)(g * 4 + q) * 32 + col) * 16 + 8 * hf);
        float R0r = 0.f, R0i = 0.f, R1r = 0.f, R1i = 0.f;
        bf16x8 Cf[4], Df;
        if (PASS == 2) {
            const float2 p0 = tab_a256[g * NS + col], p1 = tab_a256[g * NS + 32 + col];
            for (int j0 = 0; j0 < r; j0 += 8) {
                float2 e0[8], e1[8];
#pragma unroll
                for (int q = 0; q < 8; ++q) { const int j = (j0 + q < r) ? j0 + q : r - 1;
                    e0[q] = *(const float2*)(E + ((size_t)(j * NG + g) * NS + col) * 2); e1[q] = *(const float2*)(E + ((size_t)(j * NG + g) * NS + 32 + col) * 2); }
#pragma unroll
                for (int q = 0; q < 8; ++q) if (j0 + q < r) {
                    const float t0r = p0.x * R0r - p0.y * R0i + e0[q].x, t0i = p0.x * R0i + p0.y * R0r + e0[q].y; R0r = t0r; R0i = t0i;
                    const float t1r = p1.x * R1r - p1.y * R1i + e1[q].x, t1i = p1.x * R1i + p1.y * R1r + e1[q].y; R1r = t1r; R1i = t1i; } }
#pragma unroll
            for (int kb = 0; kb < 4; ++kb) Cf[kb] = *(const bf16x8*)(Ct + (size_t)(g * NH + (lane & 15)) * 128 + kb * 32 + 8 * (lane >> 4));
            const unsigned dbits = cvt_pk_bf16(a.in[13][g * NH + (lane & 15)], 0.f) & 0xffffu;
#pragma unroll
            for (int jj = 0; jj < 8; ++jj) Df[jj] = (short)((lane < 32 && (8 * (lane >> 4) + jj) == (lane & 15)) ? dbits : 0u);
        }
        bf16x8 Un = *(const bf16x8*)(ub + (size_t)(r * 256 + tokmap(col)) * SW + g * NH + 8 * hf);
        bf16x8 A2n[2] = {{0, 0, 0, 0, 0, 0, 0, 0}, {0, 0, 0, 0, 0, 0, 0, 0}};
        if (PASS == 2) {
#pragma unroll
            for (int mt = 0; mt < 2; ++mt) A2n[mt] = *(const bf16x8*)(ub + (size_t)(r * 256 + 16 * mt + (lane & 15)) * SW + g * NH + 8 * ((lane >> 4) & 1)); }
        for (int c = 0; c < 8; ++c) {
            const int t0 = r * 256 + c * 32;
            const bf16x8 Ua = Un; bf16x8 A2[2] = {A2n[0], A2n[1]};
            if (lane >= 32) { A2[0] = (bf16x8){0, 0, 0, 0, 0, 0, 0, 0}; A2[1] = (bf16x8){0, 0, 0, 0, 0, 0, 0, 0}; }
            { const int tn = t0 + (c < 7 ? 32 : 0);
                Un = *(const bf16x8*)(ub + (size_t)(tn + tokmap(col)) * SW + g * NH + 8 * hf);
                if (PASS == 2) {
#pragma unroll
                    for (int mt = 0; mt < 2; ++mt) A2n[mt] = *(const bf16x8*)(ub + (size_t)(tn + 16 * mt + (lane & 15)) * SW + g * NH + 8 * ((lane >> 4) & 1)); } }
            constexpr bool has_cv = false; ConvD cd; float cv[32]; float csc = 1.f;
            if (has_cv) { const int jstep = (PASS == 2 ? 4 + c : c); cd = conv_desc(2 * ((jstep >> 1) * 2048 + id) + (jstep & 1), a, F.ws);
#pragma unroll
                for (int kk = 0; kk < 32; ++kk) cv[kk] = cd.src[(size_t)kk * cd.ld + lane];
                if (cd.scale) csc = cd.scale[lane & 31]; }
            const f32x16 zz = {0.f, 0.f, 0.f, 0.f, 0.f, 0.f, 0.f, 0.f, 0.f, 0.f, 0.f, 0.f, 0.f, 0.f, 0.f, 0.f};
            f32x16 bu0 = __builtin_amdgcn_mfma_f32_32x32x16_bf16(Ua, Bf[0], zz, 0, 0, 0);
            f32x16 bu1 = __builtin_amdgcn_mfma_f32_32x32x16_bf16(Ua, Bf[1], zz, 0, 0, 0);
            f32x16 bu2 = __builtin_amdgcn_mfma_f32_32x32x16_bf16(Ua, Bf[2], zz, 0, 0, 0);
            f32x16 bu3 = __builtin_amdgcn_mfma_f32_32x32x16_bf16(Ua, Bf[3], zz, 0, 0, 0);
            scan_tile<PASS>(bu0, bu2, c0, R0r, R0i, hf);
            scan_tile<PASS>(bu1, bu3, c1, R1r, R1i, hf);
            if (PASS == 2) {
                LAS unsigned* sw = (LAS unsigned*)sl;
#pragma unroll
                for (int q = 0; q < 16; ++q) { sw[(16 * hf + q) * 68 + col] = cvt_pk_bf16(bu0[q], bu2[q]); sw[(16 * hf + q) * 68 + 32 + col] = cvt_pk_bf16(bu1[q], bu3[q]); }
                asm volatile("s_waitcnt lgkmcnt(0)" ::: "memory");
#pragma unroll
                for (int mt = 0; mt < 2; ++mt) {
                    f32x4 y = {0.f, 0.f, 0.f, 0.f};
#pragma unroll
                    for (int kb = 0; kb < 4; ++kb) { const bf16x8 Af = *(const LAS bf16x8*)(sl + ((16 * mt + (lane & 15)) * 68 + kb * 16 + 4 * (lane >> 4)) * 4);
                        y = __builtin_amdgcn_mfma_f32_16x16x32_bf16(Af, Cf[kb], y, 0, 0, 0); }
                    y = __builtin_amdgcn_mfma_f32_16x16x32_bf16(A2[mt], Df, y, 0, 0, 0);
#pragma unroll
                    for (int j = 0; j < 4; ++j) ys[(size_t)(t0 + 16 * mt + 4 * (lane >> 4) + j) * SW + g * NH + (lane & 15)] = (bf16_t)(cvt_pk_bf16(fgelu_tanh(y[j]), 0.f) & 0xffffu);
                }
                asm volatile("s_waitcnt lgkmcnt(0)" ::: "memory");
            }
            if (has_cv) conv_finish(cv, cd, csc, cscr, lane);
        }
        if (PASS == 1 && hf == 0) {
            *(float2*)(E + ((size_t)(r * NG + g) * NS + col) * 2) = make_float2(R0r, R0i);
            *(float2*)(E + ((size_t)(r * NG + g) * NS + 32 + col) * 2) = make_float2(R1r, R1i);
        }
    }
}

__device__ __forceinline__ void p6_route(const Frame& F, const Args& a) {
    const bf16_t* x1b = (const bf16_t*)(F.ws + WS_X1B); const bf16_t* wrt = (const bf16_t*)(F.ws + WS_WRT); float* rstd2 = (float*)(F.ws + WS_RSTD2);
    int* cnt = (int*)(F.ctl + CW_CNT); int* list = (int*)(F.ws + WS_LIST);
    int* tok_e = (int*)(F.ws + WS_TOK); int* tok_pos = tok_e + 2 * T; float* tok_w = (float*)(tok_pos + 2 * T);
    volatile LAS int* lcnt = (volatile LAS int*)(F.MISC + 96); volatile LAS int* lbase = (volatile LAS int*)(F.MISC + 128);
    constexpr int WP = 2064;
    LAS unsigned char* wl = F.lds;
    LAS float* lg = (LAS float*)(F.lds + 102400 + (F.wave & 3) * 4096);
    const int lane = F.lane; const bool active = F.wave < 4;
    { u32x4 t[12];
#pragma unroll
      for (int q = 0; q < 12; ++q) { const int p = F.tid + 512 * q; t[q] = *(const u32x4*)(wrt + (size_t)(p >> 7) * D + (p & 127) * 8); }
#pragma unroll
      for (int q = 0; q < 12; ++q) { const int p = F.tid + 512 * q; *(LAS u32x4*)(wl + (p >> 7) * WP + (p & 127) * 16) = t[q]; } }
    for (int blk = blockIdx.x; blk < T / 64; blk += F.G) {
        if (F.tid < 32) lcnt[F.tid] = 0;
        __syncthreads();
        const int tok0 = blk * 64 + (F.wave & 3) * 16;
        int e1 = 0, e2 = 0, rk1 = 0, rk2 = 0; float wt1 = 0.f, wt2 = 0.f;
        if (active) {
            f32x4 acc[3]; float ssq = 0.f;
#pragma unroll
            for (int n = 0; n < 3; ++n) acc[n] = (f32x4){0.f, 0.f, 0.f, 0.f};
            const bf16_t* arow = x1b + (size_t)(tok0 + (lane & 15)) * D + 8 * (lane >> 4);
            const LAS unsigned char* brow = wl + (lane & 15) * WP + 16 * (lane >> 4);
#pragma unroll 8
            for (int kb = 0; kb < 32; ++kb) {
                const u32x4 aw = *(const u32x4*)(arow + kb * 32);
                f32x4 p, q; unpack8(aw, p, q); ssq += (p[0] * p[0] + p[1] * p[1]) + (p[2] * p[2] + p[3] * p[3]) + (q[0] * q[0] + q[1] * q[1]) + (q[2] * q[2] + q[3] * q[3]);
                const bf16x8 Af = __builtin_bit_cast(bf16x8, aw);
#pragma unroll
                for (int n = 0; n < 3; ++n) { const bf16x8 Bfr = *(const LAS bf16x8*)(brow + n * 16 * WP + kb * 64);
                    acc[n] = __builtin_amdgcn_mfma_f32_16x16x32_bf16(Af, Bfr, acc[n], 0, 0, 0); }
            }
            ssq += __shfl_xor(ssq, 16); ssq += __shfl_xor(ssq, 32);
            const float rs = rsqrtf(ssq * (1.f / D) + EPS);
#pragma unroll
            for (int n = 0; n < 3; ++n)
#pragma unroll
                for (int j = 0; j < 4; ++j) lg[(4 * (lane >> 4) + j) * 52 + n * 16 + (lane & 15)] = acc[n][j];
            asm volatile("s_waitcnt lgkmcnt(0)" ::: "memory");
            if (lane < 16) {
                const LAS float* my = lg + lane * 52;
                float l0 = my[0] * rs + a.in[20][0], l1 = my[1] * rs + a.in[20][1], l2 = my[2] * rs + a.in[20][2], l3 = my[3] * rs + a.in[20][3];
                int gi = 0; float lmax = l0;
                if (l1 > lmax) { lmax = l1; gi = 1; } if (l2 > lmax) { lmax = l2; gi = 2; } if (l3 > lmax) { lmax = l3; gi = 3; }
                const float se = __expf(l0 - lmax) + __expf(l1 - lmax) + __expf(l2 - lmax) + __expf(l3 - lmax);
                const float pg = 1.f / se;
                float v1 = -3.0e38f, v2 = -3.0e38f; int i1 = 0, i2 = 0;
#pragma unroll
                for (int j = 0; j < 8; ++j) { const float vv = my[4 + gi * 8 + j] * rs + a.in[22][gi * 8 + j];
                    if (vv > v1) { v2 = v1; i2 = i1; v1 = vv; i1 = j; } else if (vv > v2) { v2 = vv; i2 = j; } }
                const float w1 = 1.f / (1.f + __expf(v2 - v1));
                e1 = gi * 8 + i1; e2 = gi * 8 + i2; wt1 = pg * w1; wt2 = pg * (1.f - w1);
                rk1 = __hip_atomic_fetch_add((LAS int*)&lcnt[e1], 1, __ATOMIC_RELAXED, __HIP_MEMORY_SCOPE_WORKGROUP);
                rk2 = __hip_atomic_fetch_add((LAS int*)&lcnt[e2], 1, __ATOMIC_RELAXED, __HIP_MEMORY_SCOPE_WORKGROUP);
                rstd2[tok0 + lane] = rs;
            }
        }
        __syncthreads();
        if (F.tid < 32) { const int c = lcnt[F.tid]; lbase[F.tid] = c ? __hip_atomic_fetch_add(&cnt[F.tid], c, __ATOMIC_RELAXED, __HIP_MEMORY_SCOPE_AGENT) : 0; }
        __syncthreads();
        if (active && lane < 16) { const int t = tok0 + lane; const int p1 = lbase[e1] + rk1, p2 = lbase[e2] + rk2;
            list[e1 * T + p1] = t; list[e2 * T + p2] = t;
            tok_e[2 * t] = e1; tok_e[2 * t + 1] = e2; tok_pos[2 * t] = p1; tok_pos[2 * t + 1] = p2; tok_w[2 * t] = wt1; tok_w[2 * t + 1] = wt2; }
        __syncthreads();
    }
}
__device__ __forceinline__ void tr64q(const float* __restrict__ src, int ld, int col0, int k0, const float* __restrict__ scale, float mul, unsigned char* __restrict__ dst, size_t drow0, int Kdst, LAS unsigned char* scr, int lane) {
    const float* s = src + (size_t)k0 * ld + col0 + lane;
#pragma unroll
    for (int hh = 0; hh < 2; ++hh) {
        float v[32];
#pragma unroll
        for (int kk = 0; kk < 32; ++kk) v[kk] = s[(size_t)(32 * hh + kk) * ld];
        if (scale) {
#pragma unroll
            for (int kk = 0; kk < 32; ++kk) v[kk] *= scale[k0 + 32 * hh + kk];
        }
#pragma unroll
        for (int c = 0; c < 2; ++c) { u32x4 o;
            o.x = cvt4_fp8(v[16 * c + 0] * mul, v[16 * c + 1] * mul, v[16 * c + 2] * mul, v[16 * c + 3] * mul); o.y = cvt4_fp8(v[16 * c + 4] * mul, v[16 * c + 5] * mul, v[16 * c + 6] * mul, v[16 * c + 7] * mul);
            o.z = cvt4_fp8(v[16 * c + 8] * mul, v[16 * c + 9] * mul, v[16 * c + 10] * mul, v[16 * c + 11] * mul); o.w = cvt4_fp8(v[16 * c + 12] * mul, v[16 * c + 13] * mul, v[16 * c + 14] * mul, v[16 * c + 15] * mul);
            *(LAS u32x4*)(scr + lane * 80 + 16 * (2 * hh + c)) = o; }
        asm volatile("s_waitcnt vmcnt(0)" ::: "memory");
    }
    asm volatile("s_waitcnt lgkmcnt(0)" ::: "memory");
#pragma unroll
    for (int j = 0; j < 4; ++j) { const int row = 16 * j + (lane >> 2); const u32x4 o = *(const LAS u32x4*)(scr + row * 80 + 16 * (lane & 3));
        *(u32x4*)(dst + (drow0 + row) * (size_t)Kdst + k0 + 16 * (lane & 3)) = o; }
    asm volatile("s_waitcnt lgkmcnt(0)" ::: "memory");
}
__device__ __forceinline__ void p6_convert(const Frame& F, const Args& a, int lo, int hi, int widx, int nwork) {
    LAS unsigned char* scr = F.lds + F.wave * 16384;
    unsigned char* Wgu_q = F.ws + WS_WGU; unsigned char* Wd_q = F.ws + WS_WD;
    constexpr int I_GU = NE * 16 * 16;
    for (int it = lo + widx; it < hi; it += nwork) {
        if (it < I_GU) { const int e = it / 256, r = it % 256, kb = r / 16, nb = r % 16, j0 = 64 * nb, pn = j0 >> 8, i = j0 & 255;
            tr64q((i < 128 ? a.in[23] : a.in[24]) + (size_t)e * D * EFF, EFF, 128 * pn + (i & 127), 64 * kb, a.in[18], 32.f, Wgu_q, (size_t)e * 1024 + j0, D, scr, F.lane); }
        else { const int q = it - I_GU, e = q / 128, r = q % 128, kb = r / 16, nb = r % 16;
            tr64q(a.in[25] + (size_t)e * EFF * D, D, 64 * nb, 64 * kb, nullptr, 16.f, Wd_q, (size_t)e * 1024 + 64 * nb, EFF, scr, F.lane); }
    }
}
__device__ __forceinline__ void load_tb(const Frame& F) {
    volatile LAS int* tb = (volatile LAS int*)(F.MISC + 16); volatile LAS int* lc = (volatile LAS int*)(F.MISC + 64);
    if (F.tid < 32) lc[F.tid] = (int)__hip_atomic_load(F.ctl + CW_CNT + F.tid, __ATOMIC_RELAXED, __HIP_MEMORY_SCOPE_AGENT);
    __syncthreads();
    if (F.tid == 0) { int s = 0; for (int e = 0; e < 32; ++e) { tb[e] = s; s += (lc[e] + 255) >> 8; } tb[32] = s; }
    __syncthreads();
}
__device__ __forceinline__ void p9_final(const Frame& F, const Args& a) {
    const LAS int* tb = (const LAS int*)(F.MISC + 16);
    const int* tok_e = (const int*)(F.ws + WS_TOK); const int* tok_pos = tok_e + 2 * T; const float* tok_w = (const float*)(tok_pos + 2 * T);
    const bf16_t* Y = (const bf16_t*)(F.ws + WS_Y); const bf16_t* x1b = (const bf16_t*)(F.ws + WS_X1B); const float* gf = a.in[26]; float* out = a.out;
    const int gw = blockIdx.x * 8 + F.wave, NGW = F.G * 8;
    for (int tq = 2 * gw; tq < T; tq += 2 * NGW) {
        int s1[2], s2[2]; float w1[2], w2[2];
#pragma unroll
        for (int q = 0; q < 2; ++q) { const int t = tq + q; s1[q] = 256 * tb[tok_e[2 * t]] + tok_pos[2 * t]; s2[q] = 256 * tb[tok_e[2 * t + 1]] + tok_pos[2 * t + 1]; w1[q] = tok_w[2 * t]; w2[q] = tok_w[2 * t + 1]; }
        u32x4 xw[2][2], y1[2][2], y2[2][2];
#pragma unroll
        for (int q = 0; q < 2; ++q)
#pragma unroll
            for (int j = 0; j < 2; ++j) { const int c = 8 * F.lane + 512 * j; xw[q][j] = *(const u32x4*)(x1b + (size_t)(tq + q) * D + c);
                y1[q][j] = *(const u32x4*)(Y + (size_t)s1[q] * D + c); y2[q][j] = *(const u32x4*)(Y + (size_t)s2[q] * D + c); }
        f32x4 va[2][2], vb[2][2]; float ss[2];
#pragma unroll
        for (int q = 0; q < 2; ++q) { ss[q] = 0.f;
#pragma unroll
            for (int j = 0; j < 2; ++j) { f32x4 xa, xb_, ya, yb, za, zb; unpack8(xw[q][j], xa, xb_); unpack8(y1[q][j], ya, yb); unpack8(y2[q][j], za, zb);
                va[q][j] = xa + w1[q] * ya + w2[q] * za; vb[q][j] = xb_ + w1[q] * yb + w2[q] * zb;
                ss[q] += (va[q][j][0] * va[q][j][0] + va[q][j][1] * va[q][j][1]) + (va[q][j][2] * va[q][j][2] + va[q][j][3] * va[q][j][3]) + (vb[q][j][0] * vb[q][j][0] + vb[q][j][1] * vb[q][j][1]) + (vb[q][j][2] * vb[q][j][2] + vb[q][j][3] * vb[q][j][3]); } }
#pragma unroll
        for (int o = 1; o < 64; o <<= 1) { ss[0] += __shfl_xor(ss[0], o); ss[1] += __shfl_xor(ss[1], o); }
#pragma unroll
        for (int q = 0; q < 2; ++q) { const float rs = rsqrtf(ss[q] * (1.f / D) + EPS);
#pragma unroll
            for (int j = 0; j < 2; ++j) { const int c = 8 * F.lane + 512 * j;
                *(f32x4*)(out + (size_t)(tq + q) * D + c) = va[q][j] * rs * *(const f32x4*)(gf + c); *(f32x4*)(out + (size_t)(tq + q) * D + c + 4) = vb[q][j] * rs * *(const f32x4*)(gf + c + 4); } }
        asm volatile("s_waitcnt vmcnt(8)" ::: "memory");
    }
}

__global__ void __launch_bounds__(512, 2) mega_fwd(Args args) {
    extern __shared__ __attribute__((aligned(16))) unsigned char lds_raw[];
    Frame F;
    F.lds = (LAS unsigned char*)lds_raw; F.MISC = (volatile LAS unsigned*)(F.lds + MISC_OFF);
    F.tid = threadIdx.x; F.lane = F.tid & 63; F.wave = __builtin_amdgcn_readfirstlane(F.tid >> 6); F.G = gridDim.x;
    F.ws = args.ws; F.ctl = (unsigned*)(args.ws + WS_CTL);
    for (int u = F.tid; u < (LDS_BYTES - MISC_OFF) / 4; u += 512) ((LAS unsigned*)(F.lds + MISC_OFF))[u] = 0u;
    __syncthreads();
    XcdBarrier bar; bar.bar = F.ctl + CW_BAR; bar.x = 0; bar.st = nullptr;
    if (args.use_bar) bar = xcd_barrier_post(F.ctl + CW_BAR, F.MISC + 0);
    const int lo = args.ph_lo, hi = args.ph_hi;
#define IN(k) (lo <= (k) && (k) < hi)
#define SEAM(k) do { if (IN(k) && IN((k) + 1)) xcd_barrier(bar); } while (0)
    unsigned char* ws = args.ws;
    const int c = (int)blockIdx.x;

    if (IN(0)) { p0_prologue(F, args); }
    SEAM(0);
    if (IN(1)) {
        pg8::DenseOrder S{(const char*)(ws + WS_XB), (const char*)(ws + WS_WIN), D, T / 256, INC / 256, 1, F.G, c};
        EpiWin E{(const float*)(ws + WS_RSTD1), (bf16_t*)(ws + WS_V), (bf16_t*)(ws + WS_BG), (bf16_t*)(ws + WS_UB), (bf16_t*)(ws + WS_GATES), args.in[16]};
        pg8::gemm_phase<EpiWin, pg8::DenseOrder, false, true>(F.lds, D, S, E);
        { const int nu = (T / 256) * (INC / 256), rem = nu % F.G; if (rem != 0 && c >= rem) p6_convert(F, args, 0, CV_EARLY, (c - rem) * 8 + F.wave, (F.G - rem) * 8); }
    }
    SEAM(1);
    if (IN(2)) { p2_conv(F, args); ssm_pass<1>(F, args); }
    SEAM(2);
    if (IN(3)) { ssm_pass<2>(F, args); }
    SEAM(3);
    if (IN(4)) {
        { pg8::DenseOrder S{(const char*)(ws + WS_YS), (const char*)(ws + WS_WGLU), SW, T / 256, 4, 2, F.G, c};
          EpiGlu E{(const bf16_t*)(ws + WS_GATES), (bf16_t*)(ws + WS_MB)};
          pg8::gemm_phase<EpiGlu, pg8::DenseOrder, false, true>(F.lds, SW, S, E); }
        asm volatile("s_waitcnt vmcnt(0)" ::: "memory"); __syncthreads();
        { pg8::DenseOrder S{(const char*)(ws + WS_Z), (const char*)(ws + WS_WC), D, T / 256, 4, 1, F.G, c};
          EpiMix E{(const bf16_t*)(ws + WS_GATES), (const bf16_t*)(ws + WS_MB), (bf16_t*)(ws + WS_MIXED)};
          pg8::gemm_phase<EpiMix, pg8::DenseOrder, false, true>(F.lds, D, S, E); }
    }
    SEAM(4);
    if (IN(5)) {
        pg8::DenseOrder S{(const char*)(ws + WS_MIXED), (const char*)(ws + WS_WO), D, T / 256, 4, 1, F.G, c};
        EpiX1 E{args.in[0], args.out, (bf16_t*)(ws + WS_X1B), ws + WS_X1Q};
        pg8::gemm_phase<EpiX1, pg8::DenseOrder, false, true>(F.lds, D, S, E);
    }
    SEAM(5);
    if (IN(6)) { p6_route(F, args); { const int nu = (T / 256) * (INC / 256), rem = nu % F.G; p6_convert(F, args, rem != 0 ? CV_EARLY : 0, NE * 256 + NE * 128, blockIdx.x * 8 + F.wave, F.G * 8); } }
    SEAM(6);
    if (IN(7)) {
        load_tb(F);
        pg8::MoEOrder S{(const LAS int*)(F.MISC + 16), (const LAS int*)(F.MISC + 64), (const int*)(ws + WS_LIST), (const char*)(ws + WS_X1Q), (const char*)(ws + WS_WGU), D / 2, (size_t)1024 * D, F.G, c, true, (const char*)(ws + WS_WGU), 64};
        EpiUp E{(const int*)(ws + WS_LIST), (const float*)(ws + WS_RSTD2), ws + WS_HMID};
        pg8::gemm_phase<EpiUp, pg8::MoEOrder, true, true, true>(F.lds, D / 2, S, E);
    }
    SEAM(7);
    if (IN(8)) {
        load_tb(F);
        pg8::MoEOrder S{(const LAS int*)(F.MISC + 16), (const LAS int*)(F.MISC + 64), (const int*)(ws + WS_LIST), (const char*)(ws + WS_HMID), (const char*)(ws + WS_WD), EFF / 2, (size_t)1024 * EFF, F.G, c, false, (const char*)(ws + WS_WD2), WD_SPLIT};
        EpiDown E{(bf16_t*)(ws + WS_Y)};
        pg8::gemm_phase<EpiDown, pg8::MoEOrder, false, true, true>(F.lds, EFF / 2, S, E);
    }
    SEAM(8);
    if (IN(9)) { load_tb(F); p9_final(F, args); }
#undef IN
#undef SEAM
}

#ifndef MK_MODE
#define MK_MODE 2
#endif
extern "C" void kernel_launch(void* const* d_in, const int* in_sizes, int n_in, void* d_out, int out_size, void* d_ws, size_t ws_size, hipStream_t stream) {
    static int grid = 0;
    if (grid == 0) {
        if (ws_size < WS_END) { fprintf(stderr, "kernel_launch: workspace too small (%zu < %zu)\n", ws_size, (size_t)WS_END); grid = -1; return; }
        int dev = 0, cus = 0, per_cu = 0;
        (void)hipGetDevice(&dev); (void)hipDeviceGetAttribute(&cus, hipDeviceAttributeMultiprocessorCount, dev);
        (void)hipFuncSetAttribute((const void*)mega_fwd, hipFuncAttributeMaxDynamicSharedMemorySize, LDS_BYTES);
        (void)hipOccupancyMaxActiveBlocksPerMultiprocessor(&per_cu, (const void*)mega_fwd, 512, LDS_BYTES);
        (void)hipGetLastError();
        grid = cus * (per_cu < 1 ? 1 : 1);
    }
    if (grid < 0) return;
    (void)hipMemsetAsync((char*)d_ws + WS_CTL, 0, CTL_BYTES, stream);
    Args a{};
    for (int i = 0; i < 27; ++i) a.in[i] = (const float*)d_in[i];
    a.out = (float*)d_out; a.ws = (unsigned char*)d_ws;
#if MK_MODE == 2
    a.ph_lo = 0; a.ph_hi = 10; a.use_bar = 1;
    hipLaunchKernelGGL(mega_fwd, dim3(grid), dim3(512), LDS_BYTES, stream, a);
#else
    const int nfast = (MK_MODE == 1) ? 6 : 10;
    for (int p = 0; p < nfast; ++p) { a.ph_lo = p; a.ph_hi = p + 1; a.use_bar = 0; hipLaunchKernelGGL(mega_fwd, dim3(grid), dim3(512), LDS_BYTES, stream, a); }
#if MK_MODE == 1
    {
        using namespace nv;
        float* out = (float*)d_out; char* ws = (char*)d_ws; const size_t MiB_ = 1u << 20;
        float* hbuf = (float*)(ws); float* B1 = (float*)(ws + 64 * MiB_); float* B2 = (float*)(ws + 128 * MiB_);
        char* misc = ws + 256 * MiB_;
        int* cnt = (int*)(misc + 2 * MiB_); int* off = cnt + 64; int* list = (int*)(misc + 2 * MiB_ + 4096);
        int* tok_e = (int*)(misc + 5 * MiB_); int* tok_pos = tok_e + 2 * nv::T; float* tok_w = (float*)(tok_pos + 2 * nv::T);
        const dim3 b256(256);
        const float* norm_ffn = (const float*)d_in[18]; const float* wrg = (const float*)d_in[19]; const float* brg = (const float*)d_in[20]; const float* wre = (const float*)d_in[21]; const float* bre = (const float*)d_in[22];
        const float* w_gate = (const float*)d_in[23]; const float* w_up = (const float*)d_in[24]; const float* w_down = (const float*)d_in[25]; const float* norm_final = (const float*)d_in[26];
        hipLaunchKernelGGL(k_rmsnorm, dim3(nv::T / 4), b256, 0, stream, out, norm_ffn, hbuf, nv::T);
        (void)hipMemsetAsync(cnt, 0, 512, stream);
        hipLaunchKernelGGL(k_route, dim3(nv::T / 4), b256, 0, stream, hbuf, wrg, brg, wre, bre, cnt, list, tok_e, tok_pos, tok_w);
        hipLaunchKernelGGL(k_offsets, dim3(1), dim3(64), 0, stream, cnt, off);
        float* Hm = B1; float* Yd = B2;
        for (int e = 0; e < nv::NE; ++e)
            hipLaunchKernelGGL(k_gemm<2>, dim3(nv::EFF / 64, nv::T / 64), b256, 0, stream, hbuf, nv::D, list + e * nv::T, nullptr, w_gate + (size_t)e * nv::D * nv::EFF, w_up + (size_t)e * nv::D * nv::EFF, nv::EFF,
                               Hm, nv::EFF, off + e, nullptr, 0, cnt + e, nv::EFF, nv::D);
        for (int e = 0; e < nv::NE; ++e)
            hipLaunchKernelGGL(k_gemm<0>, dim3(nv::D / 64, nv::T / 64), b256, 0, stream, Hm, nv::EFF, nullptr, off + e, w_down + (size_t)e * nv::EFF * nv::D, nullptr, nv::D,
                               Yd, nv::D, off + e, nullptr, 0, cnt + e, nv::D, nv::EFF);
        hipLaunchKernelGGL(k_final, dim3(nv::T / 4), b256, 0, stream, out, Yd, off, tok_e, tok_pos, tok_w, norm_final);
    }
#endif
#endif
}
```

```cpp
#define CV_EARLY_ITEMS 0
#include <hip/hip_runtime.h>
#include <stdint.h>
#include <cstdio>

namespace nv {
constexpr int T = 16384, D = 1024, SW = 512, NG = 32, NS = 64, NH = 16, INC = 5632, NE = 32, EFF = 512;
constexpr float EPS = 1e-6f;

__device__ __forceinline__ float wave_sum(float v) {
#pragma unroll
    for (int o = 1; o < 64; o <<= 1) v += __shfl_xor(v, o);
    return v;
}
__device__ __forceinline__ float sigmoidf_(float x) { return 1.f / (1.f + __expf(-x)); }
__device__ __forceinline__ float gelu_tanh(float x) { const float u = 0.7978845608028654f * (x + 0.044715f * x * x * x); return 0.5f * x * (1.f + tanhf(u)); }

__global__ __launch_bounds__(256) void k_rmsnorm(const float* x, const float* g, float* y, int rows) {
    const int row = blockIdx.x * 4 + (threadIdx.x >> 6), lane = threadIdx.x & 63;
    if (row >= rows) return;
    const float4* xr = (const float4*)(x + (size_t)row * D);
    float4 v[4]; float s = 0.f;
#pragma unroll
    for (int j = 0; j < 4; ++j) { v[j] = xr[lane + 64 * j]; s += v[j].x * v[j].x + v[j].y * v[j].y + v[j].z * v[j].z + v[j].w * v[j].w; }
    const float r = rsqrtf(wave_sum(s) * (1.f / D) + EPS);
    float4* yr = (float4*)(y + (size_t)row * D);
#pragma unroll
    for (int j = 0; j < 4; ++j) { const float4 gg = ((const float4*)g)[lane + 64 * j]; yr[lane + 64 * j] = make_float4(v[j].x * r * gg.x, v[j].y * r * gg.y, v[j].z * r * gg.z, v[j].w * r * gg.w); }
}

template <int MODE>
__global__ __launch_bounds__(256) void k_gemm(const float* A, int lda, const int* gather, const int* aoff_dev, const float* B, const float* B2, int ldb,
                                              float* C, int ldc, const int* coff_dev, const float* resid, int M, const int* Mdev, int N, int K) {
    __shared__ float As[16][68];
    __shared__ float Bs[16][64];
    __shared__ float Bs2[16][64];
    if (Mdev) M = *Mdev;
    const int row0 = blockIdx.y * 64, col0 = blockIdx.x * 64;
    if (row0 >= M) return;
    const int aoff = aoff_dev ? *aoff_dev : 0, coff = coff_dev ? *coff_dev : 0;
    const int tid = threadIdx.x, ty = tid >> 4, tx = tid & 15;
    const int lr = tid >> 2, lk = (tid & 3) * 4;
    const int bk = tid >> 4, bn = (tid & 15) * 4;
    int arow = -1;
    if (row0 + lr < M) arow = gather ? gather[row0 + lr] : (aoff + row0 + lr);
    float acc[4][4] = {}, acc2[4][4] = {};
    for (int k0 = 0; k0 < K; k0 += 16) {
        float4 av = make_float4(0.f, 0.f, 0.f, 0.f);
        if (arow >= 0) av = *(const float4*)(A + (size_t)arow * lda + k0 + lk);
        As[lk + 0][lr] = av.x; As[lk + 1][lr] = av.y; As[lk + 2][lr] = av.z; As[lk + 3][lr] = av.w;
        *(float4*)&Bs[bk][bn] = *(const float4*)(B + (size_t)(k0 + bk) * ldb + col0 + bn);
        if (MODE >= 2) *(float4*)&Bs2[bk][bn] = *(const float4*)(B2 + (size_t)(k0 + bk) * ldb + col0 + bn);
        __syncthreads();
#pragma unroll
        for (int k = 0; k < 16; ++k) {
            const float4 a = *(const float4*)&As[k][ty * 4];
            const float4 b = *(const float4*)&Bs[k][tx * 4];
            const float aa[4] = {a.x, a.y, a.z, a.w}, bb[4] = {b.x, b.y, b.z, b.w};
#pragma unroll
            for (int i = 0; i < 4; ++i)
#pragma unroll
                for (int j = 0; j < 4; ++j) acc[i][j] += aa[i] * bb[j];
            if (MODE >= 2) {
                const float4 b2 = *(const float4*)&Bs2[k][tx * 4]; const float cc[4] = {b2.x, b2.y, b2.z, b2.w};
#pragma unroll
                for (int i = 0; i < 4; ++i)
#pragma unroll
                    for (int j = 0; j < 4; ++j) acc2[i][j] += aa[i] * cc[j];
            }
        }
        __syncthreads();
    }
#pragma unroll
    for (int i = 0; i < 4; ++i) {
        const int r = row0 + ty * 4 + i;
        if (r >= M) continue;
        float o[4];
#pragma unroll
        for (int j = 0; j < 4; ++j) {
            float v = acc[i][j];
            if (MODE == 2) v = (v * sigmoidf_(v)) * acc2[i][j];
            if (MODE == 3) v = v * sigmoidf_(acc2[i][j]);
            o[j] = v;
        }
        const size_t ci = (size_t)(coff + r) * ldc + col0 + tx * 4;
        if (MODE == 1) { const float4 rr = *(const float4*)(resid + ci); o[0] += rr.x; o[1] += rr.y; o[2] += rr.z; o[3] += rr.w; }
        *(float4*)(C + ci) = make_float4(o[0], o[1], o[2], o[3]);
    }
}

__global__ __launch_bounds__(256) void k_conv(const float* xc, const float* cg, float* bg_z, const float* cw, const float* cb) {
    const size_t i = (size_t)blockIdx.x * 256 + threadIdx.x;
    const int t = (int)(i / D), c = (int)(i % D);
    float y = cb[c] + cw[2 * D + c] * (cg[i] * xc[i]);
    if (t >= 1) y += cw[1 * D + c] * (cg[i - D] * xc[i - D]);
    if (t >= 2) y += cw[0 * D + c] * (cg[i - 2 * D] * xc[i - 2 * D]);
    bg_z[i] = bg_z[i] * y;
}

struct cplx { float re, im; };
__device__ __forceinline__ cplx cmul(cplx a, cplx b) { return {a.re * b.re - a.im * b.im, a.re * b.im + a.im * b.re}; }

__device__ __forceinline__ void ssm_consts(const float* a_re, const float* a_im, const float* log_dt, int g, int n, cplx& abar, cplx& coef, cplx& a256) {
    const double lr = a_re[g * NS + n], li = a_im[g * NS + n], dt = exp((double)log_dt[g]);
    const double er = exp(lr * dt), cr = er * cos(li * dt), ci = er * sin(li * dt);
    abar = {(float)cr, (float)ci};
    const double nr = cr - 1.0, ni = ci, den = lr * lr + li * li;
    coef = {(float)((nr * lr + ni * li) / den), (float)((ni * lr - nr * li) / den)};
    const double e2 = exp(lr * dt * 256.0);
    a256 = {(float)(e2 * cos(li * dt * 256.0)), (float)(e2 * sin(li * dt * 256.0))};
}

template <int PASS>
__global__ __launch_bounds__(64) void k_ssm(const float* u, const float* a_re, const float* a_im, const float* log_dt, const float* b_re, const float* b_im,
                                            const float* c_re, const float* c_im, const float* dsk, float* E, const float* Cin, float* ys) {
    __shared__ float part[16][65];
    const int g = blockIdx.x, r = blockIdx.y, n = threadIdx.x;
    cplx abar, coef, a256; ssm_consts(a_re, a_im, log_dt, g, n, abar, coef, a256);
    cplx bb[16]; float cre[16], cim[16];
#pragma unroll
    for (int h = 0; h < 16; ++h) {
        bb[h] = cmul(coef, cplx{b_re[(g * NS + n) * NH + h], b_im[(g * NS + n) * NH + h]});
        cre[h] = c_re[(g * NH + h) * NS + n]; cim[h] = c_im[(g * NH + h) * NS + n];
    }
    cplx s = {0.f, 0.f};
    if (PASS == 2) s = {Cin[((size_t)(r * NG + g) * NS + n) * 2], Cin[((size_t)(r * NG + g) * NS + n) * 2 + 1]};
    for (int t = r * 256; t < r * 256 + 256; ++t) {
        const float* ut = u + (size_t)t * SW + g * NH;
        cplx bu = {0.f, 0.f};
#pragma unroll
        for (int h = 0; h < 16; ++h) { const float uv = ut[h]; bu.re += bb[h].re * uv; bu.im += bb[h].im * uv; }
        s = cmul(abar, s); s.re += bu.re; s.im += bu.im;
        if (PASS == 2) {
#pragma unroll
            for (int h = 0; h < 16; ++h) part[h][n] = cre[h] * s.re - cim[h] * s.im;
            __syncthreads();
            const int h = n & 15, q = n >> 4; float y = 0.f;
#pragma unroll
            for (int j = 0; j < 16; ++j) y += part[h][q * 16 + j];
            y += __shfl_xor(y, 16); y += __shfl_xor(y, 32);
            if (q == 0) { const float v = y + dsk[g * NH + h] * ut[h]; ys[(size_t)t * SW + g * NH + h] = gelu_tanh(v); }
            __syncthreads();
        }
    }
    if (PASS == 1) { E[((size_t)(r * NG + g) * NS + n) * 2] = s.re; E[((size_t)(r * NG + g) * NS + n) * 2 + 1] = s.im; }
}
__global__ __launch_bounds__(64) void k_ssm_carry(const float* a_re, const float* a_im, const float* log_dt, const float* E, float* Cin) {
    const int g = blockIdx.x, n = threadIdx.x;
    cplx abar, coef, a256; ssm_consts(a_re, a_im, log_dt, g, n, abar, coef, a256);
    cplx run = {0.f, 0.f};
    for (int r = 0; r < T / 256; ++r) {
        const size_t i = ((size_t)(r * NG + g) * NS + n) * 2;
        Cin[i] = run.re; Cin[i + 1] = run.im;
        run = cmul(a256, run); run.re += E[i]; run.im += E[i + 1];
    }
}

template <int ADD>
__global__ __launch_bounds__(256) void k_mix(const float* gl, const float* bias, const float* y, float* m) {
    const size_t i = (size_t)blockIdx.x * 256 + threadIdx.x; const int c = (int)(i % D);
    const float v = sigmoidf_(gl[i] + bias[c]) * y[i];
    m[i] = ADD ? m[i] + v : v;
}

__global__ __launch_bounds__(256) void k_route(const float* h2, const float* wrg, const float* brg, const float* wre, const float* bre,
                                               int* cnt, int* list, int* tok_e, int* tok_pos, float* tok_w) {
    const int t = blockIdx.x * 4 + (threadIdx.x >> 6), lane = threadIdx.x & 63;
    float acc[36];
#pragma unroll
    for (int j = 0; j < 36; ++j) acc[j] = 0.f;
    for (int k = lane; k < D; k += 64) {
        const float hv = h2[(size_t)t * D + k];
#pragma unroll
        for (int j = 0; j < 4; ++j) acc[j] += hv * wrg[k * 4 + j];
#pragma unroll
        for (int j = 0; j < 32; ++j) acc[4 + j] += hv * wre[k * 32 + j];
    }
#pragma unroll
    for (int j = 0; j < 36; ++j) acc[j] = wave_sum(acc[j]);
    if (lane == 0) {
        float lg[4]; int gi = 0; float lmax;
#pragma unroll
        for (int j = 0; j < 4; ++j) { lg[j] = acc[j] + brg[j]; }
        lmax = lg[0];
#pragma unroll
        for (int j = 1; j < 4; ++j) if (lg[j] > lmax) { lmax = lg[j]; gi = j; }
        float se = 0.f;
#pragma unroll
        for (int j = 0; j < 4; ++j) se += __expf(lg[j] - lmax);
        const float pg = 1.f / se;
        float v1 = -3.0e38f, v2 = -3.0e38f; int i1 = 0, i2 = 0;
#pragma unroll
        for (int j = 0; j < 8; ++j) { float v = 0.f;
#pragma unroll
            for (int q = 0; q < 4; ++q) if (q == gi) v = acc[4 + q * 8 + j] + bre[q * 8 + j];
            if (v > v1) { v2 = v1; i2 = i1; v1 = v; i1 = j; } else if (v > v2) { v2 = v; i2 = j; } }
        const float w1 = 1.f / (1.f + __expf(v2 - v1)), w2 = 1.f - w1;
        const int e1 = gi * 8 + i1, e2 = gi * 8 + i2;
        const int p1 = atomicAdd(&cnt[e1], 1), p2 = atomicAdd(&cnt[e2], 1);
        list[e1 * T + p1] = t; list[e2 * T + p2] = t;
        tok_e[t * 2] = e1; tok_e[t * 2 + 1] = e2; tok_pos[t * 2] = p1; tok_pos[t * 2 + 1] = p2;
        tok_w[t * 2] = pg * w1; tok_w[t * 2 + 1] = pg * w2;
    }
}
__global__ void k_offsets(const int* cnt, int* off) { if (threadIdx.x == 0) { int s = 0; for (int e = 0; e < NE; ++e) { off[e] = s; s += cnt[e]; } } }

__global__ __launch_bounds__(256) void k_final(float* out, const float* Y, const int* off, const int* tok_e, const int* tok_pos, const float* tok_w, const float* g) {
    const int t = blockIdx.x * 4 + (threadIdx.x >> 6), lane = threadIdx.x & 63;
    const int s1 = off[tok_e[t * 2]] + tok_pos[t * 2], s2 = off[tok_e[t * 2 + 1]] + tok_pos[t * 2 + 1];
    const float w1 = tok_w[t * 2], w2 = tok_w[t * 2 + 1];
    float4* xr = (float4*)(out + (size_t)t * D);
    const float4* y1 = (const float4*)(Y + (size_t)s1 * D); const float4* y2 = (const float4*)(Y + (size_t)s2 * D);
    float4 v[4]; float s = 0.f;
#pragma unroll
    for (int j = 0; j < 4; ++j) { const float4 a = xr[lane + 64 * j], b = y1[lane + 64 * j], c = y2[lane + 64 * j];
        v[j] = make_float4(a.x + w1 * b.x + w2 * c.x, a.y + w1 * b.y + w2 * c.y, a.z + w1 * b.z + w2 * c.z, a.w + w1 * b.w + w2 * c.w);
        s += v[j].x * v[j].x + v[j].y * v[j].y + v[j].z * v[j].z + v[j].w * v[j].w; }
    const float r = rsqrtf(wave_sum(s) * (1.f / D) + EPS);
#pragma unroll
    for (int j = 0; j < 4; ++j) { const float4 gg = ((const float4*)g)[lane + 64 * j]; xr[lane + 64 * j] = make_float4(v[j].x * r * gg.x, v[j].y * r * gg.y, v[j].z * r * gg.z, v[j].w * r * gg.w); }
}
}

#define LAS __attribute__((address_space(3)))
typedef unsigned short bf16_t;
typedef short bf16x8 __attribute__((ext_vector_type(8)));
typedef float f32x4 __attribute__((ext_vector_type(4)));
typedef float f32x16 __attribute__((ext_vector_type(16)));
typedef unsigned u32x4 __attribute__((ext_vector_type(4)));
typedef unsigned u32x2 __attribute__((ext_vector_type(2)));

constexpr int T = 16384, D = 1024, SW = 512, NG = 32, NS = 64, NH = 16, INC = 5632, NE = 32, EFF = 512;
constexpr float EPS = 1e-6f;

typedef __bf16 bf16x2_t __attribute__((ext_vector_type(2)));
typedef float f32x2c_t __attribute__((ext_vector_type(2)));
__device__ __forceinline__ unsigned cvt_pk_bf16(float lo, float hi) { const f32x2c_t v = {lo, hi}; return __builtin_bit_cast(unsigned, __builtin_convertvector(v, bf16x2_t)); }
__device__ __forceinline__ unsigned cvt4_fp8(float a, float b, float c, float d) { int w = __builtin_amdgcn_cvt_pk_fp8_f32(a, b, 0, false); w = __builtin_amdgcn_cvt_pk_fp8_f32(c, d, w, true); return (unsigned)w; }
__device__ __forceinline__ float bf_lo(unsigned w) { return __uint_as_float(w << 16); }
__device__ __forceinline__ float bf_hi(unsigned w) { return __uint_as_float(w & 0xffff0000u); }
__device__ __forceinline__ float fsigmoid(float x) { return __builtin_amdgcn_rcpf(1.f + __builtin_amdgcn_exp2f(-1.4426950408889634f * x)); }
__device__ __forceinline__ float fsilu(float x) { return x * fsigmoid(x); }
__device__ __forceinline__ float fgelu_tanh(float x) { const float u = 0.7978845608028654f * (x + 0.044715f * x * x * x); return x * fsigmoid(2.f * u); }
__device__ __forceinline__ float wave_sum64(float v) {
#pragma unroll
    for (int o = 1; o < 64; o <<= 1) v += __shfl_xor(v, o);
    return v;
}

namespace pg8 {
constexpr int BM = 256, BK = 64, HALF = 128, HTB = HALF * BK * 2, STAGE_BYTES = 8 * HTB, NXCD = 8, WGM = 8;
__host__ __device__ __forceinline__ int lds_byte(int r, int c) { const int st = (r >> 4) * 2 + (c >> 5), rr = r & 15, cc = c & 31, ob = rr * 64 + cc * 2; return st * 1024 + (ob ^ (((ob >> 9) & 1) << 5)); }
__host__ __device__ __forceinline__ void stage_rc(int b, int& R, int& C) { const int st = b / 1024, sb = b % 1024, swz = sb ^ (((sb >> 9) & 1) << 5); R = (st >> 1) * 16 + swz / 64; C = (st & 1) * 32 + (swz % 64) / 2; }
__host__ __device__ __forceinline__ int perm32(int rho) { const int n = rho >> 4, i = rho & 15; return 8 * (i >> 2) + 4 * n + (i & 3); }

struct Unit { int pm, pn, e, nrow, srow; };

__device__ __forceinline__ void tile_map(int L, int nM, int nN, int& pm, int& pn) {
    const int nwg = nM * nN; int wgid = L;
    { const int q = nwg / NXCD, r = nwg % NXCD, xcd = wgid % NXCD, off = wgid / NXCD; wgid = (xcd < r ? xcd * (q + 1) : r * (q + 1) + (xcd - r) * q) + off; }
    const int nig = WGM * nN, gid = wgid / nig, fm = gid * WGM, gsz = (nM - fm) < WGM ? (nM - fm) : WGM;
    pm = fm + ((wgid % nig) % gsz); pn = (wgid % nig) / gsz;
}
struct DenseOrder {
    const char* A; const char* Bt; int K, nM, nNt, sub, G, c;
    __device__ __forceinline__ bool next(int i, Unit& u) const {
        const int L = (i / sub) * G + c; if (L >= nM * nNt) return false;
        int pm, pn; tile_map(L, nM, nNt, pm, pn); u.pm = pm; u.pn = pn * sub + (i % sub); u.e = 0; u.nrow = 256; u.srow = 0; return true;
    }
    __device__ __forceinline__ const char* a_base(const Unit& u) const { return A + (size_t)u.pm * (size_t)(BM * 2) * K; }
    __device__ __forceinline__ const char* b_base(const Unit& u) const { return Bt + (size_t)u.pn * (size_t)(BM * 2) * K; }
    __device__ __forceinline__ unsigned a_row(const Unit&, int r) const { return (unsigned)r; }
};
struct MoEOrder {
    const LAS int* tb; const LAS int* lc; const int* list; const char* A; const char* Bt; int K; size_t bstride; int G, c; bool gather; const char* Bt2; int esplit;
    __device__ __forceinline__ bool next(int i, Unit& u) const {
        const int L = i * G + c; const int ntile = tb[32]; if (L >= ntile * 4) return false;
        const int tt = L >> 2; int e = 0;
#pragma unroll 1
        for (int q = 1; q < 32; ++q) if (tb[q] <= tt) e = q;
        e = __builtin_amdgcn_readfirstlane(e);
        u.e = e; u.pm = tt - tb[e]; u.pn = L & 3; const int rem = lc[e] - 256 * u.pm; u.nrow = rem < 256 ? rem : 256; u.srow = 256 * tt; return true;
    }
    __device__ __forceinline__ const char* a_base(const Unit& u) const { return gather ? A : A + (size_t)u.srow * 2 * K; }
    __device__ __forceinline__ const char* b_base(const Unit& u) const { return (u.e < esplit ? Bt + (size_t)u.e * bstride : Bt2 + (size_t)(u.e - esplit) * bstride) + (size_t)u.pn * (size_t)(BM * 2) * K; }
    __device__ __forceinline__ unsigned a_row(const Unit& u, int r) const { return r < u.nrow ? (unsigned)list[u.e * T + 256 * u.pm + r] : 0u; }
};

typedef int v8i_t __attribute__((ext_vector_type(8)));
typedef int v4i_t __attribute__((ext_vector_type(4)));
__device__ __forceinline__ v8i_t cat8(const bf16x8 lo, const bf16x8 hi) { const v4i_t a = __builtin_bit_cast(v4i_t, lo), b = __builtin_bit_cast(v4i_t, hi); return __builtin_shufflevector(a, b, 0, 1, 2, 3, 4, 5, 6, 7); }
template <class Epi, class Sched, bool GATHER, bool ALIGN_EPI, bool FP8 = false>
__device__ __forceinline__ void gemm_phase(LAS unsigned char* lds, const int K, const Sched& S, const Epi& E) {
    const int tid = threadIdx.x, wid = __builtin_amdgcn_readfirstlane(tid >> 6), lane = tid & 63, wr = wid >> 2, wc = wid & 3, fr = lane & 15, fq = lane >> 4;
    const int nt = K / BK;
    unsigned voffB[2], vA[2][2], nvA[2][2]; int Rr[2], Cc[2];
#pragma unroll
    for (int i = 0; i < 2; ++i) { int R, C; stage_rc(tid * 16 + i * 8192, R, C); const int Rb = Epi::PERM ? ((R & ~31) + perm32(R & 31)) : R;
        Rr[i] = R; Cc[i] = C; voffB[i] = (unsigned)(Rb * K + C) * 2u; }
    const size_t kstep = (size_t)(BK * 2);
    const size_t hstep = (size_t)HALF * K * 2;
    const unsigned ldsw = (unsigned)wid * 1024u;
    const int aoff = lds_byte(wr * 64 + fr, fq * 8), boff = lds_byte(wc * 32 + fr, fq * 8);
#define PG8_SA(b, h) (((b) * 2 + (h)) * HTB)
#define PG8_SB(b, h) ((4 + (b) * 2 + (h)) * HTB)
#define PG8_STAGE(bufoff, gbase, voff) do { _Pragma("unroll") for (int _i = 0; _i < 2; ++_i) \
        __builtin_amdgcn_global_load_lds((const unsigned*)((const char*)(gbase) + (voff)[_i]), (LAS unsigned*)(lds + (bufoff) + ldsw + _i * 8192), 16, 0, 0); } while (0)
#define PG8_LDA(dst, b, h) do { if constexpr (FP8) { _Pragma("unroll") for (int m = 0; m < 4; ++m) dst##8[m] = cat8(*(const LAS bf16x8*)(lds + PG8_SA(b, h) + aoff + m * 2048), *(const LAS bf16x8*)(lds + PG8_SA(b, h) + aoff + m * 2048 + 1024)); } \
    else { _Pragma("unroll") for (int m = 0; m < 4; ++m) _Pragma("unroll") for (int k = 0; k < 2; ++k) dst[m][k] = *(const LAS bf16x8*)(lds + PG8_SA(b, h) + aoff + m * 2048 + k * 1024); } } while (0)
#define PG8_LDB(dst, b, h) do { if constexpr (FP8) { _Pragma("unroll") for (int n = 0; n < 2; ++n) dst##8[n] = cat8(*(const LAS bf16x8*)(lds + PG8_SB(b, h) + boff + n * 2048), *(const LAS bf16x8*)(lds + PG8_SB(b, h) + boff + n * 2048 + 1024)); } \
    else { _Pragma("unroll") for (int n = 0; n < 2; ++n) _Pragma("unroll") for (int k = 0; k < 2; ++k) dst[n][k] = *(const LAS bf16x8*)(lds + PG8_SB(b, h) + boff + n * 2048 + k * 1024); } } while (0)
#define PG8_MMA(ai, bj, At, Bt) do { __builtin_amdgcn_s_setprio(1); if constexpr (FP8) { _Pragma("unroll") for (int m = 0; m < 4; ++m) _Pragma("unroll") for (int n = 0; n < 2; ++n) \
        asm volatile("v_mfma_scale_f32_16x16x128_f8f6f4 %0, %1, %2, %0, %3, %3 op_sel_hi:[0,0,0]" : "+v"(acc[ai][bj][m][n]) : "v"(Bt##8[n]), "v"(At##8[m]), "v"(sc8)); } \
    else { _Pragma("unroll") for (int m = 0; m < 4; ++m) _Pragma("unroll") for (int n = 0; n < 2; ++n) _Pragma("unroll") for (int k = 0; k < 2; ++k) \
        acc[ai][bj][m][n] = __builtin_amdgcn_mfma_f32_16x16x32_bf16(Bt[n][k], At[m][k], acc[ai][bj][m][n], 0, 0, 0); } __builtin_amdgcn_s_setprio(0); } while (0)
#define PG8_WAIT_V(n) asm volatile("s_waitcnt vmcnt(" #n ")" ::: "memory")
#define PG8_WAIT_L(n) asm volatile("s_waitcnt lgkmcnt(" #n ")" ::: "memory")
#define PG8_BAR __builtin_amdgcn_s_barrier()
#define PG8_SCHED __builtin_amdgcn_sched_barrier(0)
    Unit cur, nxt; int ui = 0;
    if (!S.next(0, cur)) return;
#pragma unroll
    for (int h = 0; h < 2; ++h)
#pragma unroll
        for (int i = 0; i < 2; ++i) vA[h][i] = (unsigned)((GATHER ? S.a_row(cur, h * HALF + Rr[i]) : (unsigned)(h * HALF + Rr[i])) * (unsigned)K + (unsigned)Cc[i]) * 2u;
    f32x4 acc[2][2][4][2];
    if constexpr (Epi::HAS_INIT) E.init(acc, cur, wr, wc, fr, fq);
    else {
#pragma unroll
    for (int a = 0; a < 2; ++a)
#pragma unroll
        for (int b = 0; b < 2; ++b)
#pragma unroll
            for (int m = 0; m < 4; ++m)
#pragma unroll
                for (int n = 0; n < 2; ++n) acc[a][b][m][n] = (f32x4){0.f, 0.f, 0.f, 0.f};
    }
    const int sc8 = 0x7f7f7f7f;
    bf16x8 At[4][2], B0[2][2], B1[2][2]; v8i_t At8[4], B08[2], B18[2];
    const char* cA = S.a_base(cur); const char* cB = S.b_base(cur);
    PG8_STAGE(PG8_SB(0, 0), cB, voffB); PG8_STAGE(PG8_SB(0, 1), cB + hstep, voffB); PG8_STAGE(PG8_SA(0, 0), cA, vA[0]); PG8_STAGE(PG8_SA(0, 1), cA, vA[1]);
    if (wr == 1) PG8_BAR;
    PG8_WAIT_V(2); PG8_BAR;
    PG8_STAGE(PG8_SB(1, 0), cB + kstep, voffB); PG8_STAGE(PG8_SA(1, 0), cA + kstep, vA[0]); PG8_STAGE(PG8_SB(1, 1), cB + hstep + kstep, voffB);
    PG8_WAIT_V(6); PG8_BAR;
    for (;;) {
        const bool has_next = S.next(ui + 1, nxt);
        const char* nA = has_next ? S.a_base(nxt) : cA; const char* nB = has_next ? S.b_base(nxt) : cB;
        if constexpr (GATHER) {
#pragma unroll
            for (int h = 0; h < 2; ++h)
#pragma unroll
                for (int i = 0; i < 2; ++i) nvA[h][i] = has_next ? (unsigned)(S.a_row(nxt, h * HALF + Rr[i]) * (unsigned)K + (unsigned)Cc[i]) * 2u : vA[h][i];
        }
#define PG8_WAIT_RX() do { if (relax) { if constexpr (Epi::NST >= 16) PG8_WAIT_V(24); else if constexpr (Epi::NST >= 8) PG8_WAIT_V(16); else PG8_WAIT_V(8); } else PG8_WAIT_V(8); } while (0)
#define PG8_TRIP(t) do { \
            const bool last = ((t) == nt - 2); int rx_ = __builtin_amdgcn_readfirstlane(((ui > 0) && ((t) == 0)) ? 1 : 0); asm volatile("" : "+s"(rx_)); const bool relax = rx_ != 0; \
            const char* a1 = cA + (size_t)((t) + 1) * kstep; \
            const char* a2 = last ? nA : cA + (size_t)((t) + 2) * kstep; const char* b2 = last ? nB : cB + (size_t)((t) + 2) * kstep; \
            const char* a3 = a2 + kstep; const char* b3 = b2 + kstep; \
            unsigned x0[2], x1[2]; \
            if constexpr (GATHER) { x0[0] = last ? nvA[0][0] : vA[0][0]; x0[1] = last ? nvA[0][1] : vA[0][1]; x1[0] = last ? nvA[1][0] : vA[1][0]; x1[1] = last ? nvA[1][1] : vA[1][1]; } \
            else { x0[0] = vA[0][0]; x0[1] = vA[0][1]; x1[0] = vA[1][0]; x1[1] = vA[1][1]; } \
            PG8_LDB(B0, 0, 0); PG8_LDB(B1, 0, 1); PG8_SCHED; PG8_LDA(At, 0, 0); PG8_STAGE(PG8_SA(1, 1), a1, vA[1]); \
            PG8_WAIT_RX(); PG8_WAIT_L(0); PG8_BAR; PG8_MMA(0, 0, At, B0); PG8_MMA(0, 1, At, B1); PG8_BAR; PG8_SCHED; \
            PG8_LDA(At, 0, 1); PG8_STAGE(PG8_SB(0, 0), b2, voffB); PG8_STAGE(PG8_SB(0, 1), b2 + hstep, voffB); PG8_STAGE(PG8_SA(0, 0), a2, x0); \
            PG8_WAIT_RX(); PG8_WAIT_L(0); PG8_BAR; PG8_MMA(1, 0, At, B0); PG8_MMA(1, 1, At, B1); PG8_BAR; PG8_SCHED; \
            PG8_LDB(B0, 1, 0); PG8_LDB(B1, 1, 1); PG8_SCHED; PG8_LDA(At, 1, 0); PG8_STAGE(PG8_SA(0, 1), a2, x1); \
            PG8_WAIT_V(8); PG8_WAIT_L(0); PG8_BAR; PG8_MMA(0, 0, At, B0); PG8_MMA(0, 1, At, B1); PG8_BAR; PG8_SCHED; \
            PG8_LDA(At, 1, 1); PG8_STAGE(PG8_SB(1, 0), b3, voffB); PG8_STAGE(PG8_SB(1, 1), b3 + hstep, voffB); PG8_STAGE(PG8_SA(1, 0), a3, x0); \
            PG8_WAIT_V(8); PG8_WAIT_L(0); PG8_BAR; PG8_MMA(1, 0, At, B0); PG8_MMA(1, 1, At, B1); PG8_BAR; PG8_SCHED; } while (0)
        for (int t = 0; t < nt; t += 2) PG8_TRIP(t);
        if constexpr (ALIGN_EPI) { if (wr == 0) PG8_BAR; }
        if constexpr (FP8) asm volatile("s_nop 15\n\ts_nop 15" ::: "memory");
        E(acc, cur, wr, wc, fr, fq);
        if (!has_next) break;
        if constexpr (Epi::HAS_INIT) E.init(acc, nxt, wr, wc, fr, fq);
        else {
#pragma unroll
        for (int a = 0; a < 2; ++a)
#pragma unroll
            for (int b = 0; b < 2; ++b)
#pragma unroll
                for (int m = 0; m < 4; ++m)
#pragma unroll
                    for (int n = 0; n < 2; ++n) acc[a][b][m][n] = (f32x4){0.f, 0.f, 0.f, 0.f};
        }
        cur = nxt; cA = nA; cB = nB; ++ui;
        if constexpr (GATHER) { vA[0][0] = nvA[0][0]; vA[0][1] = nvA[0][1]; vA[1][0] = nvA[1][0]; vA[1][1] = nvA[1][1]; }
        if constexpr (ALIGN_EPI) { if (wr == 1) PG8_BAR; }
    }
    PG8_WAIT_V(0);
    if constexpr (!ALIGN_EPI) { if (wr == 0) PG8_BAR; }
    PG8_BAR;
#undef PG8_TRIP
#undef PG8_WAIT_RX
#undef PG8_SA
#undef PG8_SB
#undef PG8_STAGE
#undef PG8_LDA
#undef PG8_LDB
#undef PG8_MMA
#undef PG8_WAIT_V
#undef PG8_WAIT_L
#undef PG8_BAR
#undef PG8_SCHED
}
}

#define EPI_ROWS(ai, m) (u.pm * 256 + (ai) * 128 + wr * 64 + (m) * 16 + fr)
__device__ __forceinline__ u32x4 pack8(const f32x4 a, const f32x4 b) { u32x4 w; w.x = cvt_pk_bf16(a[0], a[1]); w.y = cvt_pk_bf16(a[2], a[3]); w.z = cvt_pk_bf16(b[0], b[1]); w.w = cvt_pk_bf16(b[2], b[3]); return w; }
__device__ __forceinline__ void unpack8(const u32x4 w, f32x4& a, f32x4& b) { a = (f32x4){bf_lo(w.x), bf_hi(w.x), bf_lo(w.y), bf_hi(w.y)}; b = (f32x4){bf_lo(w.z), bf_hi(w.z), bf_lo(w.w), bf_hi(w.w)}; }

struct EpiWin {
    static constexpr bool PERM = true, HAS_INIT = false; static constexpr int NST = 8;
    const float* rstd; bf16_t* v; bf16_t* bg; bf16_t* ub; bf16_t* gates; const float* gate_bias;
    __device__ __forceinline__ void operator()(const f32x4 (&acc)[2][2][4][2], const pg8::Unit& u, int wr, int wc, int fr, int fq) const {
        if (u.pn < 8) {
#pragma unroll
            for (int ai = 0; ai < 2; ++ai)
#pragma unroll
                for (int m = 0; m < 4; ++m) { const int row = EPI_ROWS(ai, m); const float rs = rstd[row], rs2 = rs * rs;
                    const f32x4 a0 = acc[ai][0][m][0] * acc[ai][1][m][0] * rs2, a1 = acc[ai][0][m][1] * acc[ai][1][m][1] * rs2;
                    *(u32x4*)(v + (size_t)row * D + 128 * u.pn + 32 * wc + 8 * fq) = pack8(a0, a1); }
        } else if (u.pn < 14) {
            bf16_t* base; int ld, c0;
            if (u.pn < 12) { base = bg; ld = D; c0 = 256 * (u.pn - 8); } else { base = ub; ld = SW; c0 = 256 * (u.pn - 12); }
#pragma unroll
            for (int ai = 0; ai < 2; ++ai)
#pragma unroll
                for (int m = 0; m < 4; ++m) { const int row = EPI_ROWS(ai, m); const float rs = rstd[row];
#pragma unroll
                    for (int bj = 0; bj < 2; ++bj) *(u32x4*)(base + (size_t)row * ld + c0 + 128 * bj + 32 * wc + 8 * fq) = pack8(acc[ai][bj][m][0] * rs, acc[ai][bj][m][1] * rs); }
        } else {
            const int c0 = 256 * (u.pn - 14) + 32 * wc + 8 * fq;
            f32x4 bv[2][2];
#pragma unroll
            for (int bj = 0; bj < 2; ++bj)
#pragma unroll
                for (int n = 0; n < 2; ++n) bv[bj][n] = *(const f32x4*)(gate_bias + c0 + 128 * bj + 4 * n);
#pragma unroll
            for (int ai = 0; ai < 2; ++ai)
#pragma unroll
                for (int m = 0; m < 4; ++m) { const int row = EPI_ROWS(ai, m); const float rs = rstd[row];
#pragma unroll
                    for (int bj = 0; bj < 2; ++bj) { f32x4 g0 = acc[ai][bj][m][0] * rs + bv[bj][0], g1 = acc[ai][bj][m][1] * rs + bv[bj][1];
#pragma unroll
                        for (int j = 0; j < 4; ++j) { g0[j] = fsigmoid(g0[j]); g1[j] = fsigmoid(g1[j]); }
                        *(u32x4*)(gates + (size_t)row * 2048 + c0 + 128 * bj) = pack8(g0, g1); } }
        }
    }
};
struct EpiGlu {
    static constexpr bool PERM = true, HAS_INIT = false; static constexpr int NST = 8;
    const bf16_t* gates; bf16_t* mb;
    __device__ __forceinline__ void operator()(const f32x4 (&acc)[2][2][4][2], const pg8::Unit& u, int wr, int wc, int fr, int fq) const {
        const int col = 128 * u.pn + 32 * wc + 8 * fq;
#pragma unroll
        for (int ai = 0; ai < 2; ++ai)
#pragma unroll
            for (int m = 0; m < 4; ++m) { const int row = EPI_ROWS(ai, m);
                f32x4 g0, g1; unpack8(*(const u32x4*)(gates + (size_t)row * 2048 + 1024 + col), g0, g1);
                f32x4 y0 = acc[ai][0][m][0], y1 = acc[ai][0][m][1]; const f32x4 b0 = acc[ai][1][m][0], b1 = acc[ai][1][m][1];
#pragma unroll
                for (int j = 0; j < 4; ++j) { y0[j] = y0[j] * fsigmoid(b0[j]) * g0[j]; y1[j] = y1[j] * fsigmoid(b1[j]) * g1[j]; }
                *(u32x4*)(mb + (size_t)row * D + col) = pack8(y0, y1); }
    }
};
struct EpiMix {
    static constexpr bool PERM = true, HAS_INIT = false; static constexpr int NST = 16;
    const bf16_t* gates; const bf16_t* mb; bf16_t* mixed;
    __device__ __forceinline__ void operator()(const f32x4 (&acc)[2][2][4][2], const pg8::Unit& u, int wr, int wc, int fr, int fq) const {
#pragma unroll
        for (int ai = 0; ai < 2; ++ai)
#pragma unroll
            for (int m = 0; m < 4; ++m) { const int row = EPI_ROWS(ai, m);
#pragma unroll
                for (int bj = 0; bj < 2; ++bj) { const int col = 256 * u.pn + 128 * bj + 32 * wc + 8 * fq;
                    f32x4 g0, g1, m0, m1; unpack8(*(const u32x4*)(gates + (size_t)row * 2048 + col), g0, g1); unpack8(*(const u32x4*)(mb + (size_t)row * D + col), m0, m1);
                    *(u32x4*)(mixed + (size_t)row * D + col) = pack8(g0 * acc[ai][bj][m][0] + m0, g1 * acc[ai][bj][m][1] + m1); } }
    }
};
struct EpiX1 {
    static constexpr bool PERM = true, HAS_INIT = true; static constexpr int NST = 16;
    const float* __restrict__ x; float* __restrict__ x1; bf16_t* __restrict__ x1b; unsigned char* __restrict__ x1q;
    __device__ __forceinline__ void init(f32x4 (&acc)[2][2][4][2], const pg8::Unit& u, int wr, int wc, int fr, int fq) const {
#pragma unroll
        for (int ai = 0; ai < 2; ++ai)
#pragma unroll
            for (int m = 0; m < 4; ++m)
#pragma unroll
                for (int bj = 0; bj < 2; ++bj)
#pragma unroll
                    for (int n = 0; n < 2; ++n) acc[ai][bj][m][n] = *(const f32x4*)(x + (size_t)EPI_ROWS(ai, m) * D + 256 * u.pn + 128 * bj + 32 * wc + 8 * fq + 4 * n);
    }
    __device__ __forceinline__ void operator()(const f32x4 (&acc)[2][2][4][2], const pg8::Unit& u, int wr, int wc, int fr, int fq) const {
#pragma unroll
        for (int ai = 0; ai < 2; ++ai)
#pragma unroll
            for (int m = 0; m < 4; ++m) { const int row = EPI_ROWS(ai, m);
#pragma unroll
                for (int bj = 0; bj < 2; ++bj) { const size_t o = (size_t)row * D + 256 * u.pn + 128 * bj + 32 * wc + 8 * fq;
                    const f32x4 r0 = acc[ai][bj][m][0], r1 = acc[ai][bj][m][1];
                    *(u32x4*)(x1b + o) = pack8(r0, r1);
                    u32x2 q8; q8.x = cvt4_fp8(r0[0], r0[1], r0[2], r0[3]); q8.y = cvt4_fp8(r1[0], r1[1], r1[2], r1[3]); *(u32x2*)(x1q + o) = q8; }
                }
    }
};
struct EpiUp {
    static constexpr bool PERM = true, HAS_INIT = false; static constexpr int NST = 8;
    const int* list; const float* rstd2; unsigned char* hmid;
    __device__ __forceinline__ void operator()(const f32x4 (&acc)[2][2][4][2], const pg8::Unit& u, int wr, int wc, int fr, int fq) const {
        const int col = 128 * u.pn + 32 * wc + 8 * fq;
#pragma unroll
        for (int ai = 0; ai < 2; ++ai)
#pragma unroll
            for (int m = 0; m < 4; ++m) { const int r = ai * 128 + wr * 64 + m * 16 + fr; const bool ok = r < u.nrow;
                const int tok = ok ? list[u.e * T + 256 * u.pm + r] : 0; const float rs = ok ? rstd2[tok] * (1.f / 32.f) : 0.f;
                f32x4 g0 = acc[ai][0][m][0] * rs, g1 = acc[ai][0][m][1] * rs; const f32x4 u0 = acc[ai][1][m][0] * rs, u1 = acc[ai][1][m][1] * rs;
#pragma unroll
                for (int j = 0; j < 4; ++j) { g0[j] = fsilu(g0[j]) * u0[j]; g1[j] = fsilu(g1[j]) * u1[j]; }
                u32x2 q8; q8.x = cvt4_fp8(g0[0], g0[1], g0[2], g0[3]); q8.y = cvt4_fp8(g1[0], g1[1], g1[2], g1[3]); *(u32x2*)(hmid + (size_t)(u.srow + r) * EFF + col) = q8; }
    }
};
struct EpiDown {
    static constexpr bool PERM = true, HAS_INIT = false; static constexpr int NST = 16;
    bf16_t* Y;
    __device__ __forceinline__ void operator()(const f32x4 (&acc)[2][2][4][2], const pg8::Unit& u, int wr, int wc, int fr, int fq) const {
#pragma unroll
        for (int ai = 0; ai < 2; ++ai)
#pragma unroll
            for (int m = 0; m < 4; ++m) { const int r = ai * 128 + wr * 64 + m * 16 + fr;
#pragma unroll
                for (int bj = 0; bj < 2; ++bj) *(u32x4*)(Y + (size_t)(u.srow + r) * D + 256 * u.pn + 128 * bj + 32 * wc + 8 * fq) = pack8(acc[ai][bj][m][0] * (1.f / 16.f), acc[ai][bj][m][1] * (1.f / 16.f)); }
    }
};

constexpr size_t MiB = 1u << 20;
constexpr size_t WS_CTL = 0, CTL_BYTES = 64 * 1024;
constexpr size_t WS_WIN = 1 * MiB, WS_WC = 12 * MiB, WS_WGLU = 14 * MiB, WS_WO = 16 * MiB;
constexpr size_t WS_RSTD1 = 18 * MiB, WS_RSTD2 = WS_RSTD1 + 64 * 1024, WS_TABA = WS_RSTD2 + 64 * 1024, WS_TABA256 = WS_TABA + 32 * 1024, WS_BBT = WS_TABA256 + 32 * 1024,
                 WS_CT = WS_BBT + 128 * 1024, WS_WRT = WS_CT + 128 * 1024, WS_E = 19 * MiB;
constexpr size_t WS_XB = 20 * MiB, WS_Z = 20 * MiB;
constexpr size_t WS_V = 52 * MiB, WS_MB = 52 * MiB, WS_X1B = 52 * MiB;
constexpr size_t WS_BG = 84 * MiB, WS_MIXED = 84 * MiB, WS_HMID = 84 * MiB;
constexpr size_t WS_UB = 116 * MiB, WS_YS = 116 * MiB;
constexpr size_t WS_GATES = 132 * MiB;
constexpr size_t WS_Y = 124 * MiB;
constexpr size_t WS_WGU = 196 * MiB, WS_X1Q = 228 * MiB;
constexpr size_t WS_WD = 260 * MiB, WS_WD2 = 2 * MiB;
constexpr int WD_SPLIT = 64;
#ifndef CV_EARLY_ITEMS
#define CV_EARLY_ITEMS 5120
#endif
constexpr int CV_EARLY = CV_EARLY_ITEMS;
constexpr size_t WS_TOK = 4 * MiB, WS_LIST = 6 * MiB, WS_END = 290 * MiB;
constexpr int CW_CNT = 64;
constexpr int CW_BAR = 4096;
constexpr int RING_BYTES = 131072, MISC_OFF = RING_BYTES, LDS_BYTES = 147456;

#define XB_TMO      128
#define XB_XCNT(j)  (256  + 64 * (j))
#define XB_XSUB(j)  (1280 + 64 * (j))
#define XB_XGEN(j)  (2304 + 64 * (j))
#define XB_TOP      3328
#define XB_TOPGEN   3392
#define XCD_BAR_WORDS 3456
#define XB_SPIN_CAP (1u << 18)
__device__ __forceinline__ unsigned xb_ld(unsigned* p)              { return __hip_atomic_load(p, __ATOMIC_RELAXED, __HIP_MEMORY_SCOPE_AGENT); }
__device__ __forceinline__ unsigned xb_add(unsigned* p, unsigned v) { return __hip_atomic_fetch_add(p, v, __ATOMIC_RELAXED, __HIP_MEMORY_SCOPE_AGENT); }
__device__ __forceinline__ unsigned xb_xcc_id() { return (unsigned)__builtin_amdgcn_s_getreg((3 << 11) | 20) & 0xFu; }
#define XB_SPIN(cond, bar) do { unsigned _sp = 0; while (cond) { __builtin_amdgcn_s_sleep(1); \
    if ((++_sp & 255u) == 0u) { if (xb_ld(&(bar)[XB_TMO])) break; if (_sp > XB_SPIN_CAP) { atomicAdd(&(bar)[XB_TMO], 1u); break; } } } } while (0)
struct XcdBarrier { unsigned* bar; unsigned x; volatile LAS unsigned* st; };
__device__ __forceinline__ XcdBarrier xcd_barrier_post(unsigned* bar, volatile LAS unsigned* st) {
    XcdBarrier b; b.bar = bar; b.x = xb_xcc_id(); b.st = st;
    if (threadIdx.x == 0) (void)xb_add(&bar[XB_XCNT(b.x)], 1u);
    return b;
}
__device__ __forceinline__ void xcd_barrier_complete(unsigned* bar, unsigned x, unsigned& nloc, unsigned& nx) {
    const unsigned G = gridDim.x * gridDim.y * gridDim.z;
    unsigned sum, cnt, mine, sp = 0u;
    for (;;) {
        sum = 0u; cnt = 0u; mine = 0u;
#pragma unroll
        for (unsigned j = 0; j < 16; ++j) { const unsigned c = xb_ld(&bar[XB_XCNT(j)]); sum += c; cnt += (c > 0u) ? 1u : 0u; mine = (j == x) ? c : mine; }
        if (sum == G) break;
        __builtin_amdgcn_s_sleep(1);
        if ((++sp & 255u) == 0u) { if (xb_ld(&bar[XB_TMO])) break; if (sp > XB_SPIN_CAP) { atomicAdd(&bar[XB_TMO], 1u); break; } }
    }
    nloc = mine > 0u ? mine : 1u; nx = cnt > 0u ? cnt : 1u;
}
__device__ __forceinline__ void xcd_barrier(const XcdBarrier& b) {
    asm volatile("s_waitcnt vmcnt(0)" ::: "memory");
    __syncthreads();
    if (threadIdx.x == 0) {
        unsigned* bar = b.bar;
        __builtin_amdgcn_s_waitcnt(0);
        unsigned nloc = b.st[0], nx = b.st[1];
        if (nloc == 0u) { xcd_barrier_complete(bar, b.x, nloc, nx); b.st[0] = nloc; b.st[1] = nx; }
        const unsigned old = xb_add(&bar[XB_XSUB(b.x)], 1u);
        const unsigned gen = old / nloc;
        if (old + 1u == (gen + 1u) * nloc) {
            __builtin_amdgcn_fence(__ATOMIC_RELEASE, "agent");
            asm volatile("s_waitcnt vmcnt(0)" ::: "memory");
            const unsigned og = xb_add(&bar[XB_TOP], 1u);
            const unsigned tg = og / nx;
            if (og + 1u == (tg + 1u) * nx) xb_add(&bar[XB_TOPGEN], 1u);
            else XB_SPIN(xb_ld(&bar[XB_TOPGEN]) == tg, bar);
            __builtin_amdgcn_fence(__ATOMIC_ACQUIRE, "agent");
            xb_add(&bar[XB_XGEN(b.x)], 1u);
            asm volatile("s_waitcnt vmcnt(0)" ::: "memory");
        } else {
            XB_SPIN(xb_ld(&bar[XB_XGEN(b.x)]) == gen, bar);
            __builtin_amdgcn_fence(__ATOMIC_ACQUIRE, "agent");
            asm volatile("s_waitcnt vmcnt(0)" ::: "memory");
        }
    }
    __syncthreads();
}

struct Args { const float* in[27]; float* out; unsigned char* ws; int ph_lo, ph_hi, use_bar, pad; };
struct Frame {
    LAS unsigned char* lds; volatile LAS unsigned* MISC; unsigned* ctl; unsigned char* ws;
    int tid, lane, wave, G;
};

__device__ __forceinline__ void tr64(const float* __restrict__ src, int ld, int col0, int k0, const float* __restrict__ scale, bf16_t* __restrict__ dst, size_t drow0, int Kdst, LAS unsigned char* scr, int lane) {
    const float* s = src + (size_t)k0 * ld + col0 + lane;
#pragma unroll
    for (int hh = 0; hh < 2; ++hh) {
        float v[32];
#pragma unroll
        for (int kk = 0; kk < 32; ++kk) v[kk] = s[(size_t)(32 * hh + kk) * ld];
        if (scale) {
#pragma unroll
            for (int kk = 0; kk < 32; ++kk) v[kk] *= scale[k0 + 32 * hh + kk];
        }
#pragma unroll
        for (int c = 0; c < 4; ++c) { u32x4 o; o.x = cvt_pk_bf16(v[8 * c + 0], v[8 * c + 1]); o.y = cvt_pk_bf16(v[8 * c + 2], v[8 * c + 3]); o.z = cvt_pk_bf16(v[8 * c + 4], v[8 * c + 5]); o.w = cvt_pk_bf16(v[8 * c + 6], v[8 * c + 7]);
            *(LAS u32x4*)(scr + lane * 144 + 16 * (4 * hh + c)) = o; }
        asm volatile("s_waitcnt vmcnt(0)" ::: "memory");
    }
    asm volatile("s_waitcnt lgkmcnt(0)" ::: "memory");
#pragma unroll
    for (int j = 0; j < 8; ++j) { const int row = 8 * j + (lane >> 3); const u32x4 o = *(const LAS u32x4*)(scr + row * 144 + 16 * (lane & 7));
        *(u32x4*)(dst + (drow0 + row) * (size_t)Kdst + k0 + 8 * (lane & 7)) = o; }
    asm volatile("s_waitcnt lgkmcnt(0)" ::: "memory");
}

__device__ __forceinline__ void p0_prologue(const Frame& F, const Args& a) {
    LAS unsigned char* scr = F.lds + F.wave * 16384;
    const int gw = blockIdx.x * 8 + F.wave, NGW = F.G * 8;
    bf16_t* Win_t = (bf16_t*)(F.ws + WS_WIN); bf16_t* Wc_t = (bf16_t*)(F.ws + WS_WC); bf16_t* Wglu_t = (bf16_t*)(F.ws + WS_WGLU); bf16_t* Wo_t = (bf16_t*)(F.ws + WS_WO);
    constexpr int I_WIN = 16 * 88, I_WC = 16 * 16, I_WO = 16 * 16, I_GLU = 8 * 32;
    for (int it = gw; it < I_WIN + I_WC + I_WO + I_GLU; it += NGW) {
        int r = it;
        if (r < I_WIN) { const int kb = r / 88, nb = r % 88, j0 = 64 * nb; int col0;
            if (j0 < 2048) { const int pn = j0 >> 8, i = j0 & 255; col0 = (i < 128) ? (128 * pn + i) : (2048 + 128 * pn + (i - 128)); } else if (j0 < 3072) col0 = j0 - 1024; else col0 = j0;
            tr64(a.in[2], INC, col0, 64 * kb, a.in[1], Win_t, (size_t)j0, D, scr, F.lane); continue; }
        r -= I_WIN;
        if (r < I_WC) { tr64(a.in[5], D, 64 * (r % 16), 64 * (r / 16), nullptr, Wc_t, (size_t)(64 * (r % 16)), D, scr, F.lane); continue; }
        r -= I_WC;
        if (r < I_WO) { tr64(a.in[17], D, 64 * (r % 16), 64 * (r / 16), nullptr, Wo_t, (size_t)(64 * (r % 16)), D, scr, F.lane); continue; }
        r -= I_WO;
        { const int kb = r / 32, nb = r % 32, j0 = 64 * nb, pn = j0 >> 8, i = j0 & 255;
          tr64(i < 128 ? a.in[14] : a.in[15], D, 128 * pn + (i & 127), 64 * kb, nullptr, Wglu_t, (size_t)j0, SW, scr, F.lane); }
    }
    { const float* __restrict__ x = a.in[0]; bf16_t* __restrict__ xb = (bf16_t*)(F.ws + WS_XB); float* __restrict__ rstd1 = (float*)(F.ws + WS_RSTD1);
      for (int m = 4 * gw; m < T; m += 4 * NGW) {
          f32x4 v[4][4]; float sq[4];
#pragma unroll
          for (int q = 0; q < 4; ++q) { const f32x4* xr = (const f32x4*)(x + (size_t)(m + q) * D) + F.lane;
#pragma unroll
              for (int j = 0; j < 4; ++j) v[q][j] = xr[64 * j]; }
#pragma unroll
          for (int q = 0; q < 4; ++q) { sq[q] = 0.f;
#pragma unroll
              for (int j = 0; j < 4; ++j) sq[q] += (v[q][j][0] * v[q][j][0] + v[q][j][1] * v[q][j][1]) + (v[q][j][2] * v[q][j][2] + v[q][j][3] * v[q][j][3]);
              u32x2* o = (u32x2*)(xb + (size_t)(m + q) * D) + F.lane;
#pragma unroll
              for (int j = 0; j < 4; ++j) { u32x2 w; w.x = cvt_pk_bf16(v[q][j][0], v[q][j][1]); w.y = cvt_pk_bf16(v[q][j][2], v[q][j][3]); o[64 * j] = w; } }
#pragma unroll
          for (int o = 1; o < 64; o <<= 1) {
#pragma unroll
              for (int q = 0; q < 4; ++q) sq[q] += __shfl_xor(sq[q], o); }
          if (F.lane < 4) { const float sv = F.lane == 0 ? sq[0] : F.lane == 1 ? sq[1] : F.lane == 2 ? sq[2] : sq[3]; rstd1[m + F.lane] = rsqrtf(sv * (1.f / D) + EPS); }
          asm volatile("s_waitcnt vmcnt(8)" ::: "memory"); } }
    { bf16_t* wrt = (bf16_t*)(F.ws + WS_WRT); const float* g2 = a.in[18];
      for (int i = blockIdx.x * 512 + F.tid; i < 48 * D; i += F.G * 512) { const int j = i / D, k = i % D; float w = 0.f;
          if (j < 4) w = a.in[19][k * 4 + j]; else if (j < 36) w = a.in[21][k * 32 + (j - 4)];
          wrt[i] = (bf16_t)(cvt_pk_bf16(w * g2[k], 0.f) & 0xffffu); } }
    { float* tab_a = (float*)(F.ws + WS_TABA); float* tab_a256 = (float*)(F.ws + WS_TABA256); bf16_t* BbT = (bf16_t*)(F.ws + WS_BBT); bf16_t* Ct = (bf16_t*)(F.ws + WS_CT);
      for (int i = blockIdx.x * 512 + F.tid; i < NG * NS; i += F.G * 512) { const int g = i / NS, n = i % NS;
          f32x4 br[4], bi[4]; float cre[16], cim[16];
#pragma unroll
          for (int q = 0; q < 4; ++q) { br[q] = *(const f32x4*)(a.in[9] + (size_t)i * NH + 4 * q); bi[q] = *(const f32x4*)(a.in[10] + (size_t)i * NH + 4 * q); }
#pragma unroll
          for (int h = 0; h < NH; ++h) { cre[h] = a.in[11][(g * NH + h) * NS + n]; cim[h] = a.in[12][(g * NH + h) * NS + n]; }
          const float lr = a.in[6][i], li = a.in[7][i], dt = expf(a.in[8][g]);
          float sn, cs; sincosf(li * dt, &sn, &cs); const float er = expf(lr * dt); const float cr = er * cs, ci = er * sn;
          float pr = cr, pi = ci;
#pragma unroll
          for (int q = 0; q < 4; ++q) { const float tr_ = pr * pr - pi * pi, ti_ = 2.f * pr * pi; pr = tr_; pi = ti_; }
          *(f32x4*)(tab_a + (size_t)i * 4) = (f32x4){cr, ci, pr, pi};
#pragma unroll
          for (int q = 0; q < 4; ++q) { const float tr_ = pr * pr - pi * pi, ti_ = 2.f * pr * pi; pr = tr_; pi = ti_; }
          *(float2*)(tab_a256 + (size_t)i * 2) = make_float2(pr, pi);
          const float nr = cr - 1.f, ni = ci, den = lr * lr + li * li; const float kr = (nr * lr + ni * li) / den, ki = (ni * lr - nr * li) / den;
          unsigned wre[8], wim[8];
#pragma unroll
          for (int q = 0; q < 4; ++q) {
              wre[2 * q]     = cvt_pk_bf16(kr * br[q][0] - ki * bi[q][0], kr * br[q][1] - ki * bi[q][1]);
              wre[2 * q + 1] = cvt_pk_bf16(kr * br[q][2] - ki * bi[q][2], kr * br[q][3] - ki * bi[q][3]);
              wim[2 * q]     = cvt_pk_bf16(kr * bi[q][0] + ki * br[q][0], kr * bi[q][1] + ki * br[q][1]);
              wim[2 * q + 1] = cvt_pk_bf16(kr * bi[q][2] + ki * br[q][2], kr * bi[q][3] + ki * br[q][3]); }
          u32x4* dre = (u32x4*)(BbT + ((size_t)(g * 4 + 0 + (n >> 5)) * 32 + (n & 31)) * 16); u32x4* dim_ = (u32x4*)(BbT + ((size_t)(g * 4 + 2 + (n >> 5)) * 32 + (n & 31)) * 16);
          dre[0] = (u32x4){wre[0], wre[1], wre[2], wre[3]}; dre[1] = (u32x4){wre[4], wre[5], wre[6], wre[7]};
          dim_[0] = (u32x4){wim[0], wim[1], wim[2], wim[3]}; dim_[1] = (u32x4){wim[4], wim[5], wim[6], wim[7]};
#pragma unroll
          for (int h = 0; h < NH; ++h) *(unsigned*)(Ct + (size_t)(g * NH + h) * 128 + 2 * n) = cvt_pk_bf16(cre[h], -cim[h]); } }
}

__device__ __forceinline__ void p2_conv(const Frame& F, const Args& a) {
    const bf16_t* v = (const bf16_t*)(F.ws + WS_V); const bf16_t* bg = (const bf16_t*)(F.ws + WS_BG); bf16_t* z = (bf16_t*)(F.ws + WS_Z);
    const float* cw = a.in[3]; const float* cb = a.in[4];
    const int gw = blockIdx.x * 8 + F.wave, NGW = F.G * 8;
    for (int it = gw; it < (T / 8) * 2; it += NGW) {
        const int t0 = (it >> 1) * 8, ch = (it & 1) * 512 + F.lane * 8;
        f32x4 w0a = *(const f32x4*)(cw + ch), w0b = *(const f32x4*)(cw + ch + 4), w1a = *(const f32x4*)(cw + D + ch), w1b = *(const f32x4*)(cw + D + ch + 4);
        f32x4 w2a = *(const f32x4*)(cw + 2 * D + ch), w2b = *(const f32x4*)(cw + 2 * D + ch + 4), ba = *(const f32x4*)(cb + ch), bb = *(const f32x4*)(cb + ch + 4);
        f32x4 p2a = {0.f, 0.f, 0.f, 0.f}, p2b = p2a, p1a = p2a, p1b = p2a;
        if (t0 >= 2) { unpack8(*(const u32x4*)(v + (size_t)(t0 - 2) * D + ch), p2a, p2b); unpack8(*(const u32x4*)(v + (size_t)(t0 - 1) * D + ch), p1a, p1b); }
#pragma unroll
        for (int i = 0; i < 8; ++i) { f32x4 ca, cbv, ga, gb; unpack8(*(const u32x4*)(v + (size_t)(t0 + i) * D + ch), ca, cbv); unpack8(*(const u32x4*)(bg + (size_t)(t0 + i) * D + ch), ga, gb);
            const f32x4 ya = ga * (w0a * p2a + w1a * p1a + w2a * ca + ba), yb = gb * (w0b * p2b + w1b * p1b + w2b * cbv + bb);
            *(u32x4*)(z + (size_t)(t0 + i) * D + ch) = pack8(ya, yb);
            p2a = p1a; p2b = p1b; p1a = ca; p1b = cbv; }
    }
}

struct ConvD { const float* src; const float* scale; bf16_t* dst; int ld, Kdst; };
__device__ __forceinline__ ConvD conv_desc(int H, const Args& a, unsigned char* ws) {
    ConvD d; const int it = H >> 1, hh = H & 1;
    if (it < NE * 256) { const int e = it >> 8, r = it & 255, kb = r >> 4, nb = r & 15, j0 = 64 * nb, pn = j0 >> 8, i = j0 & 255, k0 = 64 * kb + 32 * hh;
        d.src = (i < 128 ? a.in[23] : a.in[24]) + (size_t)e * D * EFF + (size_t)k0 * EFF + 128 * pn + (i & 127); d.ld = EFF; d.scale = a.in[18] + k0;
        d.dst = (bf16_t*)(ws + WS_WGU) + ((size_t)e * 1024 + j0) * D + k0; d.Kdst = D; }
    else { const int q = it - NE * 256, e = q >> 7, r = q & 127, kb = r >> 4, nb = r & 15, k0 = 64 * kb + 32 * hh;
        d.src = a.in[25] + (size_t)e * EFF * D + (size_t)k0 * D + 64 * nb; d.ld = D; d.scale = nullptr;
        d.dst = (bf16_t*)(e < WD_SPLIT ? ws + WS_WD + (size_t)e * MiB : ws + WS_WD2 + (size_t)(e - WD_SPLIT) * MiB) + (size_t)(64 * nb) * EFF + k0; d.Kdst = EFF; }
    return d;
}
__device__ __forceinline__ void conv_finish(float (&cv)[32], const ConvD& d, const float sc, LAS unsigned char* scr, int lane) {
    if (d.scale) {
#pragma unroll
        for (int kk = 0; kk < 32; ++kk) cv[kk] *= __uint_as_float((unsigned)__builtin_amdgcn_readlane((int)__float_as_uint(sc), kk));
    }
#pragma unroll
    for (int c = 0; c < 4; ++c) { u32x4 o; o.x = cvt_pk_bf16(cv[8 * c + 0], cv[8 * c + 1]); o.y = cvt_pk_bf16(cv[8 * c + 2], cv[8 * c + 3]); o.z = cvt_pk_bf16(cv[8 * c + 4], cv[8 * c + 5]); o.w = cvt_pk_bf16(cv[8 * c + 6], cv[8 * c + 7]);
        *(LAS u32x4*)(scr + lane * 80 + 16 * c) = o; }
    asm volatile("s_waitcnt lgkmcnt(0)" ::: "memory");
#pragma unroll
    for (int j = 0; j < 4; ++j) { const int row = 16 * j + (lane >> 2); const u32x4 o = *(const LAS u32x4*)(scr + row * 80 + 16 * (lane & 3));
        *(u32x4*)(d.dst + (size_t)row * d.Kdst + 8 * (lane & 3)) = o; }
    asm volatile("s_waitcnt lgkmcnt(0)" ::: "memory");
}

__device__ __forceinline__ int tokmap(int r) { return 16 * ((r >> 2) & 1) + 4 * (r >> 3) + (r & 3); }
typedef float f32x2s __attribute__((ext_vector_type(2)));
template <int PASS>
__device__ __forceinline__ void scan_pairs(f32x16& Pre, f32x16& Pim, f32x16& Qre, f32x16& Qim, const f32x2s Ar, const f32x2s Ai, const f32x2s A16r, const f32x2s A16i, f32x2s& Rr, f32x2s& Ri, int hf) {
    const f32x2s zero2 = {0.f, 0.f};
    f32x2s sr = hf ? zero2 : Rr, si = hf ? zero2 : Ri;
#pragma unroll
    for (int p = 0; p < 8; ++p) { const f32x2s re = {Pre[2 * p], Pre[2 * p + 1]}, im = {Pim[2 * p], Pim[2 * p + 1]};
        const f32x2s nr = Ar * sr - Ai * si + re, ni = Ar * si + Ai * sr + im; sr = nr; si = ni;
        Pre[2 * p] = sr.x; Pre[2 * p + 1] = sr.y; Pim[2 * p] = si.x; Pim[2 * p + 1] = si.y; }
#pragma unroll
    for (int p = 0; p < 8; ++p) { const f32x2s re = {Qre[2 * p], Qre[2 * p + 1]}, im = {Qim[2 * p], Qim[2 * p + 1]};
        const f32x2s nr = Ar * sr - Ai * si + re, ni = Ar * si + Ai * sr + im; sr = nr; si = ni;
        Qre[2 * p] = sr.x; Qre[2 * p + 1] = sr.y; Qim[2 * p] = si.x; Qim[2 * p + 1] = si.y; }
    f32x2s orr, oii; orr.x = __shfl_xor(sr.x, 32); orr.y = __shfl_xor(sr.y, 32); oii.x = __shfl_xor(si.x, 32); oii.y = __shfl_xor(si.y, 32);
    Rr = A16r * sr - A16i * si + orr; Ri = A16r * si + A16i * sr + oii;
    if (PASS == 2) {
        f32x2s cr = hf ? orr : zero2, ci = hf ? oii : zero2;
#pragma unroll
        for (int p = 0; p < 8; ++p) { const f32x2s nr = Ar * cr - Ai * ci, ni = Ar * ci + Ai * cr; cr = nr; ci = ni;
            Pre[2 * p] += cr.x; Pre[2 * p + 1] += cr.y; Pim[2 * p] += ci.x; Pim[2 * p + 1] += ci.y; }
#pragma unroll
        for (int p = 0; p < 8; ++p) { const f32x2s nr = Ar * cr - Ai * ci, ni = Ar * ci + Ai * cr; cr = nr; ci = ni;
            Qre[2 * p] += cr.x; Qre[2 * p + 1] += cr.y; Qim[2 * p] += ci.x; Qim[2 * p + 1] += ci.y; }
    }
}
template <int PASS>
__device__ __forceinline__ void scan_tile(f32x16& re, f32x16& im, const f32x4 c, float& Rr, float& Ri, int hf) {
    const float ar = c[0], ai = c[1];
    float sr = hf ? 0.f : Rr, si = hf ? 0.f : Ri;
#pragma unroll
    for (int q = 0; q < 16; ++q) { const float nr = ar * sr - ai * si + re[q], ni = ar * si + ai * sr + im[q]; sr = nr; si = ni; re[q] = sr; im[q] = si; }
    const float orr = __shfl_xor(sr, 32), oii = __shfl_xor(si, 32);
    Rr = c[2] * sr - c[3] * si + orr; Ri = c[2] * si + c[3] * sr + oii;
    if (PASS == 2) {
        float cr = hf ? orr : 0.f, ci = hf ? oii : 0.f;
#pragma unroll
        for (int q = 0; q < 16; ++q) { const float nr = ar * cr - ai * ci, ni = ar * ci + ai * cr; cr = nr; ci = ni; re[q] += cr; im[q] += ci; }
    }
}
template <int PASS>
__device__ __forceinline__ void ssm_pass(const Frame& F, const Args& a) {
    const int lane = F.lane, hf = lane >> 5, col = lane & 31;
    const f32x4* tab_a = (const f32x4*)(F.ws + WS_TABA); const float2* tab_a256 = (const float2*)(F.ws + WS_TABA256);
    const bf16_t* BbT = (const bf16_t*)(F.ws + WS_BBT); const bf16_t* Ct = (const bf16_t*)(F.ws + WS_CT);
    const bf16_t* ub = (const bf16_t*)(F.ws + WS_UB); bf16_t* ys = (bf16_t*)(F.ws + WS_YS); float* E = (float*)(F.ws + WS_E);
    LAS unsigned char* sl = F.lds + F.wave * 16384; LAS unsigned char* cscr = sl + 8704;
    for (int id = blockIdx.x * 8 + F.wave; id < NG * (T / 256); id += F.G * 8) {
        const int g = id & 31, r = id >> 5;
        const f32x4 c0 = tab_a[g * NS + col], c1 = tab_a[g * NS + 32 + col];
        bf16x8 Bf[4];
#pragma unroll
        for (int q = 0; q < 4; ++q) Bf[q] = *(const bf16x8*)(BbT + ((size_t)(g * 4 + q) * 32 + col) * 16 + 8 * hf);
        float R0r = 0.f, R0i = 0.f, R1r = 0.f, R1i = 0.f;
        bf16x8 Cf[4], Df;
        if (PASS == 2) {
            const float2 p0 = tab_a256[g * NS + col], p1 = tab_a256[g * NS + 32 + col];
            { const int rh = r >> 1, nit = r - rh, jb = hf ? rh : rh - nit;
              for (int j0 = 0; j0 < nit; j0 += 8) {
                float2 e0[8], e1[8];
#pragma unroll
                for (int q = 0; q < 8; ++q) { int j = jb + j0 + q; const bool ok = (j0 + q < nit) && (j >= 0); j = ok ? j : 0;
                    e0[q] = *(const float2*)(E + ((size_t)(j * NG + g) * NS + col) * 2); e1[q] = *(const float2*)(E + ((size_t)(j * NG + g) * NS + 32 + col) * 2);
                    if (!ok) { e0[q] = make_float2(0.f, 0.f); e1[q] = make_float2(0.f, 0.f); } }
#pragma unroll
                for (int q = 0; q < 8; ++q) if (j0 + q < nit) {
                    const float t0r = p0.x * R0r - p0.y * R0i + e0[q].x, t0i = p0.x * R0i + p0.y * R0r + e0[q].y; R0r = t0r; R0i = t0i;
                    const float t1r = p1.x * R1r - p1.y * R1i + e1[q].x, t1i = p1.x * R1i + p1.y * R1r + e1[q].y; R1r = t1r; R1i = t1i; } }
              float w0r = 1.f, w0i = 0.f, w1r = 1.f, w1i = 0.f, b0r = p0.x, b0i = p0.y, b1r = p1.x, b1i = p1.y;
#pragma unroll 1
              for (int m = nit; m > 0; m >>= 1) {
                  if (m & 1) { const float a = w0r * b0r - w0i * b0i, b = w0r * b0i + w0i * b0r; w0r = a; w0i = b; const float c2 = w1r * b1r - w1i * b1i, d2 = w1r * b1i + w1i * b1r; w1r = c2; w1i = d2; }
                  const float a = b0r * b0r - b0i * b0i, b = 2.f * b0r * b0i; b0r = a; b0i = b; const float c2 = b1r * b1r - b1i * b1i, d2 = 2.f * b1r * b1i; b1r = c2; b1i = d2; }
              if (hf == 0) { const float a = w0r * R0r - w0i * R0i, b = w0r * R0i + w0i * R0r; R0r = a; R0i = b; const float c2 = w1r * R1r - w1i * R1i, d2 = w1r * R1i + w1i * R1r; R1r = c2; R1i = d2; }
              R0r += __shfl_xor(R0r, 32); R0i += __shfl_xor(R0i, 32); R1r += __shfl_xor(R1r, 32); R1i += __shfl_xor(R1i, 32); }
#pragma unroll
            for (int kb = 0; kb < 4; ++kb) Cf[kb] = *(const bf16x8*)(Ct + (size_t)(g * NH + (lane & 15)) * 128 + kb * 32 + 8 * (lane >> 4));
            const unsigned dbits = cvt_pk_bf16(a.in[13][g * NH + (lane & 15)], 0.f) & 0xffffu;
#pragma unroll
            for (int jj = 0; jj < 8; ++jj) Df[jj] = (short)((lane < 32 && (8 * (lane >> 4) + jj) == (lane & 15)) ? dbits : 0u);
        }
        const int tokP = 16 * ((col >> 2) & 1) + 2 * (col >> 3) + ((col >> 1) & 1);
        bf16x8 Un = *(const bf16x8*)(ub + (size_t)(r * 256 + tokP) * SW + g * NH + 8 * hf), Vn = *(const bf16x8*)(ub + (size_t)(r * 256 + 8 + tokP) * SW + g * NH + 8 * hf);
        bf16x8 A2n[2] = {{0, 0, 0, 0, 0, 0, 0, 0}, {0, 0, 0, 0, 0, 0, 0, 0}};
        if (PASS == 2) {
#pragma unroll
            for (int mt = 0; mt < 2; ++mt) A2n[mt] = *(const bf16x8*)(ub + (size_t)(r * 256 + 16 * mt + (lane & 15)) * SW + g * NH + 8 * ((lane >> 4) & 1)); }
        for (int c = 0; c < 8; ++c) {
            const int t0 = r * 256 + c * 32;
            const bf16x8 Ua = Un, Va = Vn; bf16x8 A2[2] = {A2n[0], A2n[1]};
            if (lane >= 32) { A2[0] = (bf16x8){0, 0, 0, 0, 0, 0, 0, 0}; A2[1] = (bf16x8){0, 0, 0, 0, 0, 0, 0, 0}; }
            { const int tn = t0 + (c < 7 ? 32 : 0);
                Un = *(const bf16x8*)(ub + (size_t)(tn + tokP) * SW + g * NH + 8 * hf); Vn = *(const bf16x8*)(ub + (size_t)(tn + 8 + tokP) * SW + g * NH + 8 * hf);
                if (PASS == 2) {
#pragma unroll
                    for (int mt = 0; mt < 2; ++mt) A2n[mt] = *(const bf16x8*)(ub + (size_t)(tn + 16 * mt + (lane & 15)) * SW + g * NH + 8 * ((lane >> 4) & 1)); } }
            constexpr bool has_cv = false; ConvD cd; float cv[32]; float csc = 1.f;
            if (has_cv) { const int jstep = (PASS == 2 ? 4 + c : c); cd = conv_desc(2 * ((jstep >> 1) * 2048 + id) + (jstep & 1), a, F.ws);
#pragma unroll
                for (int kk = 0; kk < 32; ++kk) cv[kk] = cd.src[(size_t)kk * cd.ld + lane];
                if (cd.scale) csc = cd.scale[lane & 31]; }
            const f32x16 zz = {0.f, 0.f, 0.f, 0.f, 0.f, 0.f, 0.f, 0.f, 0.f, 0.f, 0.f, 0.f, 0.f, 0.f, 0.f, 0.f};
            const bf16x8 z8 = {0, 0, 0, 0, 0, 0, 0, 0}; const bool oddrow = (col & 1) != 0;
            const bf16x8 Ulo = oddrow ? z8 : Ua, Uhi = oddrow ? Ua : z8, Vlo = oddrow ? z8 : Va, Vhi = oddrow ? Va : z8;
            f32x16 bu0 = __builtin_amdgcn_mfma_f32_32x32x16_bf16(Ulo, Bf[0], zz, 0, 0, 0);  bu0 = __builtin_amdgcn_mfma_f32_32x32x16_bf16(Uhi, Bf[1], bu0, 0, 0, 0);
            f32x16 bu2 = __builtin_amdgcn_mfma_f32_32x32x16_bf16(Ulo, Bf[2], zz, 0, 0, 0);  bu2 = __builtin_amdgcn_mfma_f32_32x32x16_bf16(Uhi, Bf[3], bu2, 0, 0, 0);
            f32x16 bu1 = __builtin_amdgcn_mfma_f32_32x32x16_bf16(Vlo, Bf[0], zz, 0, 0, 0);  bu1 = __builtin_amdgcn_mfma_f32_32x32x16_bf16(Vhi, Bf[1], bu1, 0, 0, 0);
            f32x16 bu3 = __builtin_amdgcn_mfma_f32_32x32x16_bf16(Vlo, Bf[2], zz, 0, 0, 0);  bu3 = __builtin_amdgcn_mfma_f32_32x32x16_bf16(Vhi, Bf[3], bu3, 0, 0, 0);
            { f32x2s Rr2 = {R0r, R1r}, Ri2 = {R0i, R1i};
              scan_pairs<PASS>(bu0, bu2, bu1, bu3, (f32x2s){c0[0], c1[0]}, (f32x2s){c0[1], c1[1]}, (f32x2s){c0[2], c1[2]}, (f32x2s){c0[3], c1[3]}, Rr2, Ri2, hf);
              R0r = Rr2.x; R1r = Rr2.y; R0i = Ri2.x; R1i = Ri2.y; }
            if (PASS == 2) {
                LAS unsigned* sw = (LAS unsigned*)sl;
#pragma unroll
                for (int p = 0; p < 8; ++p) {
                    sw[(16 * hf + p) * 68 + col] = cvt_pk_bf16(bu0[2 * p], bu2[2 * p]); sw[(16 * hf + p) * 68 + 32 + col] = cvt_pk_bf16(bu0[2 * p + 1], bu2[2 * p + 1]);
                    sw[(16 * hf + 8 + p) * 68 + col] = cvt_pk_bf16(bu1[2 * p], bu3[2 * p]); sw[(16 * hf + 8 + p) * 68 + 32 + col] = cvt_pk_bf16(bu1[2 * p + 1], bu3[2 * p + 1]); }
                asm volatile("s_waitcnt lgkmcnt(0)" ::: "memory");
#pragma unroll
                for (int mt = 0; mt < 2; ++mt) {
                    f32x4 y = {0.f, 0.f, 0.f, 0.f};
#pragma unroll
                    for (int kb = 0; kb < 4; ++kb) { const bf16x8 Af = *(const LAS bf16x8*)(sl + ((16 * mt + (lane & 15)) * 68 + kb * 16 + 4 * (lane >> 4)) * 4);
                        y = __builtin_amdgcn_mfma_f32_16x16x32_bf16(Af, Cf[kb], y, 0, 0, 0); }
                    y = __builtin_amdgcn_mfma_f32_16x16x32_bf16(A2[mt], Df, y, 0, 0, 0);
#pragma unroll
                    for (int j = 0; j < 4; ++j) ys[(size_t)(t0 + 16 * mt + 4 * (lane >> 4) + j) * SW + g * NH + (lane & 15)] = (bf16_t)(cvt_pk_bf16(fgelu_tanh(y[j]), 0.f) & 0xffffu);
                }
                asm volatile("s_waitcnt lgkmcnt(0)" ::: "memory");
            }
            if (has_cv) conv_finish(cv, cd, csc, cscr, lane);
        }
        if (PASS == 1 && hf == 0) {
            *(float2*)(E + ((size_t)(r * NG + g) * NS + col) * 2) = make_float2(R0r, R0i);
            *(float2*)(E + ((size_t)(r * NG + g) * NS + 32 + col) * 2) = make_float2(R1r, R1i);
        }
    }
}

__device__ __forceinline__ void p6_route(const Frame& F, const Args& a) {
    const bf16_t* x1b = (const bf16_t*)(F.ws + WS_X1B); const bf16_t* wrt = (const bf16_t*)(F.ws + WS_WRT); float* rstd2 = (float*)(F.ws + WS_RSTD2);
    int* cnt = (int*)(F.ctl + CW_CNT); int* list = (int*)(F.ws + WS_LIST);
    int* tok_e = (int*)(F.ws + WS_TOK); int* tok_pos = tok_e + 2 * T; float* tok_w = (float*)(tok_pos + 2 * T);
    volatile LAS int* lcnt = (volatile LAS int*)(F.MISC + 96); volatile LAS int* lbase = (volatile LAS int*)(F.MISC + 128);
    constexpr int WP = 2064;
    LAS unsigned char* wl = F.lds;
    LAS float* lg = (LAS float*)(F.lds + 102400 + (F.wave & 3) * 4096);
    const int lane = F.lane; const bool active = F.wave < 4;
    { u32x4 t[12];
#pragma unroll
      for (int q = 0; q < 12; ++q) { const int p = F.tid + 512 * q; t[q] = *(const u32x4*)(wrt + (size_t)(p >> 7) * D + (p & 127) * 8); }
#pragma unroll
      for (int q = 0; q < 12; ++q) { const int p = F.tid + 512 * q; *(LAS u32x4*)(wl + (p >> 7) * WP + (p & 127) * 16) = t[q]; } }
    for (int blk = blockIdx.x; blk < T / 64; blk += F.G) {
        if (F.tid < 32) lcnt[F.tid] = 0;
        __syncthreads();
        const int tok0 = blk * 64 + (F.wave & 3) * 16;
        int e1 = 0, e2 = 0, rk1 = 0, rk2 = 0; float wt1 = 0.f, wt2 = 0.f;
        if (active) {
            f32x4 acc[3]; float ssq = 0.f;
#pragma unroll
            for (int n = 0; n < 3; ++n) acc[n] = (f32x4){0.f, 0.f, 0.f, 0.f};
            const bf16_t* arow = x1b + (size_t)(tok0 + (lane & 15)) * D + 8 * (lane >> 4);
            const LAS unsigned char* brow = wl + (lane & 15) * WP + 16 * (lane >> 4);
#pragma unroll 8
            for (int kb = 0; kb < 32; ++kb) {
                const u32x4 aw = *(const u32x4*)(arow + kb * 32);
                f32x4 p, q; unpack8(aw, p, q); ssq += (p[0] * p[0] + p[1] * p[1]) + (p[2] * p[2] + p[3] * p[3]) + (q[0] * q[0] + q[1] * q[1]) + (q[2] * q[2] + q[3] * q[3]);
                const bf16x8 Af = __builtin_bit_cast(bf16x8, aw);
#pragma unroll
                for (int n = 0; n < 3; ++n) { const bf16x8 Bfr = *(const LAS bf16x8*)(brow + n * 16 * WP + kb * 64);
                    acc[n] = __builtin_amdgcn_mfma_f32_16x16x32_bf16(Af, Bfr, acc[n], 0, 0, 0); }
            }
            ssq += __shfl_xor(ssq, 16); ssq += __shfl_xor(ssq, 32);
            const float rs = rsqrtf(ssq * (1.f / D) + EPS);
#pragma unroll
            for (int n = 0; n < 3; ++n)
#pragma unroll
                for (int j = 0; j < 4; ++j) lg[(4 * (lane >> 4) + j) * 52 + n * 16 + (lane & 15)] = acc[n][j];
            asm volatile("s_waitcnt lgkmcnt(0)" ::: "memory");
            if (lane < 16) {
                const LAS float* my = lg + lane * 52;
                float l0 = my[0] * rs + a.in[20][0], l1 = my[1] * rs + a.in[20][1], l2 = my[2] * rs + a.in[20][2], l3 = my[3] * rs + a.in[20][3];
                int gi = 0; float lmax = l0;
                if (l1 > lmax) { lmax = l1; gi = 1; } if (l2 > lmax) { lmax = l2; gi = 2; } if (l3 > lmax) { lmax = l3; gi = 3; }
                const float se = __expf(l0 - lmax) + __expf(l1 - lmax) + __expf(l2 - lmax) + __expf(l3 - lmax);
                const float pg = 1.f / se;
                float v1 = -3.0e38f, v2 = -3.0e38f; int i1 = 0, i2 = 0;
#pragma unroll
                for (int j = 0; j < 8; ++j) { const float vv = my[4 + gi * 8 + j] * rs + a.in[22][gi * 8 + j];
                    if (vv > v1) { v2 = v1; i2 = i1; v1 = vv; i1 = j; } else if (vv > v2) { v2 = vv; i2 = j; } }
                const float w1 = 1.f / (1.f + __expf(v2 - v1));
                e1 = gi * 8 + i1; e2 = gi * 8 + i2; wt1 = pg * w1; wt2 = pg * (1.f - w1);
                rk1 = __hip_atomic_fetch_add((LAS int*)&lcnt[e1], 1, __ATOMIC_RELAXED, __HIP_MEMORY_SCOPE_WORKGROUP);
                rk2 = __hip_atomic_fetch_add((LAS int*)&lcnt[e2], 1, __ATOMIC_RELAXED, __HIP_MEMORY_SCOPE_WORKGROUP);
                rstd2[tok0 + lane] = rs;
            }
        }
        __syncthreads();
        if (F.tid < 32) { const int c = lcnt[F.tid]; lbase[F.tid] = c ? __hip_atomic_fetch_add(&cnt[F.tid], c, __ATOMIC_RELAXED, __HIP_MEMORY_SCOPE_AGENT) : 0; }
        __syncthreads();
        if (active && lane < 16) { const int t = tok0 + lane; const int p1 = lbase[e1] + rk1, p2 = lbase[e2] + rk2;
            list[e1 * T + p1] = t; list[e2 * T + p2] = t;
            tok_e[2 * t] = e1; tok_e[2 * t + 1] = e2; tok_pos[2 * t] = p1; tok_pos[2 * t + 1] = p2; tok_w[2 * t] = wt1; tok_w[2 * t + 1] = wt2; }
        __syncthreads();
    }
}
__device__ __forceinline__ void tr64q(const float* __restrict__ src, int ld, int col0, int k0, const float* __restrict__ scale, float mul, unsigned char* __restrict__ dst, size_t drow0, int Kdst, LAS unsigned char* scr, int lane) {
    const float* s = src + (size_t)k0 * ld + col0 + lane;
#pragma unroll
    for (int hh = 0; hh < 2; ++hh) {
        float v[32];
#pragma unroll
        for (int kk = 0; kk < 32; ++kk) v[kk] = s[(size_t)(32 * hh + kk) * ld];
        if (scale) {
#pragma unroll
            for (int kk = 0; kk < 32; ++kk) v[kk] *= scale[k0 + 32 * hh + kk];
        }
#pragma unroll
        for (int c = 0; c < 2; ++c) { u32x4 o;
            o.x = cvt4_fp8(v[16 * c + 0] * mul, v[16 * c + 1] * mul, v[16 * c + 2] * mul, v[16 * c + 3] * mul); o.y = cvt4_fp8(v[16 * c + 4] * mul, v[16 * c + 5] * mul, v[16 * c + 6] * mul, v[16 * c + 7] * mul);
            o.z = cvt4_fp8(v[16 * c + 8] * mul, v[16 * c + 9] * mul, v[16 * c + 10] * mul, v[16 * c + 11] * mul); o.w = cvt4_fp8(v[16 * c + 12] * mul, v[16 * c + 13] * mul, v[16 * c + 14] * mul, v[16 * c + 15] * mul);
            *(LAS u32x4*)(scr + lane * 80 + 16 * (2 * hh + c)) = o; }
        asm volatile("s_waitcnt vmcnt(0)" ::: "memory");
    }
    asm volatile("s_waitcnt lgkmcnt(0)" ::: "memory");
#pragma unroll
    for (int j = 0; j < 4; ++j) { const int row = 16 * j + (lane >> 2); const u32x4 o = *(const LAS u32x4*)(scr + row * 80 + 16 * (lane & 3));
        *(u32x4*)(dst + (drow0 + row) * (size_t)Kdst + k0 + 16 * (lane & 3)) = o; }
    asm volatile("s_waitcnt lgkmcnt(0)" ::: "memory");
}
__device__ __forceinline__ void p6_convert(const Frame& F, const Args& a, int lo, int hi, int widx, int nwork) {
    LAS unsigned char* scr = F.lds + F.wave * 16384;
    unsigned char* Wgu_q = F.ws + WS_WGU; unsigned char* Wd_q = F.ws + WS_WD;
    constexpr int I_GU = NE * 16 * 16;
    for (int it = lo + widx; it < hi; it += nwork) {
        if (it < I_GU) { const int e = it / 256, r = it % 256, kb = r / 16, nb = r % 16, j0 = 64 * nb, pn = j0 >> 8, i = j0 & 255;
            tr64q((i < 128 ? a.in[23] : a.in[24]) + (size_t)e * D * EFF, EFF, 128 * pn + (i & 127), 64 * kb, a.in[18], 32.f, Wgu_q, (size_t)e * 1024 + j0, D, scr, F.lane); }
        else { const int q = it - I_GU, e = q / 128, r = q % 128, kb = r / 16, nb = r % 16;
            tr64q(a.in[25] + (size_t)e * EFF * D, D, 64 * nb, 64 * kb, nullptr, 16.f, Wd_q, (size_t)e * 1024 + 64 * nb, EFF, scr, F.lane); }
    }
}
__device__ __forceinline__ void load_tb(const Frame& F) {
    volatile LAS int* tb = (volatile LAS int*)(F.MISC + 16); volatile LAS int* lc = (volatile LAS int*)(F.MISC + 64);
    if (F.tid < 32) lc[F.tid] = (int)__hip_atomic_load(F.ctl + CW_CNT + F.tid, __ATOMIC_RELAXED, __HIP_MEMORY_SCOPE_AGENT);
    __syncthreads();
    if (F.tid == 0) { int s = 0; for (int e = 0; e < 32; ++e) { tb[e] = s; s += (lc[e] + 255) >> 8; } tb[32] = s; }
    __syncthreads();
}
__device__ __forceinline__ void p9_final(const Frame& F, const Args& a) {
    const LAS int* tb = (const LAS int*)(F.MISC + 16);
    const int* tok_e = (const int*)(F.ws + WS_TOK); const int* tok_pos = tok_e + 2 * T; const float* tok_w = (const float*)(tok_pos + 2 * T);
    const bf16_t* Y = (const bf16_t*)(F.ws + WS_Y); const bf16_t* x1b = (const bf16_t*)(F.ws + WS_X1B); const float* gf = a.in[26]; float* out = a.out;
    const int gw = blockIdx.x * 8 + F.wave, NGW = F.G * 8;
    for (int tq = 2 * gw; tq < T; tq += 2 * NGW) {
        int s1[2], s2[2]; float w1[2], w2[2];
#pragma unroll
        for (int q = 0; q < 2; ++q) { const int t = tq + q; s1[q] = 256 * tb[tok_e[2 * t]] + tok_pos[2 * t]; s2[q] = 256 * tb[tok_e[2 * t + 1]] + tok_pos[2 * t + 1]; w1[q] = tok_w[2 * t]; w2[q] = tok_w[2 * t + 1]; }
        u32x4 xw[2][2], y1[2][2], y2[2][2];
#pragma unroll
        for (int q = 0; q < 2; ++q)
#pragma unroll
            for (int j = 0; j < 2; ++j) { const int c = 8 * F.lane + 512 * j; xw[q][j] = *(const u32x4*)(x1b + (size_t)(tq + q) * D + c);
                y1[q][j] = *(const u32x4*)(Y + (size_t)s1[q] * D + c); y2[q][j] = *(const u32x4*)(Y + (size_t)s2[q] * D + c); }
        f32x4 va[2][2], vb[2][2]; float ss[2];
#pragma unroll
        for (int q = 0; q < 2; ++q) { ss[q] = 0.f;
#pragma unroll
            for (int j = 0; j < 2; ++j) { f32x4 xa, xb_, ya, yb, za, zb; unpack8(xw[q][j], xa, xb_); unpack8(y1[q][j], ya, yb); unpack8(y2[q][j], za, zb);
                va[q][j] = xa + w1[q] * ya + w2[q] * za; vb[q][j] = xb_ + w1[q] * yb + w2[q] * zb;
                ss[q] += (va[q][j][0] * va[q][j][0] + va[q][j][1] * va[q][j][1]) + (va[q][j][2] * va[q][j][2] + va[q][j][3] * va[q][j][3]) + (vb[q][j][0] * vb[q][j][0] + vb[q][j][1] * vb[q][j][1]) + (vb[q][j][2] * vb[q][j][2] + vb[q][j][3] * vb[q][j][3]); } }
#pragma unroll
        for (int o = 1; o < 64; o <<= 1) { ss[0] += __shfl_xor(ss[0], o); ss[1] += __shfl_xor(ss[1], o); }
#pragma unroll
        for (int q = 0; q < 2; ++q) { const float rs = rsqrtf(ss[q] * (1.f / D) + EPS);
#pragma unroll
            for (int j = 0; j < 2; ++j) { const int c = 8 * F.lane + 512 * j;
                *(f32x4*)(out + (size_t)(tq + q) * D + c) = va[q][j] * rs * *(const f32x4*)(gf + c); *(f32x4*)(out + (size_t)(tq + q) * D + c + 4) = vb[q][j] * rs * *(const f32x4*)(gf + c + 4); } }
        asm volatile("s_waitcnt vmcnt(8)" ::: "memory");
    }
}

__global__ void __launch_bounds__(512, 2) mega_fwd(Args args) {
    extern __shared__ __attribute__((aligned(16))) unsigned char lds_raw[];
    Frame F;
    F.lds = (LAS unsigned char*)lds_raw; F.MISC = (volatile LAS unsigned*)(F.lds + MISC_OFF);
    F.tid = threadIdx.x; F.lane = F.tid & 63; F.wave = __builtin_amdgcn_readfirstlane(F.tid >> 6); F.G = gridDim.x;
    F.ws = args.ws; F.ctl = (unsigned*)(args.ws + WS_CTL);
    for (int u = F.tid; u < (LDS_BYTES - MISC_OFF) / 4; u += 512) ((LAS unsigned*)(F.lds + MISC_OFF))[u] = 0u;
    __syncthreads();
    XcdBarrier bar; bar.bar = F.ctl + CW_BAR; bar.x = 0; bar.st = nullptr;
    if (args.use_bar) bar = xcd_barrier_post(F.ctl + CW_BAR, F.MISC + 0);
    const int lo = args.ph_lo, hi = args.ph_hi;
#define IN(k) (lo <= (k) && (k) < hi)
#define SEAM(k) do { if (IN(k) && IN((k) + 1)) xcd_barrier(bar); } while (0)
    unsigned char* ws = args.ws;
    const int c = (int)blockIdx.x;

    if (IN(0)) { p0_prologue(F, args); }
    SEAM(0);
    if (IN(1)) {
        pg8::DenseOrder S{(const char*)(ws + WS_XB), (const char*)(ws + WS_WIN), D, T / 256, INC / 256, 1, F.G, c};
        EpiWin E{(const float*)(ws + WS_RSTD1), (bf16_t*)(ws + WS_V), (bf16_t*)(ws + WS_BG), (bf16_t*)(ws + WS_UB), (bf16_t*)(ws + WS_GATES), args.in[16]};
        pg8::gemm_phase<EpiWin, pg8::DenseOrder, false, true>(F.lds, D, S, E);
        { const int nu = (T / 256) * (INC / 256), rem = nu % F.G; if (rem != 0 && c >= rem) p6_convert(F, args, 0, CV_EARLY, (c - rem) * 8 + F.wave, (F.G - rem) * 8); }
    }
    SEAM(1);
    if (IN(2)) { p2_conv(F, args); ssm_pass<1>(F, args); }
    SEAM(2);
    if (IN(3)) { ssm_pass<2>(F, args); }
    SEAM(3);
    if (IN(4)) {
        { pg8::DenseOrder S{(const char*)(ws + WS_YS), (const char*)(ws + WS_WGLU), SW, T / 256, 4, 2, F.G, c};
          EpiGlu E{(const bf16_t*)(ws + WS_GATES), (bf16_t*)(ws + WS_MB)};
          pg8::gemm_phase<EpiGlu, pg8::DenseOrder, false, true>(F.lds, SW, S, E); }
        asm volatile("s_waitcnt vmcnt(0)" ::: "memory"); __syncthreads();
        { pg8::DenseOrder S{(const char*)(ws + WS_Z), (const char*)(ws + WS_WC), D, T / 256, 4, 1, F.G, c};
          EpiMix E{(const bf16_t*)(ws + WS_GATES), (const bf16_t*)(ws + WS_MB), (bf16_t*)(ws + WS_MIXED)};
          pg8::gemm_phase<EpiMix, pg8::DenseOrder, false, true>(F.lds, D, S, E); }
    }
    SEAM(4);
    if (IN(5)) {
        pg8::DenseOrder S{(const char*)(ws + WS_MIXED), (const char*)(ws + WS_WO), D, T / 256, 4, 1, F.G, c};
        EpiX1 E{args.in[0], args.out, (bf16_t*)(ws + WS_X1B), ws + WS_X1Q};
        pg8::gemm_phase<EpiX1, pg8::DenseOrder, false, true>(F.lds, D, S, E);
    }
    SEAM(5);
    if (IN(6)) { p6_route(F, args); { const int nu = (T / 256) * (INC / 256), rem = nu % F.G; p6_convert(F, args, rem != 0 ? CV_EARLY : 0, NE * 256 + NE * 128, blockIdx.x * 8 + F.wave, F.G * 8); } }
    SEAM(6);
    if (IN(7)) {
        load_tb(F);
        pg8::MoEOrder S{(const LAS int*)(F.MISC + 16), (const LAS int*)(F.MISC + 64), (const int*)(ws + WS_LIST), (const char*)(ws + WS_X1Q), (const char*)(ws + WS_WGU), D / 2, (size_t)1024 * D, F.G, c, true, (const char*)(ws + WS_WGU), 64};
        EpiUp E{(const int*)(ws + WS_LIST), (const float*)(ws + WS_RSTD2), ws + WS_HMID};
        pg8::gemm_phase<EpiUp, pg8::MoEOrder, true, true, true>(F.lds, D / 2, S, E);
    }
    SEAM(7);
    if (IN(8)) {
        load_tb(F);
        pg8::MoEOrder S{(const LAS int*)(F.MISC + 16), (const LAS int*)(F.MISC + 64), (const int*)(ws + WS_LIST), (const char*)(ws + WS_HMID), (const char*)(ws + WS_WD), EFF / 2, (size_t)1024 * EFF, F.G, c, false, (const char*)(ws + WS_WD2), WD_SPLIT};
        EpiDown E{(bf16_t*)(ws + WS_Y)};
        pg8::gemm_phase<EpiDown, pg8::MoEOrder, false, true, true>(F.lds, EFF / 2, S, E);
    }
    SEAM(8);
    if (IN(9)) { load_tb(F); p9_final(F, args); }
#undef IN
#undef SEAM
}

#ifndef MK_MODE
#define MK_MODE 2
#endif
extern "C" void kernel_launch(void* const* d_in, const int* in_sizes, int n_in, void* d_out, int out_size, void* d_ws, size_t ws_size, hipStream_t stream) {
    static int grid = 0;
    if (grid == 0) {
        if (ws_size < WS_END) { fprintf(stderr, "kernel_launch: workspace too small (%zu < %zu)\n", ws_size, (size_t)WS_END); grid = -1; return; }
        int dev = 0, cus = 0, per_cu = 0;
        (void)hipGetDevice(&dev); (void)hipDeviceGetAttribute(&cus, hipDeviceAttributeMultiprocessorCount, dev);
        (void)hipFuncSetAttribute((const void*)mega_fwd, hipFuncAttributeMaxDynamicSharedMemorySize, LDS_BYTES);
        (void)hipOccupancyMaxActiveBlocksPerMultiprocessor(&per_cu, (const void*)mega_fwd, 512, LDS_BYTES);
        (void)hipGetLastError();
        grid = cus * (per_cu < 1 ? 1 : 1);
    }
    if (grid < 0) return;
    (void)hipMemsetAsync((char*)d_ws + WS_CTL, 0, CTL_BYTES, stream);
    Args a{};
    for (int i = 0; i < 27; ++i) a.in[i] = (const float*)d_in[i];
    a.out = (float*)d_out; a.ws = (unsigned char*)d_ws;
#if MK_MODE == 2
    a.ph_lo = 0; a.ph_hi = 10; a.use_bar = 1;
    hipLaunchKernelGGL(mega_fwd, dim3(grid), dim3(512), LDS_BYTES, stream, a);
#else
    const int nfast = (MK_MODE == 1) ? 6 : 10;
    for (int p = 0; p < nfast; ++p) { a.ph_lo = p; a.ph_hi = p + 1; a.use_bar = 0; hipLaunchKernelGGL(mega_fwd, dim3(grid), dim3(512), LDS_BYTES, stream, a); }
#if MK_MODE == 1
    {
        using namespace nv;
        float* out = (float*)d_out; char* ws = (char*)d_ws; const size_t MiB_ = 1u << 20;
        float* hbuf = (float*)(ws); float* B1 = (float*)(ws + 64 * MiB_); float* B2 = (float*)(ws + 128 * MiB_);
        char* misc = ws + 256 * MiB_;
        int* cnt = (int*)(misc + 2 * MiB_); int* off = cnt + 64; int* list = (int*)(misc + 2 * MiB_ + 4096);
        int* tok_e = (int*)(misc + 5 * MiB_); int* tok_pos = tok_e + 2 * nv::T; float* tok_w = (float*)(tok_pos + 2 * nv::T);
        const dim3 b256(256);
        const float* norm_ffn = (const float*)d_in[18]; const float* wrg = (const float*)d_in[19]; const float* brg = (const float*)d_in[20]; const float* wre = (const float*)d_in[21]; const float* bre = (const float*)d_in[22];
        const float* w_gate = (const float*)d_in[23]; const float* w_up = (const float*)d_in[24]; const float* w_down = (const float*)d_in[25]; const float* norm_final = (const float*)d_in[26];
        hipLaunchKernelGGL(k_rmsnorm, dim3(nv::T / 4), b256, 0, stream, out, norm_ffn, hbuf, nv::T);
        (void)hipMemsetAsync(cnt, 0, 512, stream);
        hipLaunchKernelGGL(k_route, dim3(nv::T / 4), b256, 0, stream, hbuf, wrg, brg, wre, bre, cnt, list, tok_e, tok_pos, tok_w);
        hipLaunchKernelGGL(k_offsets, dim3(1), dim3(64), 0, stream, cnt, off);
        float* Hm = B1; float* Yd = B2;
        for (int e = 0; e < nv::NE; ++e)
            hipLaunchKernelGGL(k_gemm<2>, dim3(nv::EFF / 64, nv::T / 64), b256, 0, stream, hbuf, nv::D, list + e * nv::T, nullptr, w_gate + (size_t)e * nv::D * nv::EFF, w_up + (size_t)e * nv::D * nv::EFF, nv::EFF,
                               Hm, nv::EFF, off + e, nullptr, 0, cnt + e, nv::EFF, nv::D);
        for (int e = 0; e < nv::NE; ++e)
            hipLaunchKernelGGL(k_gemm<0>, dim3(nv::D / 64, nv::T / 64), b256, 0, stream, Hm, nv::EFF, nullptr, off + e, w_down + (size_t)e * nv::EFF * nv::D, nullptr, nv::D,
                               Yd, nv::D, off + e, nullptr, 0, cnt + e, nv::D, nv::EFF);
        hipLaunchKernelGGL(k_final, dim3(nv::T / 4), b256, 0, stream, out, Yd, off, tok_e, tok_pos, tok_w, norm_final);
    }
#endif
#endif
}
```

```cpp
#define CV_EARLY_ITEMS 0
#include <hip/hip_runtime.h>
#include <stdint.h>
#include <cstdio>

namespace nv {
constexpr int T = 16384, D = 1024, SW = 512, NG = 32, NS = 64, NH = 16, INC = 5632, NE = 32, EFF = 512;
constexpr float EPS = 1e-6f;

__device__ __forceinline__ float wave_sum(float v) {
#pragma unroll
    for (int o = 1; o < 64; o <<= 1) v += __shfl_xor(v, o);
    return v;
}
__device__ __forceinline__ float sigmoidf_(float x) { return 1.f / (1.f + __expf(-x)); }
__device__ __forceinline__ float gelu_tanh(float x) { const float u = 0.7978845608028654f * (x + 0.044715f * x * x * x); return 0.5f * x * (1.f + tanhf(u)); }

__global__ __launch_bounds__(256) void k_rmsnorm(const float* x, const float* g, float* y, int rows) {
    const int row = blockIdx.x * 4 + (threadIdx.x >> 6), lane = threadIdx.x & 63;
    if (row >= rows) return;
    const float4* xr = (const float4*)(x + (size_t)row * D);
    float4 v[4]; float s = 0.f;
#pragma unroll
    for (int j = 0; j < 4; ++j) { v[j] = xr[lane + 64 * j]; s += v[j].x * v[j].x + v[j].y * v[j].y + v[j].z * v[j].z + v[j].w * v[j].w; }
    const float r = rsqrtf(wave_sum(s) * (1.f / D) + EPS);
    float4* yr = (float4*)(y + (size_t)row * D);
#pragma unroll
    for (int j = 0; j < 4; ++j) { const float4 gg = ((const float4*)g)[lane + 64 * j]; yr[lane + 64 * j] = make_float4(v[j].x * r * gg.x, v[j].y * r * gg.y, v[j].z * r * gg.z, v[j].w * r * gg.w); }
}

template <int MODE>
__global__ __launch_bounds__(256) void k_gemm(const float* A, int lda, const int* gather, const int* aoff_dev, const float* B, const float* B2, int ldb,
                                              float* C, int ldc, const int* coff_dev, const float* resid, int M, const int* Mdev, int N, int K) {
    __shared__ float As[16][68];
    __shared__ float Bs[16][64];
    __shared__ float Bs2[16][64];
    if (Mdev) M = *Mdev;
    const int row0 = blockIdx.y * 64, col0 = blockIdx.x * 64;
    if (row0 >= M) return;
    const int aoff = aoff_dev ? *aoff_dev : 0, coff = coff_dev ? *coff_dev : 0;
    const int tid = threadIdx.x, ty = tid >> 4, tx = tid & 15;
    const int lr = tid >> 2, lk = (tid & 3) * 4;
    const int bk = tid >> 4, bn = (tid & 15) * 4;
    int arow = -1;
    if (row0 + lr < M) arow = gather ? gather[row0 + lr] : (aoff + row0 + lr);
    float acc[4][4] = {}, acc2[4][4] = {};
    for (int k0 = 0; k0 < K; k0 += 16) {
        float4 av = make_float4(0.f, 0.f, 0.f, 0.f);
        if (arow >= 0) av = *(const float4*)(A + (size_t)arow * lda + k0 + lk);
        As[lk + 0][lr] = av.x; As[lk + 1][lr] = av.y; As[lk + 2][lr] = av.z; As[lk + 3][lr] = av.w;
        *(float4*)&Bs[bk][bn] = *(const float4*)(B + (size_t)(k0 + bk) * ldb + col0 + bn);
        if (MODE >= 2) *(float4*)&Bs2[bk][bn] = *(const float4*)(B2 + (size_t)(k0 + bk) * ldb + col0 + bn);
        __syncthreads();
#pragma unroll
        for (int k = 0; k < 16; ++k) {
            const float4 a = *(const float4*)&As[k][ty * 4];
            const float4 b = *(const float4*)&Bs[k][tx * 4];
            const float aa[4] = {a.x, a.y, a.z, a.w}, bb[4] = {b.x, b.y, b.z, b.w};
#pragma unroll
            for (int i = 0; i < 4; ++i)
#pragma unroll
                for (int j = 0; j < 4; ++j) acc[i][j] += aa[i] * bb[j];
            if (MODE >= 2) {
                const float4 b2 = *(const float4*)&Bs2[k][tx * 4]; const float cc[4] = {b2.x, b2.y, b2.z, b2.w};
#pragma unroll
                for (int i = 0; i < 4; ++i)
#pragma unroll
                    for (int j = 0; j < 4; ++j) acc2[i][j] += aa[i] * cc[j];
            }
        }
        __syncthreads();
    }
#pragma unroll
    for (int i = 0; i < 4; ++i) {
        const int r = row0 + ty * 4 + i;
        if (r >= M) continue;
        float o[4];
#pragma unroll
        for (int j = 0; j < 4; ++j) {
            float v = acc[i][j];
            if (MODE == 2) v = (v * sigmoidf_(v)) * acc2[i][j];
            if (MODE == 3) v = v * sigmoidf_(acc2[i][j]);
            o[j] = v;
        }
        const size_t ci = (size_t)(coff + r) * ldc + col0 + tx * 4;
        if (MODE == 1) { const float4 rr = *(const float4*)(resid + ci); o[0] += rr.x; o[1] += rr.y; o[2] += rr.z; o[3] += rr.w; }
        *(float4*)(C + ci) = make_float4(o[0], o[1], o[2], o[3]);
    }
}

__global__ __launch_bounds__(256) void k_conv(const float* xc, const float* cg, float* bg_z, const float* cw, const float* cb) {
    const size_t i = (size_t)blockIdx.x * 256 + threadIdx.x;
    const int t = (int)(i / D), c = (int)(i % D);
    float y = cb[c] + cw[2 * D + c] * (cg[i] * xc[i]);
    if (t >= 1) y += cw[1 * D + c] * (cg[i - D] * xc[i - D]);
    if (t >= 2) y += cw[0 * D + c] * (cg[i - 2 * D] * xc[i - 2 * D]);
    bg_z[i] = bg_z[i] * y;
}

struct cplx { float re, im; };
__device__ __forceinline__ cplx cmul(cplx a, cplx b) { return {a.re * b.re - a.im * b.im, a.re * b.im + a.im * b.re}; }

__device__ __forceinline__ void ssm_consts(const float* a_re, const float* a_im, const float* log_dt, int g, int n, cplx& abar, cplx& coef, cplx& a256) {
    const double lr = a_re[g * NS + n], li = a_im[g * NS + n], dt = exp((double)log_dt[g]);
    const double er = exp(lr * dt), cr = er * cos(li * dt), ci = er * sin(li * dt);
    abar = {(float)cr, (float)ci};
    const double nr = cr - 1.0, ni = ci, den = lr * lr + li * li;
    coef = {(float)((nr * lr + ni * li) / den), (float)((ni * lr - nr * li) / den)};
    const double e2 = exp(lr * dt * 256.0);
    a256 = {(float)(e2 * cos(li * dt * 256.0)), (float)(e2 * sin(li * dt * 256.0))};
}

template <int PASS>
__global__ __launch_bounds__(64) void k_ssm(const float* u, const float* a_re, const float* a_im, const float* log_dt, const float* b_re, const float* b_im,
                                            const float* c_re, const float* c_im, const float* dsk, float* E, const float* Cin, float* ys) {
    __shared__ float part[16][65];
    const int g = blockIdx.x, r = blockIdx.y, n = threadIdx.x;
    cplx abar, coef, a256; ssm_consts(a_re, a_im, log_dt, g, n, abar, coef, a256);
    cplx bb[16]; float cre[16], cim[16];
#pragma unroll
    for (int h = 0; h < 16; ++h) {
        bb[h] = cmul(coef, cplx{b_re[(g * NS + n) * NH + h], b_im[(g * NS + n) * NH + h]});
        cre[h] = c_re[(g * NH + h) * NS + n]; cim[h] = c_im[(g * NH + h) * NS + n];
    }
    cplx s = {0.f, 0.f};
    if (PASS == 2) s = {Cin[((size_t)(r * NG + g) * NS + n) * 2], Cin[((size_t)(r * NG + g) * NS + n) * 2 + 1]};
    for (int t = r * 256; t < r * 256 + 256; ++t) {
        const float* ut = u + (size_t)t * SW + g * NH;
        cplx bu = {0.f, 0.f};
#pragma unroll
        for (int h = 0; h < 16; ++h) { const float uv = ut[h]; bu.re += bb[h].re * uv; bu.im += bb[h].im * uv; }
        s = cmul(abar, s); s.re += bu.re; s.im += bu.im;
        if (PASS == 2) {
#pragma unroll
            for (int h = 0; h < 16; ++h) part[h][n] = cre[h] * s.re - cim[h] * s.im;
            __syncthreads();
            const int h = n & 15, q = n >> 4; float y = 0.f;
#pragma unroll
            for (int j = 0; j < 16; ++j) y += part[h][q * 16 + j];
            y += __shfl_xor(y, 16); y += __shfl_xor(y, 32);
            if (q == 0) { const float v = y + dsk[g * NH + h] * ut[h]; ys[(size_t)t * SW + g * NH + h] = gelu_tanh(v); }
            __syncthreads();
        }
    }
    if (PASS == 1) { E[((size_t)(r * NG + g) * NS + n) * 2] = s.re; E[((size_t)(r * NG + g) * NS + n) * 2 + 1] = s.im; }
}
__global__ __launch_bounds__(64) void k_ssm_carry(const float* a_re, const float* a_im, const float* log_dt, const float* E, float* Cin) {
    const int g = blockIdx.x, n = threadIdx.x;
    cplx abar, coef, a256; ssm_consts(a_re, a_im, log_dt, g, n, abar, coef, a256);
    cplx run = {0.f, 0.f};
    for (int r = 0; r < T / 256; ++r) {
        const size_t i = ((size_t)(r * NG + g) * NS + n) * 2;
        Cin[i] = run.re; Cin[i + 1] = run.im;
        run = cmul(a256, run); run.re += E[i]; run.im += E[i + 1];
    }
}

template <int ADD>
__global__ __launch_bounds__(256) void k_mix(const float* gl, const float* bias, const float* y, float* m) {
    const size_t i = (size_t)blockIdx.x * 256 + threadIdx.x; const int c = (int)(i % D);
    const float v = sigmoidf_(gl[i] + bias[c]) * y[i];
    m[i] = ADD ? m[i] + v : v;
}

__global__ __launch_bounds__(256) void k_route(const float* h2, const float* wrg, const float* brg, const float* wre, const float* bre,
                                               int* cnt, int* list, int* tok_e, int* tok_pos, float* tok_w) {
    const int t = blockIdx.x * 4 + (threadIdx.x >> 6), lane = threadIdx.x & 63;
    float acc[36];
#pragma unroll
    for (int j = 0; j < 36; ++j) acc[j] = 0.f;
    for (int k = lane; k < D; k += 64) {
        const float hv = h2[(size_t)t * D + k];
#pragma unroll
        for (int j = 0; j < 4; ++j) acc[j] += hv * wrg[k * 4 + j];
#pragma unroll
        for (int j = 0; j < 32; ++j) acc[4 + j] += hv * wre[k * 32 + j];
    }
#pragma unroll
    for (int j = 0; j < 36; ++j) acc[j] = wave_sum(acc[j]);
    if (lane == 0) {
        float lg[4]; int gi = 0; float lmax;
#pragma unroll
        for (int j = 0; j < 4; ++j) { lg[j] = acc[j] + brg[j]; }
        lmax = lg[0];
#pragma unroll
        for (int j = 1; j < 4; ++j) if (lg[j] > lmax) { lmax = lg[j]; gi = j; }
        float se = 0.f;
#pragma unroll
        for (int j = 0; j < 4; ++j) se += __expf(lg[j] - lmax);
        const float pg = 1.f / se;
        float v1 = -3.0e38f, v2 = -3.0e38f; int i1 = 0, i2 = 0;
#pragma unroll
        for (int j = 0; j < 8; ++j) { float v = 0.f;
#pragma unroll
            for (int q = 0; q < 4; ++q) if (q == gi) v = acc[4 + q * 8 + j] + bre[q * 8 + j];
            if (v > v1) { v2 = v1; i2 = i1; v1 = v; i1 = j; } else if (v > v2) { v2 = v; i2 = j; } }
        const float w1 = 1.f / (1.f + __expf(v2 - v1)), w2 = 1.f - w1;
        const int e1 = gi * 8 + i1, e2 = gi * 8 + i2;
        const int p1 = atomicAdd(&cnt[e1], 1), p2 = atomicAdd(&cnt[e2], 1);
        list[e1 * T + p1] = t; list[e2 * T + p2] = t;
        tok_e[t * 2] = e1; tok_e[t * 2 + 1] = e2; tok_pos[t * 2] = p1; tok_pos[t * 2 + 1] = p2;
        tok_w[t * 2] = pg * w1; tok_w[t * 2 + 1] = pg * w2;
    }
}
__global__ void k_offsets(const int* cnt, int* off) { if (threadIdx.x == 0) { int s = 0; for (int e = 0; e < NE; ++e) { off[e] = s; s += cnt[e]; } } }

__global__ __launch_bounds__(256) void k_final(float* out, const float* Y, const int* off, const int* tok_e, const int* tok_pos, const float* tok_w, const float* g) {
    const int t = blockIdx.x * 4 + (threadIdx.x >> 6), lane = threadIdx.x & 63;
    const int s1 = off[tok_e[t * 2]] + tok_pos[t * 2], s2 = off[tok_e[t * 2 + 1]] + tok_pos[t * 2 + 1];
    const float w1 = tok_w[t * 2], w2 = tok_w[t * 2 + 1];
    float4* xr = (float4*)(out + (size_t)t * D);
    const float4* y1 = (const float4*)(Y + (size_t)s1 * D); const float4* y2 = (const float4*)(Y + (size_t)s2 * D);
    float4 v[4]; float s = 0.f;
#pragma unroll
    for (int j = 0; j < 4; ++j) { const float4 a = xr[lane + 64 * j], b = y1[lane + 64 * j], c = y2[lane + 64 * j];
        v[j] = make_float4(a.x + w1 * b.x + w2 * c.x, a.y + w1 * b.y + w2 * c.y, a.z + w1 * b.z + w2 * c.z, a.w + w1 * b.w + w2 * c.w);
        s += v[j].x * v[j].x + v[j].y * v[j].y + v[j].z * v[j].z + v[j].w * v[j].w; }
    const float r = rsqrtf(wave_sum(s) * (1.f / D) + EPS);
#pragma unroll
    for (int j = 0; j < 4; ++j) { const float4 gg = ((const float4*)g)[lane + 64 * j]; xr[lane + 64 * j] = make_float4(v[j].x * r * gg.x, v[j].y * r * gg.y, v[j].z * r * gg.z, v[j].w * r * gg.w); }
}
}

#define LAS __attribute__((address_space(3)))
typedef unsigned short bf16_t;
typedef short bf16x8 __attribute__((ext_vector_type(8)));
typedef float f32x4 __attribute__((ext_vector_type(4)));
typedef float f32x16 __attribute__((ext_vector_type(16)));
typedef unsigned u32x4 __attribute__((ext_vector_type(4)));
typedef unsigned u32x2 __attribute__((ext_vector_type(2)));

constexpr int T = 16384, D = 1024, SW = 512, NG = 32, NS = 64, NH = 16, INC = 5632, NE = 32, EFF = 512;
constexpr float EPS = 1e-6f;

typedef __bf16 bf16x2_t __attribute__((ext_vector_type(2)));
typedef float f32x2c_t __attribute__((ext_vector_type(2)));
__device__ __forceinline__ unsigned cvt_pk_bf16(float lo, float hi) { const f32x2c_t v = {lo, hi}; return __builtin_bit_cast(unsigned, __builtin_convertvector(v, bf16x2_t)); }
__device__ __forceinline__ unsigned cvt4_fp8(float a, float b, float c, float d) { int w = __builtin_amdgcn_cvt_pk_fp8_f32(a, b, 0, false); w = __builtin_amdgcn_cvt_pk_fp8_f32(c, d, w, true); return (unsigned)w; }
__device__ __forceinline__ float bf_lo(unsigned w) { return __uint_as_float(w << 16); }
__device__ __forceinline__ float bf_hi(unsigned w) { return __uint_as_float(w & 0xffff0000u); }
__device__ __forceinline__ float fsigmoid(float x) { return __builtin_amdgcn_rcpf(1.f + __builtin_amdgcn_exp2f(-1.4426950408889634f * x)); }
__device__ __forceinline__ float fsilu(float x) { return x * fsigmoid(x); }
__device__ __forceinline__ float fgelu_tanh(float x) { const float u = 0.7978845608028654f * (x + 0.044715f * x * x * x); return x * fsigmoid(2.f * u); }
__device__ __forceinline__ float wave_sum64(float v) {
#pragma unroll
    for (int o = 1; o < 64; o <<= 1) v += __shfl_xor(v, o);
    return v;
}

namespace pg8 {
constexpr int BM = 256, BK = 64, HALF = 128, HTB = HALF * BK * 2, STAGE_BYTES = 8 * HTB, NXCD = 8, WGM = 8;
__host__ __device__ __forceinline__ int lds_byte(int r, int c) { const int st = (r >> 4) * 2 + (c >> 5), rr = r & 15, cc = c & 31, ob = rr * 64 + cc * 2; return st * 1024 + (ob ^ (((ob >> 9) & 1) << 5)); }
__host__ __device__ __forceinline__ void stage_rc(int b, int& R, int& C) { const int st = b / 1024, sb = b % 1024, swz = sb ^ (((sb >> 9) & 1) << 5); R = (st >> 1) * 16 + swz / 64; C = (st & 1) * 32 + (swz % 64) / 2; }
__host__ __device__ __forceinline__ int perm32(int rho) { const int n = rho >> 4, i = rho & 15; return 8 * (i >> 2) + 4 * n + (i & 3); }

struct Unit { int pm, pn, e, nrow, srow; };

__device__ __forceinline__ void tile_map(int L, int nM, int nN, int& pm, int& pn) {
    const int nwg = nM * nN; int wgid = L;
    { const int q = nwg / NXCD, r = nwg % NXCD, xcd = wgid % NXCD, off = wgid / NXCD; wgid = (xcd < r ? xcd * (q + 1) : r * (q + 1) + (xcd - r) * q) + off; }
    const int nig = WGM * nN, gid = wgid / nig, fm = gid * WGM, gsz = (nM - fm) < WGM ? (nM - fm) : WGM;
    pm = fm + ((wgid % nig) % gsz); pn = (wgid % nig) / gsz;
}
struct DenseOrder {
    const char* A; const char* Bt; int K, nM, nNt, sub, G, c;
    __device__ __forceinline__ bool next(int i, Unit& u) const {
        const int L = (i / sub) * G + c; if (L >= nM * nNt) return false;
        int pm, pn; tile_map(L, nM, nNt, pm, pn); u.pm = pm; u.pn = pn * sub + (i % sub); u.e = 0; u.nrow = 256; u.srow = 0; return true;
    }
    __device__ __forceinline__ const char* a_base(const Unit& u) const { return A + (size_t)u.pm * (size_t)(BM * 2) * K; }
    __device__ __forceinline__ const char* b_base(const Unit& u) const { return Bt + (size_t)u.pn * (size_t)(BM * 2) * K; }
    __device__ __forceinline__ unsigned a_row(const Unit&, int r) const { return (unsigned)r; }
};
struct MoEOrder {
    const LAS int* tb; const LAS int* lc; const int* list; const char* A; const char* Bt; int K; size_t bstride; int G, c; bool gather; const char* Bt2; int esplit;
    __device__ __forceinline__ bool next(int i, Unit& u) const {
        const int L = i * G + c; const int ntile = tb[32]; if (L >= ntile * 4) return false;
        const int tt = L >> 2; int e = 0;
#pragma unroll 1
        for (int q = 1; q < 32; ++q) if (tb[q] <= tt) e = q;
        e = __builtin_amdgcn_readfirstlane(e);
        u.e = e; u.pm = tt - tb[e]; u.pn = L & 3; const int rem = lc[e] - 256 * u.pm; u.nrow = rem < 256 ? rem : 256; u.srow = 256 * tt; return true;
    }
    __device__ __forceinline__ const char* a_base(const Unit& u) const { return gather ? A : A + (size_t)u.srow * 2 * K; }
    __device__ __forceinline__ const char* b_base(const Unit& u) const { return (u.e < esplit ? Bt + (size_t)u.e * bstride : Bt2 + (size_t)(u.e - esplit) * bstride) + (size_t)u.pn * (size_t)(BM * 2) * K; }
    __device__ __forceinline__ unsigned a_row(const Unit& u, int r) const { return r < u.nrow ? (unsigned)list[u.e * T + 256 * u.pm + r] : 0u; }
};

typedef int v8i_t __attribute__((ext_vector_type(8)));
typedef int v4i_t __attribute__((ext_vector_type(4)));
__device__ __forceinline__ v8i_t cat8(const bf16x8 lo, const bf16x8 hi) { const v4i_t a = __builtin_bit_cast(v4i_t, lo), b = __builtin_bit_cast(v4i_t, hi); return __builtin_shufflevector(a, b, 0, 1, 2, 3, 4, 5, 6, 7); }
template <class Epi, class Sched, bool GATHER, bool ALIGN_EPI, bool FP8 = false>
__device__ __forceinline__ void gemm_phase(LAS unsigned char* lds, const int K, const Sched& S, const Epi& E) {
    const int tid = threadIdx.x, wid = __builtin_amdgcn_readfirstlane(tid >> 6), lane = tid & 63, wr = wid >> 2, wc = wid & 3, fr = lane & 15, fq = lane >> 4;
    const int nt = K / BK;
    unsigned voffB[2], vA[2][2], nvA[2][2]; int Rr[2], Cc[2];
#pragma unroll
    for (int i = 0; i < 2; ++i) { int R, C; stage_rc(tid * 16 + i * 8192, R, C); const int Rb = Epi::PERM ? ((R & ~31) + perm32(R & 31)) : R;
        Rr[i] = R; Cc[i] = C; voffB[i] = (unsigned)(Rb * K + C) * 2u; }
    const size_t kstep = (size_t)(BK * 2);
    const size_t hstep = (size_t)HALF * K * 2;
    const unsigned ldsw = (unsigned)wid * 1024u;
    const int aoff = lds_byte(wr * 64 + fr, fq * 8), boff = lds_byte(wc * 32 + fr, fq * 8);
#define PG8_SA(b, h) (((b) * 2 + (h)) * HTB)
#define PG8_SB(b, h) ((4 + (b) * 2 + (h)) * HTB)
#define PG8_STAGE(bufoff, gbase, voff) do { _Pragma("unroll") for (int _i = 0; _i < 2; ++_i) \
        __builtin_amdgcn_global_load_lds((const unsigned*)((const char*)(gbase) + (voff)[_i]), (LAS unsigned*)(lds + (bufoff) + ldsw + _i * 8192), 16, 0, 0); } while (0)
#define PG8_LDA(dst, b, h) do { if constexpr (FP8) { _Pragma("unroll") for (int m = 0; m < 4; ++m) dst##8[m] = cat8(*(const LAS bf16x8*)(lds + PG8_SA(b, h) + aoff + m * 2048), *(const LAS bf16x8*)(lds + PG8_SA(b, h) + aoff + m * 2048 + 1024)); } \
    else { _Pragma("unroll") for (int m = 0; m < 4; ++m) _Pragma("unroll") for (int k = 0; k < 2; ++k) dst[m][k] = *(const LAS bf16x8*)(lds + PG8_SA(b, h) + aoff + m * 2048 + k * 1024); } } while (0)
#define PG8_LDB(dst, b, h) do { if constexpr (FP8) { _Pragma("unroll") for (int n = 0; n < 2; ++n) dst##8[n] = cat8(*(const LAS bf16x8*)(lds + PG8_SB(b, h) + boff + n * 2048), *(const LAS bf16x8*)(lds + PG8_SB(b, h) + boff + n * 2048 + 1024)); } \
    else { _Pragma("unroll") for (int n = 0; n < 2; ++n) _Pragma("unroll") for (int k = 0; k < 2; ++k) dst[n][k] = *(const LAS bf16x8*)(lds + PG8_SB(b, h) + boff + n * 2048 + k * 1024); } } while (0)
#define PG8_MMA(ai, bj, At, Bt) do { __builtin_amdgcn_s_setprio(1); if constexpr (FP8) { _Pragma("unroll") for (int m = 0; m < 4; ++m) _Pragma("unroll") for (int n = 0; n < 2; ++n) \
        asm volatile("v_mfma_scale_f32_16x16x128_f8f6f4 %0, %1, %2, %0, %3, %3 op_sel_hi:[0,0,0]" : "+v"(acc[ai][bj][m][n]) : "v"(Bt##8[n]), "v"(At##8[m]), "v"(sc8)); } \
    else { _Pragma("unroll") for (int m = 0; m < 4; ++m) _Pragma("unroll") for (int n = 0; n < 2; ++n) _Pragma("unroll") for (int k = 0; k < 2; ++k) \
        acc[ai][bj][m][n] = __builtin_amdgcn_mfma_f32_16x16x32_bf16(Bt[n][k], At[m][k], acc[ai][bj][m][n], 0, 0, 0); } __builtin_amdgcn_s_setprio(0); } while (0)
#define PG8_WAIT_V(n) asm volatile("s_waitcnt vmcnt(" #n ")" ::: "memory")
#define PG8_WAIT_L(n) asm volatile("s_waitcnt lgkmcnt(" #n ")" ::: "memory")
#define PG8_BAR __builtin_amdgcn_s_barrier()
#define PG8_SCHED __builtin_amdgcn_sched_barrier(0)
    Unit cur, nxt; int ui = 0;
    if (!S.next(0, cur)) return;
#pragma unroll
    for (int h = 0; h < 2; ++h)
#pragma unroll
        for (int i = 0; i < 2; ++i) vA[h][i] = (unsigned)((GATHER ? S.a_row(cur, h * HALF + Rr[i]) : (unsigned)(h * HALF + Rr[i])) * (unsigned)K + (unsigned)Cc[i]) * 2u;
    f32x4 acc[2][2][4][2];
    if constexpr (Epi::HAS_INIT) E.init(acc, cur, wr, wc, fr, fq);
    else {
#pragma unroll
    for (int a = 0; a < 2; ++a)
#pragma unroll
        for (int b = 0; b < 2; ++b)
#pragma unroll
            for (int m = 0; m < 4; ++m)
#pragma unroll
                for (int n = 0; n < 2; ++n) acc[a][b][m][n] = (f32x4){0.f, 0.f, 0.f, 0.f};
    }
    const int sc8 = 0x7f7f7f7f;
    bf16x8 At[4][2], B0[2][2], B1[2][2]; v8i_t At8[4], B08[2], B18[2];
    const char* cA = S.a_base(cur); const char* cB = S.b_base(cur);
    PG8_STAGE(PG8_SB(0, 0), cB, voffB); PG8_STAGE(PG8_SB(0, 1), cB + hstep, voffB); PG8_STAGE(PG8_SA(0, 0), cA, vA[0]); PG8_STAGE(PG8_SA(0, 1), cA, vA[1]);
    if (wr == 1) PG8_BAR;
    PG8_WAIT_V(2); PG8_BAR;
    PG8_STAGE(PG8_SB(1, 0), cB + kstep, voffB); PG8_STAGE(PG8_SA(1, 0), cA + kstep, vA[0]); PG8_STAGE(PG8_SB(1, 1), cB + hstep + kstep, voffB);
    PG8_WAIT_V(6); PG8_BAR;
    for (;;) {
        const bool has_next = S.next(ui + 1, nxt);
        const char* nA = has_next ? S.a_base(nxt) : cA; const char* nB = has_next ? S.b_base(nxt) : cB;
        if constexpr (GATHER) {
#pragma unroll
            for (int h = 0; h < 2; ++h)
#pragma unroll
                for (int i = 0; i < 2; ++i) nvA[h][i] = has_next ? (unsigned)(S.a_row(nxt, h * HALF + Rr[i]) * (unsigned)K + (unsigned)Cc[i]) * 2u : vA[h][i];
        }
#define PG8_WAIT_RX() do { if (relax) { if constexpr (Epi::NST >= 16) PG8_WAIT_V(24); else if constexpr (Epi::NST >= 8) PG8_WAIT_V(16); else PG8_WAIT_V(8); } else PG8_WAIT_V(8); } while (0)
#define PG8_TRIP(t) do { \
            const bool last = ((t) == nt - 2); int rx_ = __builtin_amdgcn_readfirstlane(((ui > 0) && ((t) == 0)) ? 1 : 0); asm volatile("" : "+s"(rx_)); const bool relax = rx_ != 0; \
            const char* a1 = cA + (size_t)((t) + 1) * kstep; \
            const char* a2 = last ? nA : cA + (size_t)((t) + 2) * kstep; const char* b2 = last ? nB : cB + (size_t)((t) + 2) * kstep; \
            const char* a3 = a2 + kstep; const char* b3 = b2 + kstep; \
            unsigned x0[2], x1[2]; \
            if constexpr (GATHER) { x0[0] = last ? nvA[0][0] : vA[0][0]; x0[1] = last ? nvA[0][1] : vA[0][1]; x1[0] = last ? nvA[1][0] : vA[1][0]; x1[1] = last ? nvA[1][1] : vA[1][1]; } \
            else { x0[0] = vA[0][0]; x0[1] = vA[0][1]; x1[0] = vA[1][0]; x1[1] = vA[1][1]; } \
            PG8_LDB(B0, 0, 0); PG8_LDB(B1, 0, 1); PG8_SCHED; PG8_LDA(At, 0, 0); PG8_STAGE(PG8_SA(1, 1), a1, vA[1]); \
            PG8_WAIT_RX(); PG8_WAIT_L(0); PG8_BAR; PG8_MMA(0, 0, At, B0); PG8_MMA(0, 1, At, B1); PG8_BAR; PG8_SCHED; \
            PG8_LDA(At, 0, 1); PG8_STAGE(PG8_SB(0, 0), b2, voffB); PG8_STAGE(PG8_SB(0, 1), b2 + hstep, voffB); PG8_STAGE(PG8_SA(0, 0), a2, x0); \
            PG8_WAIT_RX(); PG8_WAIT_L(0); PG8_BAR; PG8_MMA(1, 0, At, B0); PG8_MMA(1, 1, At, B1); PG8_BAR; PG8_SCHED; \
            PG8_LDB(B0, 1, 0); PG8_LDB(B1, 1, 1); PG8_SCHED; PG8_LDA(At, 1, 0); PG8_STAGE(PG8_SA(0, 1), a2, x1); \
            PG8_WAIT_V(8); PG8_WAIT_L(0); PG8_BAR; PG8_MMA(0, 0, At, B0); PG8_MMA(0, 1, At, B1); PG8_BAR; PG8_SCHED; \
            PG8_LDA(At, 1, 1); PG8_STAGE(PG8_SB(1, 0), b3, voffB); PG8_STAGE(PG8_SB(1, 1), b3 + hstep, voffB); PG8_STAGE(PG8_SA(1, 0), a3, x0); \
            PG8_WAIT_V(8); PG8_WAIT_L(0); PG8_BAR; PG8_MMA(1, 0, At, B0); PG8_MMA(1, 1, At, B1); PG8_BAR; PG8_SCHED; } while (0)
        for (int t = 0; t < nt; t += 2) PG8_TRIP(t);
        if constexpr (ALIGN_EPI) { if (wr == 0) PG8_BAR; }
        if constexpr (FP8) asm volatile("s_nop 15\n\ts_nop 15" ::: "memory");
        E(acc, cur, wr, wc, fr, fq);
        if (!has_next) break;
        if constexpr (Epi::HAS_INIT) E.init(acc, nxt, wr, wc, fr, fq);
        else {
#pragma unroll
        for (int a = 0; a < 2; ++a)
#pragma unroll
            for (int b = 0; b < 2; ++b)
#pragma unroll
                for (int m = 0; m < 4; ++m)
#pragma unroll
                    for (int n = 0; n < 2; ++n) acc[a][b][m][n] = (f32x4){0.f, 0.f, 0.f, 0.f};
        }
        cur = nxt; cA = nA; cB = nB; ++ui;
        if constexpr (GATHER) { vA[0][0] = nvA[0][0]; vA[0][1] = nvA[0][1]; vA[1][0] = nvA[1][0]; vA[1][1] = nvA[1][1]; }
        if constexpr (ALIGN_EPI) { if (wr == 1) PG8_BAR; }
    }
    PG8_WAIT_V(0);
    if constexpr (!ALIGN_EPI) { if (wr == 0) PG8_BAR; }
    PG8_BAR;
#undef PG8_TRIP
#undef PG8_WAIT_RX
#undef PG8_SA
#undef PG8_SB
#undef PG8_STAGE
#undef PG8_LDA
#undef PG8_LDB
#undef PG8_MMA
#undef PG8_WAIT_V
#undef PG8_WAIT_L
#undef PG8_BAR
#undef PG8_SCHED
}
}

#define EPI_ROWS(ai, m) (u.pm * 256 + (ai) * 128 + wr * 64 + (m) * 16 + fr)
__device__ __forceinline__ u32x4 pack8(const f32x4 a, const f32x4 b) { u32x4 w; w.x = cvt_pk_bf16(a[0], a[1]); w.y = cvt_pk_bf16(a[2], a[3]); w.z = cvt_pk_bf16(b[0], b[1]); w.w = cvt_pk_bf16(b[2], b[3]); return w; }
__device__ __forceinline__ void unpack8(const u32x4 w, f32x4& a, f32x4& b) { a = (f32x4){bf_lo(w.x), bf_hi(w.x), bf_lo(w.y), bf_hi(w.y)}; b = (f32x4){bf_lo(w.z), bf_hi(w.z), bf_lo(w.w), bf_hi(w.w)}; }

struct EpiWin {
    static constexpr bool PERM = true, HAS_INIT = false; static constexpr int NST = 8;
    const float* rstd; bf16_t* v; bf16_t* bg; bf16_t* ub; bf16_t* gates; const float* gate_bias;
    __device__ __forceinline__ void operator()(const f32x4 (&acc)[2][2][4][2], const pg8::Unit& u, int wr, int wc, int fr, int fq) const {
        if (u.pn < 8) {
#pragma unroll
            for (int ai = 0; ai < 2; ++ai)
#pragma unroll
                for (int m = 0; m < 4; ++m) { const int row = EPI_ROWS(ai, m); const float rs = rstd[row], rs2 = rs * rs;
                    const f32x4 a0 = acc[ai][0][m][0] * acc[ai][1][m][0] * rs2, a1 = acc[ai][0][m][1] * acc[ai][1][m][1] * rs2;
                    *(u32x4*)(v + (size_t)row * D + 128 * u.pn + 32 * wc + 8 * fq) = pack8(a0, a1); }
        } else if (u.pn < 14) {
            bf16_t* base; int ld, c0;
            if (u.pn < 12) { base = bg; ld = D; c0 = 256 * (u.pn - 8); } else { base = ub; ld = SW; c0 = 256 * (u.pn - 12); }
#pragma unroll
            for (int ai = 0; ai < 2; ++ai)
#pragma unroll
                for (int m = 0; m < 4; ++m) { const int row = EPI_ROWS(ai, m); const float rs = rstd[row];
#pragma unroll
                    for (int bj = 0; bj < 2; ++bj) *(u32x4*)(base + (size_t)row * ld + c0 + 128 * bj + 32 * wc + 8 * fq) = pack8(acc[ai][bj][m][0] * rs, acc[ai][bj][m][1] * rs); }
        } else {
            const int c0 = 256 * (u.pn - 14) + 32 * wc + 8 * fq;
            f32x4 bv[2][2];
#pragma unroll
            for (int bj = 0; bj < 2; ++bj)
#pragma unroll
                for (int n = 0; n < 2; ++n) bv[bj][n] = *(const f32x4*)(gate_bias + c0 + 128 * bj + 4 * n);
#pragma unroll
            for (int ai = 0; ai < 2; ++ai)
#pragma unroll
                for (int m = 0; m < 4; ++m) { const int row = EPI_ROWS(ai, m); const float rs = rstd[row];
#pragma unroll
                    for (int bj = 0; bj < 2; ++bj) { f32x4 g0 = acc[ai][bj][m][0] * rs + bv[bj][0], g1 = acc[ai][bj][m][1] * rs + bv[bj][1];
#pragma unroll
                        for (int j = 0; j < 4; ++j) { g0[j] = fsigmoid(g0[j]); g1[j] = fsigmoid(g1[j]); }
                        *(u32x4*)(gates + (size_t)row * 2048 + c0 + 128 * bj) = pack8(g0, g1); } }
        }
    }
};
struct EpiGlu {
    static constexpr bool PERM = true, HAS_INIT = false; static constexpr int NST = 8;
    const bf16_t* gates; bf16_t* mb;
    __device__ __forceinline__ void operator()(const f32x4 (&acc)[2][2][4][2], const pg8::Unit& u, int wr, int wc, int fr, int fq) const {
        const int col = 128 * u.pn + 32 * wc + 8 * fq;
#pragma unroll
        for (int ai = 0; ai < 2; ++ai)
#pragma unroll
            for (int m = 0; m < 4; ++m) { const int row = EPI_ROWS(ai, m);
                f32x4 g0, g1; unpack8(*(const u32x4*)(gates + (size_t)row * 2048 + 1024 + col), g0, g1);
                f32x4 y0 = acc[ai][0][m][0], y1 = acc[ai][0][m][1]; const f32x4 b0 = acc[ai][1][m][0], b1 = acc[ai][1][m][1];
#pragma unroll
                for (int j = 0; j < 4; ++j) { y0[j] = y0[j] * fsigmoid(b0[j]) * g0[j]; y1[j] = y1[j] * fsigmoid(b1[j]) * g1[j]; }
                *(u32x4*)(mb + (size_t)row * D + col) = pack8(y0, y1); }
    }
};
struct EpiMix {
    static constexpr bool PERM = true, HAS_INIT = false; static constexpr int NST = 16;
    const bf16_t* gates; const bf16_t* mb; bf16_t* mixed;
    __device__ __forceinline__ void operator()(const f32x4 (&acc)[2][2][4][2], const pg8::Unit& u, int wr, int wc, int fr, int fq) const {
#pragma unroll
        for (int ai = 0; ai < 2; ++ai)
#pragma unroll
            for (int m = 0; m < 4; ++m) { const int row = EPI_ROWS(ai, m);
#pragma unroll
                for (int bj = 0; bj < 2; ++bj) { const int col = 256 * u.pn + 128 * bj + 32 * wc + 8 * fq;
                    f32x4 g0, g1, m0, m1; unpack8(*(const u32x4*)(gates + (size_t)row * 2048 + col), g0, g1); unpack8(*(const u32x4*)(mb + (size_t)row * D + col), m0, m1);
                    *(u32x4*)(mixed + (size_t)row * D + col) = pack8(g0 * acc[ai][bj][m][0] + m0, g1 * acc[ai][bj][m][1] + m1); } }
    }
};
struct EpiX1 {
    static constexpr bool PERM = true, HAS_INIT = true; static constexpr int NST = 16;
    const float* __restrict__ x; float* __restrict__ x1; bf16_t* __restrict__ x1b; unsigned char* __restrict__ x1q;
    __device__ __forceinline__ void init(f32x4 (&acc)[2][2][4][2], const pg8::Unit& u, int wr, int wc, int fr, int fq) const {
#pragma unroll
        for (int ai = 0; ai < 2; ++ai)
#pragma unroll
            for (int m = 0; m < 4; ++m)
#pragma unroll
                for (int bj = 0; bj < 2; ++bj)
#pragma unroll
                    for (int n = 0; n < 2; ++n) acc[ai][bj][m][n] = __builtin_nontemporal_load((const f32x4*)(x + (size_t)EPI_ROWS(ai, m) * D + 256 * u.pn + 128 * bj + 32 * wc + 8 * fq + 4 * n));
    }
    __device__ __forceinline__ void operator()(const f32x4 (&acc)[2][2][4][2], const pg8::Unit& u, int wr, int wc, int fr, int fq) const {
#pragma unroll
        for (int ai = 0; ai < 2; ++ai)
#pragma unroll
            for (int m = 0; m < 4; ++m) { const int row = EPI_ROWS(ai, m);
#pragma unroll
                for (int bj = 0; bj < 2; ++bj) { const size_t o = (size_t)row * D + 256 * u.pn + 128 * bj + 32 * wc + 8 * fq;
                    const f32x4 r0 = acc[ai][bj][m][0], r1 = acc[ai][bj][m][1];
                    *(u32x4*)(x1b + o) = pack8(r0, r1);
                    u32x2 q8; q8.x = cvt4_fp8(r0[0], r0[1], r0[2], r0[3]); q8.y = cvt4_fp8(r1[0], r1[1], r1[2], r1[3]); *(u32x2*)(x1q + o) = q8; }
                }
    }
};
struct EpiUp {
    static constexpr bool PERM = true, HAS_INIT = false; static constexpr int NST = 8;
    const int* list; const float* rstd2; unsigned char* hmid;
    __device__ __forceinline__ void operator()(const f32x4 (&acc)[2][2][4][2], const pg8::Unit& u, int wr, int wc, int fr, int fq) const {
        const int col = 128 * u.pn + 32 * wc + 8 * fq;
#pragma unroll
        for (int ai = 0; ai < 2; ++ai)
#pragma unroll
            for (int m = 0; m < 4; ++m) { const int r = ai * 128 + wr * 64 + m * 16 + fr; const bool ok = r < u.nrow;
                const int tok = ok ? list[u.e * T + 256 * u.pm + r] : 0; const float rs = ok ? rstd2[tok] * (1.f / 32.f) : 0.f;
                f32x4 g0 = acc[ai][0][m][0] * rs, g1 = acc[ai][0][m][1] * rs; const f32x4 u0 = acc[ai][1][m][0] * rs, u1 = acc[ai][1][m][1] * rs;
#pragma unroll
                for (int j = 0; j < 4; ++j) { g0[j] = fsilu(g0[j]) * u0[j]; g1[j] = fsilu(g1[j]) * u1[j]; }
                u32x2 q8; q8.x = cvt4_fp8(g0[0], g0[1], g0[2], g0[3]); q8.y = cvt4_fp8(g1[0], g1[1], g1[2], g1[3]); *(u32x2*)(hmid + (size_t)(u.srow + r) * EFF + col) = q8; }
    }
};
struct EpiDown {
    static constexpr bool PERM = true, HAS_INIT = false; static constexpr int NST = 16;
    bf16_t* Y;
    __device__ __forceinline__ void operator()(const f32x4 (&acc)[2][2][4][2], const pg8::Unit& u, int wr, int wc, int fr, int fq) const {
#pragma unroll
        for (int ai = 0; ai < 2; ++ai)
#pragma unroll
            for (int m = 0; m < 4; ++m) { const int r = ai * 128 + wr * 64 + m * 16 + fr;
#pragma unroll
                for (int bj = 0; bj < 2; ++bj) *(u32x4*)(Y + (size_t)(u.srow + r) * D + 256 * u.pn + 128 * bj + 32 * wc + 8 * fq) = pack8(acc[ai][bj][m][0] * (1.f / 16.f), acc[ai][bj][m][1] * (1.f / 16.f)); }
    }
};

constexpr size_t MiB = 1u << 20;
constexpr size_t WS_CTL = 0, CTL_BYTES = 64 * 1024;
constexpr size_t WS_WIN = 1 * MiB, WS_WC = 12 * MiB, WS_WGLU = 14 * MiB, WS_WO = 16 * MiB;
constexpr size_t WS_RSTD1 = 18 * MiB, WS_RSTD2 = WS_RSTD1 + 64 * 1024, WS_TABA = WS_RSTD2 + 64 * 1024, WS_TABA256 = WS_TABA + 32 * 1024, WS_BBT = WS_TABA256 + 32 * 1024,
                 WS_CT = WS_BBT + 128 * 1024, WS_WRT = WS_CT + 128 * 1024, WS_E = 19 * MiB;
constexpr size_t WS_XB = 20 * MiB, WS_Z = 20 * MiB;
constexpr size_t WS_V = 52 * MiB, WS_MB = 52 * MiB, WS_X1B = 52 * MiB;
constexpr size_t WS_BG = 84 * MiB, WS_MIXED = 84 * MiB, WS_HMID = 84 * MiB;
constexpr size_t WS_UB = 116 * MiB, WS_YS = 116 * MiB;
constexpr size_t WS_GATES = 132 * MiB;
constexpr size_t WS_Y = 124 * MiB;
constexpr size_t WS_WGU = 196 * MiB, WS_X1Q = 228 * MiB;
constexpr size_t WS_WD = 260 * MiB, WS_WD2 = 2 * MiB;
constexpr int WD_SPLIT = 64;
#ifndef CV_EARLY_ITEMS
#define CV_EARLY_ITEMS 5120
#endif
constexpr int CV_EARLY = CV_EARLY_ITEMS;
constexpr size_t WS_TOK = 4 * MiB, WS_LIST = 6 * MiB, WS_END = 290 * MiB;
constexpr int CW_CNT = 64;
constexpr int CW_BAR = 4096;
constexpr int RING_BYTES = 131072, MISC_OFF = RING_BYTES, LDS_BYTES = 147456;

#define XB_TMO      128
#define XB_XCNT(j)  (256  + 64 * (j))
#define XB_XSUB(j)  (1280 + 64 * (j))
#define XB_XGEN(j)  (2304 + 64 * (j))
#define XB_TOP      3328
#define XB_TOPGEN   3392
#define XCD_BAR_WORDS 3456
#define XB_SPIN_CAP (1u << 18)
__device__ __forceinline__ unsigned xb_ld(unsigned* p)              { return __hip_atomic_load(p, __ATOMIC_RELAXED, __HIP_MEMORY_SCOPE_AGENT); }
__device__ __forceinline__ unsigned xb_add(unsigned* p, unsigned v) { return __hip_atomic_fetch_add(p, v, __ATOMIC_RELAXED, __HIP_MEMORY_SCOPE_AGENT); }
__device__ __forceinline__ unsigned xb_xcc_id() { return (unsigned)__builtin_amdgcn_s_getreg((3 << 11) | 20) & 0xFu; }
#define XB_SPIN(cond, bar) do { unsigned _sp = 0; while (cond) { __builtin_amdgcn_s_sleep(1); \
    if ((++_sp & 255u) == 0u) { if (xb_ld(&(bar)[XB_TMO])) break; if (_sp > XB_SPIN_CAP) { atomicAdd(&(bar)[XB_TMO], 1u); break; } } } } while (0)
struct XcdBarrier { unsigned* bar; unsigned x; volatile LAS unsigned* st; };
__device__ __forceinline__ XcdBarrier xcd_barrier_post(unsigned* bar, volatile LAS unsigned* st) {
    XcdBarrier b; b.bar = bar; b.x = xb_xcc_id(); b.st = st;
    if (threadIdx.x == 0) (void)xb_add(&bar[XB_XCNT(b.x)], 1u);
    return b;
}
__device__ __forceinline__ void xcd_barrier_complete(unsigned* bar, unsigned x, unsigned& nloc, unsigned& nx) {
    const unsigned G = gridDim.x * gridDim.y * gridDim.z;
    unsigned sum, cnt, mine, sp = 0u;
    for (;;) {
        sum = 0u; cnt = 0u; mine = 0u;
#pragma unroll
        for (unsigned j = 0; j < 16; ++j) { const unsigned c = xb_ld(&bar[XB_XCNT(j)]); sum += c; cnt += (c > 0u) ? 1u : 0u; mine = (j == x) ? c : mine; }
        if (sum == G) break;
        __builtin_amdgcn_s_sleep(1);
        if ((++sp & 255u) == 0u) { if (xb_ld(&bar[XB_TMO])) break; if (sp > XB_SPIN_CAP) { atomicAdd(&bar[XB_TMO], 1u); break; } }
    }
    nloc = mine > 0u ? mine : 1u; nx = cnt > 0u ? cnt : 1u;
}
__device__ __forceinline__ void xcd_barrier(const XcdBarrier& b) {
    asm volatile("s_waitcnt vmcnt(0)" ::: "memory");
    __syncthreads();
    if (threadIdx.x == 0) {
        unsigned* bar = b.bar;
        __builtin_amdgcn_s_waitcnt(0);
        unsigned nloc = b.st[0], nx = b.st[1];
        if (nloc == 0u) { xcd_barrier_complete(bar, b.x, nloc, nx); b.st[0] = nloc; b.st[1] = nx; }
        const unsigned old = xb_add(&bar[XB_XSUB(b.x)], 1u);
        const unsigned gen = old / nloc;
        if (old + 1u == (gen + 1u) * nloc) {
            __builtin_amdgcn_fence(__ATOMIC_RELEASE, "agent");
            asm volatile("s_waitcnt vmcnt(0)" ::: "memory");
            const unsigned og = xb_add(&bar[XB_TOP], 1u);
            const unsigned tg = og / nx;
            if (og + 1u == (tg + 1u) * nx) xb_add(&bar[XB_TOPGEN], 1u);
            else XB_SPIN(xb_ld(&bar[XB_TOPGEN]) == tg, bar);
            __builtin_amdgcn_fence(__ATOMIC_ACQUIRE, "agent");
            xb_add(&bar[XB_XGEN(b.x)], 1u);
            asm volatile("s_waitcnt vmcnt(0)" ::: "memory");
        } else {
            XB_SPIN(xb_ld(&bar[XB_XGEN(b.x)]) == gen, bar);
            __builtin_amdgcn_fence(__ATOMIC_ACQUIRE, "agent");
            asm volatile("s_waitcnt vmcnt(0)" ::: "memory");
        }
    }
    __syncthreads();
}

struct Args { const float* in[27]; float* out; unsigned char* ws; int ph_lo, ph_hi, use_bar, pad; };
struct Frame {
    LAS unsigned char* lds; volatile LAS unsigned* MISC; unsigned* ctl; unsigned char* ws;
    int tid, lane, wave, G;
};

__device__ __forceinline__ void tr64(const float* __restrict__ src, int ld, int col0, int k0, const float* __restrict__ scale, bf16_t* __restrict__ dst, size_t drow0, int Kdst, LAS unsigned char* scr, int lane) {
    const float* s = src + (size_t)k0 * ld + col0 + lane;
#pragma unroll
    for (int hh = 0; hh < 2; ++hh) {
        float v[32];
#pragma unroll
        for (int kk = 0; kk < 32; ++kk) v[kk] = __builtin_nontemporal_load(s + (size_t)(32 * hh + kk) * ld);
        if (scale) {
#pragma unroll
            for (int kk = 0; kk < 32; ++kk) v[kk] *= scale[k0 + 32 * hh + kk];
        }
#pragma unroll
        for (int c = 0; c < 4; ++c) { u32x4 o; o.x = cvt_pk_bf16(v[8 * c + 0], v[8 * c + 1]); o.y = cvt_pk_bf16(v[8 * c + 2], v[8 * c + 3]); o.z = cvt_pk_bf16(v[8 * c + 4], v[8 * c + 5]); o.w = cvt_pk_bf16(v[8 * c + 6], v[8 * c + 7]);
            *(LAS u32x4*)(scr + lane * 144 + 16 * (4 * hh + c)) = o; }
        asm volatile("s_waitcnt vmcnt(0)" ::: "memory");
    }
    asm volatile("s_waitcnt lgkmcnt(0)" ::: "memory");
#pragma unroll
    for (int j = 0; j < 8; ++j) { const int row = 8 * j + (lane >> 3); const u32x4 o = *(const LAS u32x4*)(scr + row * 144 + 16 * (lane & 7));
        *(u32x4*)(dst + (drow0 + row) * (size_t)Kdst + k0 + 8 * (lane & 7)) = o; }
    asm volatile("s_waitcnt lgkmcnt(0)" ::: "memory");
}

__device__ __forceinline__ void p0_prologue(const Frame& F, const Args& a) {
    LAS unsigned char* scr = F.lds + F.wave * 16384;
    const int gw = blockIdx.x * 8 + F.wave, NGW = F.G * 8;
    bf16_t* Win_t = (bf16_t*)(F.ws + WS_WIN); bf16_t* Wc_t = (bf16_t*)(F.ws + WS_WC); bf16_t* Wglu_t = (bf16_t*)(F.ws + WS_WGLU); bf16_t* Wo_t = (bf16_t*)(F.ws + WS_WO);
    constexpr int I_WIN = 16 * 88, I_WC = 16 * 16, I_WO = 16 * 16, I_GLU = 8 * 32;
    for (int it = gw; it < I_WIN + I_WC + I_WO + I_GLU; it += NGW) {
        int r = it;
        if (r < I_WIN) { const int kb = r / 88, nb = r % 88, j0 = 64 * nb; int col0;
            if (j0 < 2048) { const int pn = j0 >> 8, i = j0 & 255; col0 = (i < 128) ? (128 * pn + i) : (2048 + 128 * pn + (i - 128)); } else if (j0 < 3072) col0 = j0 - 1024; else col0 = j0;
            tr64(a.in[2], INC, col0, 64 * kb, a.in[1], Win_t, (size_t)j0, D, scr, F.lane); continue; }
        r -= I_WIN;
        if (r < I_WC) { tr64(a.in[5], D, 64 * (r % 16), 64 * (r / 16), nullptr, Wc_t, (size_t)(64 * (r % 16)), D, scr, F.lane); continue; }
        r -= I_WC;
        if (r < I_WO) { tr64(a.in[17], D, 64 * (r % 16), 64 * (r / 16), nullptr, Wo_t, (size_t)(64 * (r % 16)), D, scr, F.lane); continue; }
        r -= I_WO;
        { const int kb = r / 32, nb = r % 32, j0 = 64 * nb, pn = j0 >> 8, i = j0 & 255;
          tr64(i < 128 ? a.in[14] : a.in[15], D, 128 * pn + (i & 127), 64 * kb, nullptr, Wglu_t, (size_t)j0, SW, scr, F.lane); }
    }
    { const float* __restrict__ x = a.in[0]; bf16_t* __restrict__ xb = (bf16_t*)(F.ws + WS_XB); float* __restrict__ rstd1 = (float*)(F.ws + WS_RSTD1);
      for (int m = 4 * gw; m < T; m += 4 * NGW) {
          f32x4 v[4][4]; float sq[4];
#pragma unroll
          for (int q = 0; q < 4; ++q) { const f32x4* xr = (const f32x4*)(x + (size_t)(m + q) * D) + F.lane;
#pragma unroll
              for (int j = 0; j < 4; ++j) v[q][j] = __builtin_nontemporal_load(xr + 64 * j); }
#pragma unroll
          for (int q = 0; q < 4; ++q) { sq[q] = 0.f;
#pragma unroll
              for (int j = 0; j < 4; ++j) sq[q] += (v[q][j][0] * v[q][j][0] + v[q][j][1] * v[q][j][1]) + (v[q][j][2] * v[q][j][2] + v[q][j][3] * v[q][j][3]);
              u32x2* o = (u32x2*)(xb + (size_t)(m + q) * D) + F.lane;
#pragma unroll
              for (int j = 0; j < 4; ++j) { u32x2 w; w.x = cvt_pk_bf16(v[q][j][0], v[q][j][1]); w.y = cvt_pk_bf16(v[q][j][2], v[q][j][3]); o[64 * j] = w; } }
#pragma unroll
          for (int o = 1; o < 64; o <<= 1) {
#pragma unroll
              for (int q = 0; q < 4; ++q) sq[q] += __shfl_xor(sq[q], o); }
          if (F.lane < 4) { const float sv = F.lane == 0 ? sq[0] : F.lane == 1 ? sq[1] : F.lane == 2 ? sq[2] : sq[3]; rstd1[m + F.lane] = rsqrtf(sv * (1.f / D) + EPS); }
          asm volatile("s_waitcnt vmcnt(8)" ::: "memory"); } }
    { bf16_t* wrt = (bf16_t*)(F.ws + WS_WRT); const float* g2 = a.in[18];
      for (int i = blockIdx.x * 512 + F.tid; i < 48 * D; i += F.G * 512) { const int j = i / D, k = i % D; float w = 0.f;
          if (j < 4) w = a.in[19][k * 4 + j]; else if (j < 36) w = a.in[21][k * 32 + (j - 4)];
          wrt[i] = (bf16_t)(cvt_pk_bf16(w * g2[k], 0.f) & 0xffffu); } }
    { float* tab_a = (float*)(F.ws + WS_TABA); float* tab_a256 = (float*)(F.ws + WS_TABA256); bf16_t* BbT = (bf16_t*)(F.ws + WS_BBT); bf16_t* Ct = (bf16_t*)(F.ws + WS_CT);
      for (int i = blockIdx.x * 512 + F.tid; i < NG * NS; i += F.G * 512) { const int g = i / NS, n = i % NS;
          f32x4 br[4], bi[4]; float cre[16], cim[16];
#pragma unroll
          for (int q = 0; q < 4; ++q) { br[q] = *(const f32x4*)(a.in[9] + (size_t)i * NH + 4 * q); bi[q] = *(const f32x4*)(a.in[10] + (size_t)i * NH + 4 * q); }
#pragma unroll
          for (int h = 0; h < NH; ++h) { cre[h] = a.in[11][(g * NH + h) * NS + n]; cim[h] = a.in[12][(g * NH + h) * NS + n]; }
          const float lr = a.in[6][i], li = a.in[7][i], dt = expf(a.in[8][g]);
          float sn, cs; sincosf(li * dt, &sn, &cs); const float er = expf(lr * dt); const float cr = er * cs, ci = er * sn;
          float pr = cr, pi = ci;
#pragma unroll
          for (int q = 0; q < 4; ++q) { const float tr_ = pr * pr - pi * pi, ti_ = 2.f * pr * pi; pr = tr_; pi = ti_; }
          *(f32x4*)(tab_a + (size_t)i * 4) = (f32x4){cr, ci, pr, pi};
#pragma unroll
          for (int q = 0; q < 4; ++q) { const float tr_ = pr * pr - pi * pi, ti_ = 2.f * pr * pi; pr = tr_; pi = ti_; }
          *(float2*)(tab_a256 + (size_t)i * 2) = make_float2(pr, pi);
          const float nr = cr - 1.f, ni = ci, den = lr * lr + li * li; const float kr = (nr * lr + ni * li) / den, ki = (ni * lr - nr * li) / den;
          unsigned wre[8], wim[8];
#pragma unroll
          for (int q = 0; q < 4; ++q) {
              wre[2 * q]     = cvt_pk_bf16(kr * br[q][0] - ki * bi[q][0], kr * br[q][1] - ki * bi[q][1]);
              wre[2 * q + 1] = cvt_pk_bf16(kr * br[q][2] - ki * bi[q][2], kr * br[q][3] - ki * bi[q][3]);
              wim[2 * q]     = cvt_pk_bf16(kr * bi[q][0] + ki * br[q][0], kr * bi[q][1] + ki * br[q][1]);
              wim[2 * q + 1] = cvt_pk_bf16(kr * bi[q][2] + ki * br[q][2], kr * bi[q][3] + ki * br[q][3]); }
          u32x4* dre = (u32x4*)(BbT + ((size_t)(g * 4 + 0 + (n >> 5)) * 32 + (n & 31)) * 16); u32x4* dim_ = (u32x4*)(BbT + ((size_t)(g * 4 + 2 + (n >> 5)) * 32 + (n & 31)) * 16);
          dre[0] = (u32x4){wre[0], wre[1], wre[2], wre[3]}; dre[1] = (u32x4){wre[4], wre[5], wre[6], wre[7]};
          dim_[0] = (u32x4){wim[0], wim[1], wim[2], wim[3]}; dim_[1] = (u32x4){wim[4], wim[5], wim[6], wim[7]};
#pragma unroll
          for (int h = 0; h < NH; ++h) *(unsigned*)(Ct + (size_t)(g * NH + h) * 128 + 2 * n) = cvt_pk_bf16(cre[h], -cim[h]); } }
}

__device__ __forceinline__ void p2_conv(const Frame& F, const Args& a) {
    const bf16_t* v = (const bf16_t*)(F.ws + WS_V); const bf16_t* bg = (const bf16_t*)(F.ws + WS_BG); bf16_t* z = (bf16_t*)(F.ws + WS_Z);
    const float* cw = a.in[3]; const float* cb = a.in[4];
    const int gw = blockIdx.x * 8 + F.wave, NGW = F.G * 8;
    for (int it = gw; it < (T / 8) * 2; it += NGW) {
        const int t0 = (it >> 1) * 8, ch = (it & 1) * 512 + F.lane * 8;
        f32x4 w0a = *(const f32x4*)(cw + ch), w0b = *(const f32x4*)(cw + ch + 4), w1a = *(const f32x4*)(cw + D + ch), w1b = *(const f32x4*)(cw + D + ch + 4);
        f32x4 w2a = *(const f32x4*)(cw + 2 * D + ch), w2b = *(const f32x4*)(cw + 2 * D + ch + 4), ba = *(const f32x4*)(cb + ch), bb = *(const f32x4*)(cb + ch + 4);
        f32x4 p2a = {0.f, 0.f, 0.f, 0.f}, p2b = p2a, p1a = p2a, p1b = p2a;
        if (t0 >= 2) { unpack8(*(const u32x4*)(v + (size_t)(t0 - 2) * D + ch), p2a, p2b); unpack8(*(const u32x4*)(v + (size_t)(t0 - 1) * D + ch), p1a, p1b); }
#pragma unroll
        for (int i = 0; i < 8; ++i) { f32x4 ca, cbv, ga, gb; unpack8(*(const u32x4*)(v + (size_t)(t0 + i) * D + ch), ca, cbv); unpack8(*(const u32x4*)(bg + (size_t)(t0 + i) * D + ch), ga, gb);
            const f32x4 ya = ga * (w0a * p2a + w1a * p1a + w2a * ca + ba), yb = gb * (w0b * p2b + w1b * p1b + w2b * cbv + bb);
            *(u32x4*)(z + (size_t)(t0 + i) * D + ch) = pack8(ya, yb);
            p2a = p1a; p2b = p1b; p1a = ca; p1b = cbv; }
    }
}

struct ConvD { const float* src; const float* scale; bf16_t* dst; int ld, Kdst; };
__device__ __forceinline__ ConvD conv_desc(int H, const Args& a, unsigned char* ws) {
    ConvD d; const int it = H >> 1, hh = H & 1;
    if (it < NE * 256) { const int e = it >> 8, r = it & 255, kb = r >> 4, nb = r & 15, j0 = 64 * nb, pn = j0 >> 8, i = j0 & 255, k0 = 64 * kb + 32 * hh;
        d.src = (i < 128 ? a.in[23] : a.in[24]) + (size_t)e * D * EFF + (size_t)k0 * EFF + 128 * pn + (i & 127); d.ld = EFF; d.scale = a.in[18] + k0;
        d.dst = (bf16_t*)(ws + WS_WGU) + ((size_t)e * 1024 + j0) * D + k0; d.Kdst = D; }
    else { const int q = it - NE * 256, e = q >> 7, r = q & 127, kb = r >> 4, nb = r & 15, k0 = 64 * kb + 32 * hh;
        d.src = a.in[25] + (size_t)e * EFF * D + (size_t)k0 * D + 64 * nb; d.ld = D; d.scale = nullptr;
        d.dst = (bf16_t*)(e < WD_SPLIT ? ws + WS_WD + (size_t)e * MiB : ws + WS_WD2 + (size_t)(e - WD_SPLIT) * MiB) + (size_t)(64 * nb) * EFF + k0; d.Kdst = EFF; }
    return d;
}
__device__ __forceinline__ void conv_finish(float (&cv)[32], const ConvD& d, const float sc, LAS unsigned char* scr, int lane) {
    if (d.scale) {
#pragma unroll
        for (int kk = 0; kk < 32; ++kk) cv[kk] *= __uint_as_float((unsigned)__builtin_amdgcn_readlane((int)__float_as_uint(sc), kk));
    }
#pragma unroll
    for (int c = 0; c < 4; ++c) { u32x4 o; o.x = cvt_pk_bf16(cv[8 * c + 0], cv[8 * c + 1]); o.y = cvt_pk_bf16(cv[8 * c + 2], cv[8 * c + 3]); o.z = cvt_pk_bf16(cv[8 * c + 4], cv[8 * c + 5]); o.w = cvt_pk_bf16(cv[8 * c + 6], cv[8 * c + 7]);
        *(LAS u32x4*)(scr + lane * 80 + 16 * c) = o; }
    asm volatile("s_waitcnt lgkmcnt(0)" ::: "memory");
#pragma unroll
    for (int j = 0; j < 4; ++j) { const int row = 16 * j + (lane >> 2); const u32x4 o = *(const LAS u32x4*)(scr + row * 80 + 16 * (lane & 3));
        *(u32x4*)(d.dst + (size_t)row * d.Kdst + 8 * (lane & 3)) = o; }
    asm volatile("s_waitcnt lgkmcnt(0)" ::: "memory");
}

__device__ __forceinline__ int tokmap(int r) { return 16 * ((r >> 2) & 1) + 4 * (r >> 3) + (r & 3); }
typedef float f32x2s __attribute__((ext_vector_type(2)));
template <int PASS>
__device__ __forceinline__ void scan_pairs(f32x16& Pre, f32x16& Pim, f32x16& Qre, f32x16& Qim, const f32x2s Ar, const f32x2s Ai, const f32x2s A16r, const f32x2s A16i, f32x2s& Rr, f32x2s& Ri, int hf) {
    const f32x2s zero2 = {0.f, 0.f};
    f32x2s sr = hf ? zero2 : Rr, si = hf ? zero2 : Ri;
#pragma unroll
    for (int p = 0; p < 8; ++p) { const f32x2s re = {Pre[2 * p], Pre[2 * p + 1]}, im = {Pim[2 * p], Pim[2 * p + 1]};
        const f32x2s nr = Ar * sr - Ai * si + re, ni = Ar * si + Ai * sr + im; sr = nr; si = ni;
        Pre[2 * p] = sr.x; Pre[2 * p + 1] = sr.y; Pim[2 * p] = si.x; Pim[2 * p + 1] = si.y; }
#pragma unroll
    for (int p = 0; p < 8; ++p) { const f32x2s re = {Qre[2 * p], Qre[2 * p + 1]}, im = {Qim[2 * p], Qim[2 * p + 1]};
        const f32x2s nr = Ar * sr - Ai * si + re, ni = Ar * si + Ai * sr + im; sr = nr; si = ni;
        Qre[2 * p] = sr.x; Qre[2 * p + 1] = sr.y; Qim[2 * p] = si.x; Qim[2 * p + 1] = si.y; }
    f32x2s orr, oii; orr.x = __shfl_xor(sr.x, 32); orr.y = __shfl_xor(sr.y, 32); oii.x = __shfl_xor(si.x, 32); oii.y = __shfl_xor(si.y, 32);
    Rr = A16r * sr - A16i * si + orr; Ri = A16r * si + A16i * sr + oii;
    if (PASS == 2) {
        f32x2s cr = hf ? orr : zero2, ci = hf ? oii : zero2;
#pragma unroll
        for (int p = 0; p < 8; ++p) { const f32x2s nr = Ar * cr - Ai * ci, ni = Ar * ci + Ai * cr; cr = nr; ci = ni;
            Pre[2 * p] += cr.x; Pre[2 * p + 1] += cr.y; Pim[2 * p] += ci.x; Pim[2 * p + 1] += ci.y; }
#pragma unroll
        for (int p = 0; p < 8; ++p) { const f32x2s nr = Ar * cr - Ai * ci, ni = Ar * ci + Ai * cr; cr = nr; ci = ni;
            Qre[2 * p] += cr.x; Qre[2 * p + 1] += cr.y; Qim[2 * p] += ci.x; Qim[2 * p + 1] += ci.y; }
    }
}
template <int PASS>
__device__ __forceinline__ void scan_tile(f32x16& re, f32x16& im, const f32x4 c, float& Rr, float& Ri, int hf) {
    const float ar = c[0], ai = c[1];
    float sr = hf ? 0.f : Rr, si = hf ? 0.f : Ri;
#pragma unroll
    for (int q = 0; q < 16; ++q) { const float nr = ar * sr - ai * si + re[q], ni = ar * si + ai * sr + im[q]; sr = nr; si = ni; re[q] = sr; im[q] = si; }
    const float orr = __shfl_xor(sr, 32), oii = __shfl_xor(si, 32);
    Rr = c[2] * sr - c[3] * si + orr; Ri = c[2] * si + c[3] * sr + oii;
    if (PASS == 2) {
        float cr = hf ? orr : 0.f, ci = hf ? oii : 0.f;
#pragma unroll
        for (int q = 0; q < 16; ++q) { const float nr = ar * cr - ai * ci, ni = ar * ci + ai * cr; cr = nr; ci = ni; re[q] += cr; im[q] += ci; }
    }
}
template <int PASS>
__device__ __forceinline__ void ssm_pass(const Frame& F, const Args& a) {
    const int lane = F.lane, hf = lane >> 5, col = lane & 31;
    const f32x4* tab_a = (const f32x4*)(F.ws + WS_TABA); const float2* tab_a256 = (const float2*)(F.ws + WS_TABA256);
    const bf16_t* BbT = (const bf16_t*)(F.ws + WS_BBT); const bf16_t* Ct = (const bf16_t*)(F.ws + WS_CT);
    const bf16_t* ub = (const bf16_t*)(F.ws + WS_UB); bf16_t* ys = (bf16_t*)(F.ws + WS_YS); float* E = (float*)(F.ws + WS_E);
    LAS unsigned char* sl = F.lds + F.wave * 16384; LAS unsigned char* cscr = sl + 8704;
    for (int id = blockIdx.x * 8 + F.wave; id < NG * (T / 256); id += F.G * 8) {
        const int g = id & 31, r = id >> 5;
        const f32x4 c0 = tab_a[g * NS + col], c1 = tab_a[g * NS + 32 + col];
        bf16x8 Bf[4];
#pragma unroll
        for (int q = 0; q < 4; ++q) Bf[q] = *(const bf16x8*)(BbT + ((size_t)(g * 4 + q) * 32 + col) * 16 + 8 * hf);
        float R0r = 0.f, R0i = 0.f, R1r = 0.f, R1i = 0.f;
        bf16x8 Cf[4], Df;
        if (PASS == 2) {
            const float2 p0 = tab_a256[g * NS + col], p1 = tab_a256[g * NS + 32 + col];
            { const int rh = r >> 1, nit = r - rh, jb = hf ? rh : rh - nit;
              for (int j0 = 0; j0 < nit; j0 += 8) {
                float2 e0[8], e1[8];
#pragma unroll
                for (int q = 0; q < 8; ++q) { int j = jb + j0 + q; const bool ok = (j0 + q < nit) && (j >= 0); j = ok ? j : 0;
                    e0[q] = *(const float2*)(E + ((size_t)(j * NG + g) * NS + col) * 2); e1[q] = *(const float2*)(E + ((size_t)(j * NG + g) * NS + 32 + col) * 2);
                    if (!ok) { e0[q] = make_float2(0.f, 0.f); e1[q] = make_float2(0.f, 0.f); } }
#pragma unroll
                for (int q = 0; q < 8; ++q) if (j0 + q < nit) {
                    const float t0r = p0.x * R0r - p0.y * R0i + e0[q].x, t0i = p0.x * R0i + p0.y * R0r + e0[q].y; R0r = t0r; R0i = t0i;
                    const float t1r = p1.x * R1r - p1.y * R1i + e1[q].x, t1i = p1.x * R1i + p1.y * R1r + e1[q].y; R1r = t1r; R1i = t1i; } }
              float w0r = 1.f, w0i = 0.f, w1r = 1.f, w1i = 0.f, b0r = p0.x, b0i = p0.y, b1r = p1.x, b1i = p1.y;
#pragma unroll 1
              for (int m = nit; m > 0; m >>= 1) {
                  if (m & 1) { const float a = w0r * b0r - w0i * b0i, b = w0r * b0i + w0i * b0r; w0r = a; w0i = b; const float c2 = w1r * b1r - w1i * b1i, d2 = w1r * b1i + w1i * b1r; w1r = c2; w1i = d2; }
                  const float a = b0r * b0r - b0i * b0i, b = 2.f * b0r * b0i; b0r = a; b0i = b; const float c2 = b1r * b1r - b1i * b1i, d2 = 2.f * b1r * b1i; b1r = c2; b1i = d2; }
              if (hf == 0) { const float a = w0r * R0r - w0i * R0i, b = w0r * R0i + w0i * R0r; R0r = a; R0i = b; const float c2 = w1r * R1r - w1i * R1i, d2 = w1r * R1i + w1i * R1r; R1r = c2; R1i = d2; }
              R0r += __shfl_xor(R0r, 32); R0i += __shfl_xor(R0i, 32); R1r += __shfl_xor(R1r, 32); R1i += __shfl_xor(R1i, 32); }
#pragma unroll
            for (int kb = 0; kb < 4; ++kb) Cf[kb] = *(const bf16x8*)(Ct + (size_t)(g * NH + (lane & 15)) * 128 + kb * 32 + 8 * (lane >> 4));
            const unsigned dbits = cvt_pk_bf16(a.in[13][g * NH + (lane & 15)], 0.f) & 0xffffu;
#pragma unroll
            for (int jj = 0; jj < 8; ++jj) Df[jj] = (short)((lane < 32 && (8 * (lane >> 4) + jj) == (lane & 15)) ? dbits : 0u);
        }
        const int tokP = 16 * ((col >> 2) & 1) + 2 * (col >> 3) + ((col >> 1) & 1);
        bf16x8 Un = *(const bf16x8*)(ub + (size_t)(r * 256 + tokP) * SW + g * NH + 8 * hf), Vn = *(const bf16x8*)(ub + (size_t)(r * 256 + 8 + tokP) * SW + g * NH + 8 * hf);
        bf16x8 A2n[2] = {{0, 0, 0, 0, 0, 0, 0, 0}, {0, 0, 0, 0, 0, 0, 0, 0}};
        if (PASS == 2) {
#pragma unroll
            for (int mt = 0; mt < 2; ++mt) A2n[mt] = *(const bf16x8*)(ub + (size_t)(r * 256 + 16 * mt + (lane & 15)) * SW + g * NH + 8 * ((lane >> 4) & 1)); }
        for (int c = 0; c < 8; ++c) {
            const int t0 = r * 256 + c * 32;
            const bf16x8 Ua = Un, Va = Vn; bf16x8 A2[2] = {A2n[0], A2n[1]};
            if (lane >= 32) { A2[0] = (bf16x8){0, 0, 0, 0, 0, 0, 0, 0}; A2[1] = (bf16x8){0, 0, 0, 0, 0, 0, 0, 0}; }
            { const int tn = t0 + (c < 7 ? 32 : 0);
                Un = *(const bf16x8*)(ub + (size_t)(tn + tokP) * SW + g * NH + 8 * hf); Vn = *(const bf16x8*)(ub + (size_t)(tn + 8 + tokP) * SW + g * NH + 8 * hf);
                if (PASS == 2) {
#pragma unroll
                    for (int mt = 0; mt < 2; ++mt) A2n[mt] = *(const bf16x8*)(ub + (size_t)(tn + 16 * mt + (lane & 15)) * SW + g * NH + 8 * ((lane >> 4) & 1)); } }
            constexpr bool has_cv = false; ConvD cd; float cv[32]; float csc = 1.f;
            if (has_cv) { const int jstep = (PASS == 2 ? 4 + c : c); cd = conv_desc(2 * ((jstep >> 1) * 2048 + id) + (jstep & 1), a, F.ws);
#pragma unroll
                for (int kk = 0; kk < 32; ++kk) cv[kk] = cd.src[(size_t)kk * cd.ld + lane];
                if (cd.scale) csc = cd.scale[lane & 31]; }
            const f32x16 zz = {0.f, 0.f, 0.f, 0.f, 0.f, 0.f, 0.f, 0.f, 0.f, 0.f, 0.f, 0.f, 0.f, 0.f, 0.f, 0.f};
            const bf16x8 z8 = {0, 0, 0, 0, 0, 0, 0, 0}; const bool oddrow = (col & 1) != 0;
            const bf16x8 Ulo = oddrow ? z8 : Ua, Uhi = oddrow ? Ua : z8, Vlo = oddrow ? z8 : Va, Vhi = oddrow ? Va : z8;
            f32x16 bu0 = __builtin_amdgcn_mfma_f32_32x32x16_bf16(Ulo, Bf[0], zz, 0, 0, 0);  bu0 = __builtin_amdgcn_mfma_f32_32x32x16_bf16(Uhi, Bf[1], bu0, 0, 0, 0);
            f32x16 bu2 = __builtin_amdgcn_mfma_f32_32x32x16_bf16(Ulo, Bf[2], zz, 0, 0, 0);  bu2 = __builtin_amdgcn_mfma_f32_32x32x16_bf16(Uhi, Bf[3], bu2, 0, 0, 0);
            f32x16 bu1 = __builtin_amdgcn_mfma_f32_32x32x16_bf16(Vlo, Bf[0], zz, 0, 0, 0);  bu1 = __builtin_amdgcn_mfma_f32_32x32x16_bf16(Vhi, Bf[1], bu1, 0, 0, 0);
            f32x16 bu3 = __builtin_amdgcn_mfma_f32_32x32x16_bf16(Vlo, Bf[2], zz, 0, 0, 0);  bu3 = __builtin_amdgcn_mfma_f32_32x32x16_bf16(Vhi, Bf[3], bu3, 0, 0, 0);
            { f32x2s Rr2 = {R0r, R1r}, Ri2 = {R0i, R1i};
              scan_pairs<PASS>(bu0, bu2, bu1, bu3, (f32x2s){c0[0], c1[0]}, (f32x2s){c0[1], c1[1]}, (f32x2s){c0[2], c1[2]}, (f32x2s){c0[3], c1[3]}, Rr2, Ri2, hf);
              R0r = Rr2.x; R1r = Rr2.y; R0i = Ri2.x; R1i = Ri2.y; }
            if (PASS == 2) {
                LAS unsigned* sw = (LAS unsigned*)sl;
#pragma unroll
                for (int p = 0; p < 8; ++p) {
                    sw[(16 * hf + p) * 68 + col] = cvt_pk_bf16(bu0[2 * p], bu2[2 * p]); sw[(16 * hf + p) * 68 + 32 + col] = cvt_pk_bf16(bu0[2 * p + 1], bu2[2 * p + 1]);
                    sw[(16 * hf + 8 + p) * 68 + col] = cvt_pk_bf16(bu1[2 * p], bu3[2 * p]); sw[(16 * hf + 8 + p) * 68 + 32 + col] = cvt_pk_bf16(bu1[2 * p + 1], bu3[2 * p + 1]); }
                asm volatile("s_waitcnt lgkmcnt(0)" ::: "memory");
#pragma unroll
                for (int mt = 0; mt < 2; ++mt) {
                    f32x4 y = {0.f, 0.f, 0.f, 0.f};
#pragma unroll
                    for (int kb = 0; kb < 4; ++kb) { const bf16x8 Af = *(const LAS bf16x8*)(sl + ((16 * mt + (lane & 15)) * 68 + kb * 16 + 4 * (lane >> 4)) * 4);
                        y = __builtin_amdgcn_mfma_f32_16x16x32_bf16(Af, Cf[kb], y, 0, 0, 0); }
                    y = __builtin_amdgcn_mfma_f32_16x16x32_bf16(A2[mt], Df, y, 0, 0, 0);
#pragma unroll
                    for (int j = 0; j < 4; ++j) ys[(size_t)(t0 + 16 * mt + 4 * (lane >> 4) + j) * SW + g * NH + (lane & 15)] = (bf16_t)(cvt_pk_bf16(fgelu_tanh(y[j]), 0.f) & 0xffffu);
                }
                asm volatile("s_waitcnt lgkmcnt(0)" ::: "memory");
            }
            if (has_cv) conv_finish(cv, cd, csc, cscr, lane);
        }
        if (PASS == 1 && hf == 0) {
            *(float2*)(E + ((size_t)(r * NG + g) * NS + col) * 2) = make_float2(R0r, R0i);
            *(float2*)(E + ((size_t)(r * NG + g) * NS + 32 + col) * 2) = make_float2(R1r, R1i);
        }
    }
}

__device__ __forceinline__ void p6_route(const Frame& F, const Args& a) {
    const bf16_t* x1b = (const bf16_t*)(F.ws + WS_X1B); const bf16_t* wrt = (const bf16_t*)(F.ws + WS_WRT); float* rstd2 = (float*)(F.ws + WS_RSTD2);
    int* cnt = (int*)(F.ctl + CW_CNT); int* list = (int*)(F.ws + WS_LIST);
    int* tok_e = (int*)(F.ws + WS_TOK); int* tok_pos = tok_e + 2 * T; float* tok_w = (float*)(tok_pos + 2 * T);
    volatile LAS int* lcnt = (volatile LAS int*)(F.MISC + 96); volatile LAS int* lbase = (volatile LAS int*)(F.MISC + 128);
    constexpr int WP = 2064;
    LAS unsigned char* wl = F.lds;
    LAS float* lg = (LAS float*)(F.lds + 102400 + (F.wave & 3) * 4096);
    const int lane = F.lane; const bool active = F.wave < 4;
    { u32x4 t[12];
#pragma unroll
      for (int q = 0; q < 12; ++q) { const int p = F.tid + 512 * q; t[q] = *(const u32x4*)(wrt + (size_t)(p >> 7) * D + (p & 127) * 8); }
#pragma unroll
      for (int q = 0; q < 12; ++q) { const int p = F.tid + 512 * q; *(LAS u32x4*)(wl + (p >> 7) * WP + (p & 127) * 16) = t[q]; } }
    for (int blk = blockIdx.x; blk < T / 64; blk += F.G) {
        if (F.tid < 32) lcnt[F.tid] = 0;
        __syncthreads();
        const int tok0 = blk * 64 + (F.wave & 3) * 16;
        int e1 = 0, e2 = 0, rk1 = 0, rk2 = 0; float wt1 = 0.f, wt2 = 0.f;
        if (active) {
            f32x4 acc[3]; float ssq = 0.f;
#pragma unroll
            for (int n = 0; n < 3; ++n) acc[n] = (f32x4){0.f, 0.f, 0.f, 0.f};
            const bf16_t* arow = x1b + (size_t)(tok0 + (lane & 15)) * D + 8 * (lane >> 4);
            const LAS unsigned char* brow = wl + (lane & 15) * WP + 16 * (lane >> 4);
#pragma unroll 8
            for (int kb = 0; kb < 32; ++kb) {
                const u32x4 aw = *(const u32x4*)(arow + kb * 32);
                f32x4 p, q; unpack8(aw, p, q); ssq += (p[0] * p[0] + p[1] * p[1]) + (p[2] * p[2] + p[3] * p[3]) + (q[0] * q[0] + q[1] * q[1]) + (q[2] * q[2] + q[3] * q[3]);
                const bf16x8 Af = __builtin_bit_cast(bf16x8, aw);
#pragma unroll
                for (int n = 0; n < 3; ++n) { const bf16x8 Bfr = *(const LAS bf16x8*)(brow + n * 16 * WP + kb * 64);
                    acc[n] = __builtin_amdgcn_mfma_f32_16x16x32_bf16(Af, Bfr, acc[n], 0, 0, 0); }
            }
            ssq += __shfl_xor(ssq, 16); ssq += __shfl_xor(ssq, 32);
            const float rs = rsqrtf(ssq * (1.f / D) + EPS);
#pragma unroll
            for (int n = 0; n < 3; ++n)
#pragma unroll
                for (int j = 0; j < 4; ++j) lg[(4 * (lane >> 4) + j) * 52 + n * 16 + (lane & 15)] = acc[n][j];
            asm volatile("s_waitcnt lgkmcnt(0)" ::: "memory");
            if (lane < 16) {
                const LAS float* my = lg + lane * 52;
                float l0 = my[0] * rs + a.in[20][0], l1 = my[1] * rs + a.in[20][1], l2 = my[2] * rs + a.in[20][2], l3 = my[3] * rs + a.in[20][3];
                int gi = 0; float lmax = l0;
                if (l1 > lmax) { lmax = l1; gi = 1; } if (l2 > lmax) { lmax = l2; gi = 2; } if (l3 > lmax) { lmax = l3; gi = 3; }
                const float se = __expf(l0 - lmax) + __expf(l1 - lmax) + __expf(l2 - lmax) + __expf(l3 - lmax);
                const float pg = 1.f / se;
                float v1 = -3.0e38f, v2 = -3.0e38f; int i1 = 0, i2 = 0;
#pragma unroll
                for (int j = 0; j < 8; ++j) { const float vv = my[4 + gi * 8 + j] * rs + a.in[22][gi * 8 + j];
                    if (vv > v1) { v2 = v1; i2 = i1; v1 = vv; i1 = j; } else if (vv > v2) { v2 = vv; i2 = j; } }
                const float w1 = 1.f / (1.f + __expf(v2 - v1));
                e1 = gi * 8 + i1; e2 = gi * 8 + i2; wt1 = pg * w1; wt2 = pg * (1.f - w1);
                rk1 = __hip_atomic_fetch_add((LAS int*)&lcnt[e1], 1, __ATOMIC_RELAXED, __HIP_MEMORY_SCOPE_WORKGROUP);
                rk2 = __hip_atomic_fetch_add((LAS int*)&lcnt[e2], 1, __ATOMIC_RELAXED, __HIP_MEMORY_SCOPE_WORKGROUP);
                rstd2[tok0 + lane] = rs;
            }
        }
        __syncthreads();
        if (F.tid < 32) { const int c = lcnt[F.tid]; lbase[F.tid] = c ? __hip_atomic_fetch_add(&cnt[F.tid], c, __ATOMIC_RELAXED, __HIP_MEMORY_SCOPE_AGENT) : 0; }
        __syncthreads();
        if (active && lane < 16) { const int t = tok0 + lane; const int p1 = lbase[e1] + rk1, p2 = lbase[e2] + rk2;
            list[e1 * T + p1] = t; list[e2 * T + p2] = t;
            tok_e[2 * t] = e1; tok_e[2 * t + 1] = e2; tok_pos[2 * t] = p1; tok_pos[2 * t + 1] = p2; tok_w[2 * t] = wt1; tok_w[2 * t + 1] = wt2; }
        __syncthreads();
    }
}
__device__ __forceinline__ void tr64q(const float* __restrict__ src, int ld, int col0, int k0, const float* __restrict__ scale, float mul, unsigned char* __restrict__ dst, size_t drow0, int Kdst, LAS unsigned char* scr, int lane) {
    const float* s = src + (size_t)k0 * ld + col0 + lane;
#pragma unroll
    for (int hh = 0; hh < 2; ++hh) {
        float v[32];
#pragma unroll
        for (int kk = 0; kk < 32; ++kk) v[kk] = __builtin_nontemporal_load(s + (size_t)(32 * hh + kk) * ld);
        if (scale) {
#pragma unroll
            for (int kk = 0; kk < 32; ++kk) v[kk] *= scale[k0 + 32 * hh + kk];
        }
#pragma unroll
        for (int c = 0; c < 2; ++c) { u32x4 o;
            o.x = cvt4_fp8(v[16 * c + 0] * mul, v[16 * c + 1] * mul, v[16 * c + 2] * mul, v[16 * c + 3] * mul); o.y = cvt4_fp8(v[16 * c + 4] * mul, v[16 * c + 5] * mul, v[16 * c + 6] * mul, v[16 * c + 7] * mul);
            o.z = cvt4_fp8(v[16 * c + 8] * mul, v[16 * c + 9] * mul, v[16 * c + 10] * mul, v[16 * c + 11] * mul); o.w = cvt4_fp8(v[16 * c + 12] * mul, v[16 * c + 13] * mul, v[16 * c + 14] * mul, v[16 * c + 15] * mul);
            *(LAS u32x4*)(scr + lane * 80 + 16 * (2 * hh + c)) = o; }
        asm volatile("s_waitcnt vmcnt(0)" ::: "memory");
    }
    asm volatile("s_waitcnt lgkmcnt(0)" ::: "memory");
#pragma unroll
    for (int j = 0; j < 4; ++j) { const int row = 16 * j + (lane >> 2); const u32x4 o = *(const LAS u32x4*)(scr + row * 80 + 16 * (lane & 3));
        *(u32x4*)(dst + (drow0 + row) * (size_t)Kdst + k0 + 16 * (lane & 3)) = o; }
    asm volatile("s_waitcnt lgkmcnt(0)" ::: "memory");
}
__device__ __forceinline__ void p6_convert(const Frame& F, const Args& a, int lo, int hi, int widx, int nwork) {
    LAS unsigned char* scr = F.lds + F.wave * 16384;
    unsigned char* Wgu_q = F.ws + WS_WGU; unsigned char* Wd_q = F.ws + WS_WD;
    constexpr int I_GU = NE * 16 * 16;
    for (int it = lo + widx; it < hi; it += nwork) {
        if (it < I_GU) { const int e = it / 256, r = it % 256, kb = r / 16, nb = r % 16, j0 = 64 * nb, pn = j0 >> 8, i = j0 & 255;
            tr64q((i < 128 ? a.in[23] : a.in[24]) + (size_t)e * D * EFF, EFF, 128 * pn + (i & 127), 64 * kb, a.in[18], 32.f, Wgu_q, (size_t)e * 1024 + j0, D, scr, F.lane); }
        else { const int q = it - I_GU, e = q / 128, r = q % 128, kb = r / 16, nb = r % 16;
            tr64q(a.in[25] + (size_t)e * EFF * D, D, 64 * nb, 64 * kb, nullptr, 16.f, Wd_q, (size_t)e * 1024 + 64 * nb, EFF, scr, F.lane); }
    }
}
__device__ __forceinline__ void load_tb(const Frame& F) {
    volatile LAS int* tb = (volatile LAS int*)(F.MISC + 16); volatile LAS int* lc = (volatile LAS int*)(F.MISC + 64);
    if (F.tid < 32) lc[F.tid] = (int)__hip_atomic_load(F.ctl + CW_CNT + F.tid, __ATOMIC_RELAXED, __HIP_MEMORY_SCOPE_AGENT);
    __syncthreads();
    if (F.tid == 0) { int s = 0; for (int e = 0; e < 32; ++e) { tb[e] = s; s += (lc[e] + 255) >> 8; } tb[32] = s; }
    __syncthreads();
}
__device__ __forceinline__ void p9_final(const Frame& F, const Args& a) {
    const LAS int* tb = (const LAS int*)(F.MISC + 16);
    const int* tok_e = (const int*)(F.ws + WS_TOK); const int* tok_pos = tok_e + 2 * T; const float* tok_w = (const float*)(tok_pos + 2 * T);
    const bf16_t* Y = (const bf16_t*)(F.ws + WS_Y); const bf16_t* x1b = (const bf16_t*)(F.ws + WS_X1B); const float* gf = a.in[26]; float* out = a.out;
    const int gw = blockIdx.x * 8 + F.wave, NGW = F.G * 8;
    for (int tq = 2 * gw; tq < T; tq += 2 * NGW) {
        int s1[2], s2[2]; float w1[2], w2[2];
#pragma unroll
        for (int q = 0; q < 2; ++q) { const int t = tq + q; s1[q] = 256 * tb[tok_e[2 * t]] + tok_pos[2 * t]; s2[q] = 256 * tb[tok_e[2 * t + 1]] + tok_pos[2 * t + 1]; w1[q] = tok_w[2 * t]; w2[q] = tok_w[2 * t + 1]; }
        u32x4 xw[2][2], y1[2][2], y2[2][2];
#pragma unroll
        for (int q = 0; q < 2; ++q)
#pragma unroll
            for (int j = 0; j < 2; ++j) { const int c = 8 * F.lane + 512 * j; xw[q][j] = *(const u32x4*)(x1b + (size_t)(tq + q) * D + c);
                y1[q][j] = *(const u32x4*)(Y + (size_t)s1[q] * D + c); y2[q][j] = *(const u32x4*)(Y + (size_t)s2[q] * D + c); }
        f32x4 va[2][2], vb[2][2]; float ss[2];
#pragma unroll
        for (int q = 0; q < 2; ++q) { ss[q] = 0.f;
#pragma unroll
            for (int j = 0; j < 2; ++j) { f32x4 xa, xb_, ya, yb, za, zb; unpack8(xw[q][j], xa, xb_); unpack8(y1[q][j], ya, yb); unpack8(y2[q][j], za, zb);
                va[q][j] = xa + w1[q] * ya + w2[q] * za; vb[q][j] = xb_ + w1[q] * yb + w2[q] * zb;
                ss[q] += (va[q][j][0] * va[q][j][0] + va[q][j][1] * va[q][j][1]) + (va[q][j][2] * va[q][j][2] + va[q][j][3] * va[q][j][3]) + (vb[q][j][0] * vb[q][j][0] + vb[q][j][1] * vb[q][j][1]) + (vb[q][j][2] * vb[q][j][2] + vb[q][j][3] * vb[q][j][3]); } }
#pragma unroll
        for (int o = 1; o < 64; o <<= 1) { ss[0] += __shfl_xor(ss[0], o); ss[1] += __shfl_xor(ss[1], o); }
#pragma unroll
        for (int q = 0; q < 2; ++q) { const float rs = rsqrtf(ss[q] * (1.f / D) + EPS);
#pragma unroll
            for (int j = 0; j < 2; ++j) { const int c = 8 * F.lane + 512 * j;
                *(f32x4*)(out + (size_t)(tq + q) * D + c) = va[q][j] * rs * *(const f32x4*)(gf + c); *(f32x4*)(out + (size_t)(tq + q) * D + c + 4) = vb[q][j] * rs * *(const f32x4*)(gf + c + 4); } }
        asm volatile("s_waitcnt vmcnt(8)" ::: "memory");
    }
}

__global__ void __launch_bounds__(512, 2) mega_fwd(Args args) {
    extern __shared__ __attribute__((aligned(16))) unsigned char lds_raw[];
    Frame F;
    F.lds = (LAS unsigned char*)lds_raw; F.MISC = (volatile LAS unsigned*)(F.lds + MISC_OFF);
    F.tid = threadIdx.x; F.lane = F.tid & 63; F.wave = __builtin_amdgcn_readfirstlane(F.tid >> 6); F.G = gridDim.x;
    F.ws = args.ws; F.ctl = (unsigned*)(args.ws + WS_CTL);
    for (int u = F.tid; u < (LDS_BYTES - MISC_OFF) / 4; u += 512) ((LAS unsigned*)(F.lds + MISC_OFF))[u] = 0u;
    __syncthreads();
    XcdBarrier bar; bar.bar = F.ctl + CW_BAR; bar.x = 0; bar.st = nullptr;
    if (args.use_bar) bar = xcd_barrier_post(F.ctl + CW_BAR, F.MISC + 0);
    const int lo = args.ph_lo, hi = args.ph_hi;
#define IN(k) (lo <= (k) && (k) < hi)
#define SEAM(k) do { if (IN(k) && IN((k) + 1)) xcd_barrier(bar); } while (0)
    unsigned char* ws = args.ws;
    const int c = (int)blockIdx.x;

    if (IN(0)) { p0_prologue(F, args); }
    SEAM(0);
    if (IN(1)) {
        pg8::DenseOrder S{(const char*)(ws + WS_XB), (const char*)(ws + WS_WIN), D, T / 256, INC / 256, 1, F.G, c};
        EpiWin E{(const float*)(ws + WS_RSTD1), (bf16_t*)(ws + WS_V), (bf16_t*)(ws + WS_BG), (bf16_t*)(ws + WS_UB), (bf16_t*)(ws + WS_GATES), args.in[16]};
        pg8::gemm_phase<EpiWin, pg8::DenseOrder, false, true>(F.lds, D, S, E);
        { const int nu = (T / 256) * (INC / 256), rem = nu % F.G; if (rem != 0 && c >= rem) p6_convert(F, args, 0, CV_EARLY, (c - rem) * 8 + F.wave, (F.G - rem) * 8); }
    }
    SEAM(1);
    if (IN(2)) { p2_conv(F, args); ssm_pass<1>(F, args); }
    SEAM(2);
    if (IN(3)) { ssm_pass<2>(F, args); }
    SEAM(3);
    if (IN(4)) {
        { pg8::DenseOrder S{(const char*)(ws + WS_YS), (const char*)(ws + WS_WGLU), SW, T / 256, 4, 2, F.G, c};
          EpiGlu E{(const bf16_t*)(ws + WS_GATES), (bf16_t*)(ws + WS_MB)};
          pg8::gemm_phase<EpiGlu, pg8::DenseOrder, false, true>(F.lds, SW, S, E); }
        asm volatile("s_waitcnt vmcnt(0)" ::: "memory"); __syncthreads();
        { pg8::DenseOrder S{(const char*)(ws + WS_Z), (const char*)(ws + WS_WC), D, T / 256, 4, 1, F.G, c};
          EpiMix E{(const bf16_t*)(ws + WS_GATES), (const bf16_t*)(ws + WS_MB), (bf16_t*)(ws + WS_MIXED)};
          pg8::gemm_phase<EpiMix, pg8::DenseOrder, false, true>(F.lds, D, S, E); }
    }
    SEAM(4);
    if (IN(5)) {
        pg8::DenseOrder S{(const char*)(ws + WS_MIXED), (const char*)(ws + WS_WO), D, T / 256, 4, 1, F.G, c};
        EpiX1 E{args.in[0], args.out, (bf16_t*)(ws + WS_X1B), ws + WS_X1Q};
        pg8::gemm_phase<EpiX1, pg8::DenseOrder, false, true>(F.lds, D, S, E);
    }
    SEAM(5);
    if (IN(6)) { p6_route(F, args); { const int nu = (T / 256) * (INC / 256), rem = nu % F.G; p6_convert(F, args, rem != 0 ? CV_EARLY : 0, NE * 256 + NE * 128, blockIdx.x * 8 + F.wave, F.G * 8); } }
    SEAM(6);
    if (IN(7)) {
        load_tb(F);
        pg8::MoEOrder S{(const LAS int*)(F.MISC + 16), (const LAS int*)(F.MISC + 64), (const int*)(ws + WS_LIST), (const char*)(ws + WS_X1Q), (const char*)(ws + WS_WGU), D / 2, (size_t)1024 * D, F.G, c, true, (const char*)(ws + WS_WGU), 64};
        EpiUp E{(const int*)(ws + WS_LIST), (const float*)(ws + WS_RSTD2), ws + WS_HMID};
        pg8::gemm_phase<EpiUp, pg8::MoEOrder, true, true, true>(F.lds, D / 2, S, E);
    }
    SEAM(7);
    if (IN(8)) {
        load_tb(F);
        pg8::MoEOrder S{(const LAS int*)(F.MISC + 16), (const LAS int*)(F.MISC + 64), (const int*)(ws + WS_LIST), (const char*)(ws + WS_HMID), (const char*)(ws + WS_WD), EFF / 2, (size_t)1024 * EFF, F.G, c, false, (const char*)(ws + WS_WD2), WD_SPLIT};
        EpiDown E{(bf16_t*)(ws + WS_Y)};
        pg8::gemm_phase<EpiDown, pg8::MoEOrder, false, true, true>(F.lds, EFF / 2, S, E);
    }
    SEAM(8);
    if (IN(9)) { load_tb(F); p9_final(F, args); }
#undef IN
#undef SEAM
}

#ifndef MK_MODE
#define MK_MODE 2
#endif
extern "C" void kernel_launch(void* const* d_in, const int* in_sizes, int n_in, void* d_out, int out_size, void* d_ws, size_t ws_size, hipStream_t stream) {
    static int grid = 0;
    if (grid == 0) {
        if (ws_size < WS_END) { fprintf(stderr, "kernel_launch: workspace too small (%zu < %zu)\n", ws_size, (size_t)WS_END); grid = -1; return; }
        int dev = 0, cus = 0, per_cu = 0;
        (void)hipGetDevice(&dev); (void)hipDeviceGetAttribute(&cus, hipDeviceAttributeMultiprocessorCount, dev);
        (void)hipFuncSetAttribute((const void*)mega_fwd, hipFuncAttributeMaxDynamicSharedMemorySize, LDS_BYTES);
        (void)hipOccupancyMaxActiveBlocksPerMultiprocessor(&per_cu, (const void*)mega_fwd, 512, LDS_BYTES);
        (void)hipGetLastError();
        grid = cus * (per_cu < 1 ? 1 : 1);
    }
    if (grid < 0) return;
    (void)hipMemsetAsync((char*)d_ws + WS_CTL, 0, CTL_BYTES, stream);
    Args a{};
    for (int i = 0; i < 27; ++i) a.in[i] = (const float*)d_in[i];
    a.out = (float*)d_out; a.ws = (unsigned char*)d_ws;
#if MK_MODE == 2
    a.ph_lo = 0; a.ph_hi = 10; a.use_bar = 1;
    hipLaunchKernelGGL(mega_fwd, dim3(grid), dim3(512), LDS_BYTES, stream, a);
#else
    const int nfast = (MK_MODE == 1) ? 6 : 10;
    for (int p = 0; p < nfast; ++p) { a.ph_lo = p; a.ph_hi = p + 1; a.use_bar = 0; hipLaunchKernelGGL(mega_fwd, dim3(grid), dim3(512), LDS_BYTES, stream, a); }
#if MK_MODE == 1
    {
        using namespace nv;
        float* out = (float*)d_out; char* ws = (char*)d_ws; const size_t MiB_ = 1u << 20;
        float* hbuf = (float*)(ws); float* B1 = (float*)(ws + 64 * MiB_); float* B2 = (float*)(ws + 128 * MiB_);
        char* misc = ws + 256 * MiB_;
        int* cnt = (int*)(misc + 2 * MiB_); int* off = cnt + 64; int* list = (int*)(misc + 2 * MiB_ + 4096);
        int* tok_e = (int*)(misc + 5 * MiB_); int* tok_pos = tok_e + 2 * nv::T; float* tok_w = (float*)(tok_pos + 2 * nv::T);
        const dim3 b256(256);
        const float* norm_ffn = (const float*)d_in[18]; const float* wrg = (const float*)d_in[19]; const float* brg = (const float*)d_in[20]; const float* wre = (const float*)d_in[21]; const float* bre = (const float*)d_in[22];
        const float* w_gate = (const float*)d_in[23]; const float* w_up = (const float*)d_in[24]; const float* w_down = (const float*)d_in[25]; const float* norm_final = (const float*)d_in[26];
        hipLaunchKernelGGL(k_rmsnorm, dim3(nv::T / 4), b256, 0, stream, out, norm_ffn, hbuf, nv::T);
        (void)hipMemsetAsync(cnt, 0, 512, stream);
        hipLaunchKernelGGL(k_route, dim3(nv::T / 4), b256, 0, stream, hbuf, wrg, brg, wre, bre, cnt, list, tok_e, tok_pos, tok_w);
        hipLaunchKernelGGL(k_offsets, dim3(1), dim3(64), 0, stream, cnt, off);
        float* Hm = B1; float* Yd = B2;
        for (int e = 0; e < nv::NE; ++e)
            hipLaunchKernelGGL(k_gemm<2>, dim3(nv::EFF / 64, nv::T / 64), b256, 0, stream, hbuf, nv::D, list + e * nv::T, nullptr, w_gate + (size_t)e * nv::D * nv::EFF, w_up + (size_t)e * nv::D * nv::EFF, nv::EFF,
                               Hm, nv::EFF, off + e, nullptr, 0, cnt + e, nv::EFF, nv::D);
        for (int e = 0; e < nv::NE; ++e)
            hipLaunchKernelGGL(k_gemm<0>, dim3(nv::D / 64, nv::T / 64), b256, 0, stream, Hm, nv::EFF, nullptr, off + e, w_down + (size_t)e * nv::EFF * nv::D, nullptr, nv::D,
                               Yd, nv::D, off + e, nullptr, 0, cnt + e, nv::D, nv::EFF);
        hipLaunchKernelGGL(k_final, dim3(nv::T / 4), b256, 0, stream, out, Yd, off, tok_e, tok_pos, tok_w, norm_final);
    }
#endif
#endif
}
```
